# Optimizing an MI355X kernel written in HIP

```python
import math
import jax, jax.numpy as jnp
from jax import lax
import numpy as np

D_MODEL = 1024
BATCH = 16
SEQ = 2048
DEPTH = 2

HEAD_DIM = 64
N_HEADS_A = D_MODEL // (2 * HEAD_DIM)
N_HEADS_B = D_MODEL // (2 * HEAD_DIM)
N_HEADS_DIFF = D_MODEL // (2 * HEAD_DIM)
DILATED_CONFIGS = ((128, 1), (512, 4), (2048, 16))
WINDOW_Q_BLOCK = 128
MOBA_BLOCK = 256
MOBA_TOPK = 3
MOBA_Q_CHUNK = 32
DIFF_Q_BLOCK = 128
ROPE_THETA = 500000.0
ROPE_DIM = HEAD_DIM // 4
D_FF = -(-(8 * D_MODEL) // (3 * 256)) * 256
NORM_EPS = 1e-5
ATTN_SCALE = HEAD_DIM ** -0.5
NEG_INF = -1e30

kernel_name = 'hybrid_dilated_moba_diffattn_block'


def rmsnorm(x, g):
    xf = x.astype(jnp.float32)
    y = xf * lax.rsqrt(jnp.mean(xf * xf, axis=-1, keepdims=True) + NORM_EPS)
    return (y * g.astype(jnp.float32)).astype(x.dtype)


def rope_tables(positions):
    inv_freq = ROPE_THETA ** (-jnp.arange(0, ROPE_DIM, 2, dtype=jnp.float32) / ROPE_DIM)
    ang = positions.astype(jnp.float32)[..., None] * inv_freq
    return jnp.cos(ang), jnp.sin(ang)


def apply_partial_rope(x, cos, sin):
    half = ROPE_DIM // 2
    xf = x.astype(jnp.float32)
    x1, x2 = xf[..., :half], xf[..., half:ROPE_DIM]
    c, s = cos[:, :, None, :], sin[:, :, None, :]
    out = jnp.concatenate([x1 * c - x2 * s, x2 * c + x1 * s, xf[..., ROPE_DIM:]], axis=-1)
    return out.astype(x.dtype)


def strided_window_attention(q, k, v, n_keys):
    B, L, R, H, dh = q.shape
    bq = math.gcd(L, WINDOW_Q_BLOCK)
    nb = L // bq
    kw_len = bq + n_keys
    pad = ((0, 0), (n_keys, 0), (0, 0), (0, 0), (0, 0))
    idx = jnp.arange(nb)[:, None] * bq + jnp.arange(kw_len)[None, :]
    kw = jnp.take(jnp.pad(k, pad), idx, axis=1)
    vw = jnp.take(jnp.pad(v, pad), idx, axis=1)
    qb = q.reshape(B, nb, bq, R, H, dh)
    logits = jnp.einsum('bnqrhd,bnkrhd->bnrhqk', qb, kw).astype(jnp.float32) * ATTN_SCALE
    rel = jnp.arange(bq)[:, None] + n_keys - jnp.arange(kw_len)[None, :]
    band = (rel >= 0) & (rel <= n_keys)
    valid = idx >= n_keys
    mask = band[None] & valid[:, None, :]
    logits = jnp.where(mask[None, :, None, None], logits, NEG_INF)
    m = jnp.max(logits, axis=-1, keepdims=True)
    p = jnp.exp(logits - m)
    denom = jnp.sum(p, axis=-1, keepdims=True)
    o = jnp.einsum('bnrhqk,bnkrhd->bnqrhd', p / denom, vw.astype(jnp.float32))
    lse = (m + jnp.log(denom))[..., 0]
    o = o.reshape(B, L, R, H, dh)
    lse = lse.transpose(0, 1, 4, 2, 3).reshape(B, L, R, H)
    return o, lse


def dilated_attention(q, k, v):
    B, S, H, dh = q.shape
    outs, lses = [], []
    for window, dilation in DILATED_CONFIGS:
        L = S // dilation
        split = lambda t: t.reshape(B, L, dilation, H, dh)
        o, lse = strided_window_attention(split(q), split(k), split(v), window // dilation)
        outs.append(o.reshape(B, S, H, dh))
        lses.append(lse.reshape(B, S, H))
    w = jax.nn.softmax(jnp.stack(lses, axis=-1), axis=-1)
    out = jnp.einsum('bshg,gbshd->bshd', w, jnp.stack(outs, axis=0))
    return out.astype(q.dtype)


def moba_attention(q, k, v):
    B, S, H, dh = q.shape
    nblk = -(-S // MOBA_BLOCK)
    s_pad = nblk * MOBA_BLOCK
    topk = min(MOBA_TOPK, nblk - 1)
    qh = q.transpose(0, 2, 1, 3)
    pad = ((0, 0), (0, 0), (0, s_pad - S), (0, 0))
    kp = jnp.pad(k.transpose(0, 2, 1, 3), pad)
    vp = jnp.pad(v.transpose(0, 2, 1, 3), pad)
    kb = kp.reshape(B, H, nblk, MOBA_BLOCK, dh)
    vb = vp.reshape(B, H, nblk, MOBA_BLOCK, dh)
    kmean = jnp.mean(kb.astype(jnp.float32), axis=3)
    bi = jnp.arange(B)[:, None, None, None]
    hi = jnp.arange(H)[None, :, None, None]

    def chunk_fn(c):
        start = c * MOBA_Q_CHUNK
        qblk = start // MOBA_BLOCK
        qc = lax.dynamic_slice_in_dim(qh, start, MOBA_Q_CHUNK, axis=2)
        ko = lax.dynamic_slice_in_dim(kp, qblk * MOBA_BLOCK, MOBA_BLOCK, axis=2)
        vo = lax.dynamic_slice_in_dim(vp, qblk * MOBA_BLOCK, MOBA_BLOCK, axis=2)
        qpos = start + jnp.arange(MOBA_Q_CHUNK)
        kpos = qblk * MOBA_BLOCK + jnp.arange(MOBA_BLOCK)
        own = jnp.einsum('bhqd,bhkd->bhqk', qc, ko).astype(jnp.float32) * ATTN_SCALE
        own = jnp.where(kpos[None, :] <= qpos[:, None], own, NEG_INF)
        if topk > 0:
            gate = jnp.einsum('bhqd,bhnd->bhqn', qc.astype(jnp.float32), kmean)
            past = jnp.arange(nblk) < qblk
            gate = jnp.where(past, gate, NEG_INF)
            _, gidx = lax.top_k(gate, topk)
            sel_valid = gidx < qblk
            ks = kb[bi, hi, gidx]
            vs = vb[bi, hi, gidx]
            sel = jnp.einsum('bhqd,bhqnkd->bhqnk', qc, ks).astype(jnp.float32) * ATTN_SCALE
            sel = jnp.where(sel_valid[..., None], sel, NEG_INF)
            logits = jnp.concatenate([sel.reshape(B, H, MOBA_Q_CHUNK, topk * MOBA_BLOCK), own], axis=-1)
            p = jax.nn.softmax(logits, axis=-1)
            p_sel = p[..., :topk * MOBA_BLOCK].reshape(B, H, MOBA_Q_CHUNK, topk, MOBA_BLOCK)
            p_own = p[..., topk * MOBA_BLOCK:]
            o = (jnp.einsum('bhqnk,bhqnkd->bhqd', p_sel, vs.astype(jnp.float32))
                 + jnp.einsum('bhqk,bhkd->bhqd', p_own, vo.astype(jnp.float32)))
        else:
            p_own = jax.nn.softmax(own, axis=-1)
            o = jnp.einsum('bhqk,bhkd->bhqd', p_own, vo.astype(jnp.float32))
        return o

    outs = lax.map(chunk_fn, jnp.arange(S // MOBA_Q_CHUNK))
    out = outs.transpose(1, 0, 3, 2, 4).reshape(B, S, H, dh)
    return out.astype(q.dtype)


def hybrid_ab_mixer(xn, w_in, w_out, cos, sin):
    B, S, _ = xn.shape
    proj = xn @ w_in
    wa, wb = N_HEADS_A * HEAD_DIM, N_HEADS_B * HEAD_DIM
    cuts = np.cumsum([wa, wa, wa, wb, wb])
    qa, ka, va, qb, kb, vb = jnp.split(proj, [int(c) for c in cuts], axis=-1)
    heads = lambda t, h: t.reshape(B, S, h, HEAD_DIM)
    qa = apply_partial_rope(heads(qa, N_HEADS_A), cos, sin)
    ka = apply_partial_rope(heads(ka, N_HEADS_A), cos, sin)
    qb = apply_partial_rope(heads(qb, N_HEADS_B), cos, sin)
    kb = apply_partial_rope(heads(kb, N_HEADS_B), cos, sin)
    oa = dilated_attention(qa, ka, heads(va, N_HEADS_A))
    ob = moba_attention(qb, kb, heads(vb, N_HEADS_B))
    o = jnp.concatenate([oa.reshape(B, S, wa), ob.reshape(B, S, wb)], axis=-1)
    return o @ w_out


def lambda_init_fn(layer_idx):
    return 0.8 - 0.6 * math.exp(-0.3 * layer_idx)


def diff_mixer(xn, w_in, w_out, lq1, lk1, lq2, lk2, subln_g, cos, sin, lambda_init):
    B, S, _ = xn.shape
    H = N_HEADS_DIFF
    wq = 2 * H * HEAD_DIM
    q, k, v = jnp.split(xn @ w_in, [wq, 2 * wq], axis=-1)
    q = apply_partial_rope(q.reshape(B, S, 2 * H, HEAD_DIM), cos, sin)
    k = apply_partial_rope(k.reshape(B, S, 2 * H, HEAD_DIM), cos, sin)
    qh = q.reshape(B, S, H, 2, HEAD_DIM).transpose(0, 2, 3, 1, 4)
    kh = k.reshape(B, S, H, 2, HEAD_DIM).transpose(0, 2, 3, 1, 4)
    vh = v.reshape(B, S, H, 2 * HEAD_DIM).transpose(0, 2, 1, 3)
    lam = (jnp.exp(jnp.sum(lq1.astype(jnp.float32) * lk1.astype(jnp.float32)))
           - jnp.exp(jnp.sum(lq2.astype(jnp.float32) * lk2.astype(jnp.float32)))
           + lambda_init)
    kpos = jnp.arange(S)

    def block_fn(c):
        start = c * DIFF_Q_BLOCK
        qc = lax.dynamic_slice_in_dim(qh, start, DIFF_Q_BLOCK, axis=3)
        logits = jnp.einsum('bhiqd,bhikd->bhiqk', qc, kh).astype(jnp.float32) * ATTN_SCALE
        qpos = start + jnp.arange(DIFF_Q_BLOCK)
        logits = jnp.where(kpos[None, :] <= qpos[:, None], logits, NEG_INF)
        p = jax.nn.softmax(logits, axis=-1)
        attn = p[:, :, 0] - lam * p[:, :, 1]
        return jnp.einsum('bhqk,bhkd->bhqd', attn, vh.astype(jnp.float32))

    outs = lax.map(block_fn, jnp.arange(S // DIFF_Q_BLOCK))
    o = outs.transpose(1, 0, 3, 2, 4).reshape(B, S, H, 2 * HEAD_DIM).astype(xn.dtype)
    o = rmsnorm(o, subln_g) * (1.0 - lambda_init)
    return o.reshape(B, S, H * 2 * HEAD_DIM) @ w_out


def swiglu(xn, w_gate, w_up, w_down):
    return (jax.nn.silu(xn @ w_gate) * (xn @ w_up)) @ w_down


def setup_inputs(seed: int = 0) -> dict:
    key = jax.random.key(seed)
    ks = jax.random.split(key, 20)
    n_even = (DEPTH + 1) // 2
    n_odd = DEPTH // 2
    w_ab_in = 3 * (N_HEADS_A + N_HEADS_B) * HEAD_DIM
    w_ab_out = (N_HEADS_A + N_HEADS_B) * HEAD_DIM
    w_diff_in = 3 * N_HEADS_DIFF * 2 * HEAD_DIM
    w_diff_out = N_HEADS_DIFF * 2 * HEAD_DIM
    nrm = lambda k, shape, scale: scale * jax.random.normal(k, shape, jnp.float32)
    gain = lambda k, shape: 1.0 + nrm(k, shape, 0.02)
    offset = jax.random.randint(ks[1], (BATCH, 1), 0, 4096, dtype=jnp.int32)
    positions = (offset + jnp.arange(SEQ, dtype=jnp.int32)[None, :]).astype(jnp.int32)
    return {
        'x': nrm(ks[0], (BATCH, SEQ, D_MODEL), 1.0),
        'positions': positions,
        'ab_norm_g': gain(ks[2], (n_even, D_MODEL)),
        'ab_w_in': nrm(ks[3], (n_even, D_MODEL, w_ab_in), D_MODEL ** -0.5),
        'ab_w_out': nrm(ks[4], (n_even, w_ab_out, D_MODEL), w_ab_out ** -0.5),
        'diff_norm_g': gain(ks[5], (n_odd, D_MODEL)),
        'diff_w_in': nrm(ks[6], (n_odd, D_MODEL, w_diff_in), D_MODEL ** -0.5),
        'diff_w_out': nrm(ks[7], (n_odd, w_diff_out, D_MODEL), w_diff_out ** -0.5),
        'diff_lambda_q1': nrm(ks[8], (n_odd, HEAD_DIM), 0.1),
        'diff_lambda_k1': nrm(ks[9], (n_odd, HEAD_DIM), 0.1),
        'diff_lambda_q2': nrm(ks[10], (n_odd, HEAD_DIM), 0.1),
        'diff_lambda_k2': nrm(ks[11], (n_odd, HEAD_DIM), 0.1),
        'diff_subln_g': gain(ks[12], (n_odd, 2 * HEAD_DIM)),
        'ffn_norm_g': gain(ks[13], (DEPTH, D_MODEL)),
        'ffn_w_gate': nrm(ks[14], (DEPTH, D_MODEL, D_FF), D_MODEL ** -0.5),
        'ffn_w_up': nrm(ks[15], (DEPTH, D_MODEL, D_FF), D_MODEL ** -0.5),
        'ffn_w_down': nrm(ks[16], (DEPTH, D_FF, D_MODEL), D_FF ** -0.5),
        'final_norm_g': gain(ks[17], (D_MODEL,)),
    }


def reference(x, positions, ab_norm_g, ab_w_in, ab_w_out, diff_norm_g, diff_w_in, diff_w_out,
              diff_lambda_q1, diff_lambda_k1, diff_lambda_q2, diff_lambda_k2, diff_subln_g,
              ffn_norm_g, ffn_w_gate, ffn_w_up, ffn_w_down, final_norm_g):
    cos, sin = rope_tables(positions)
    h = x
    for layer in range(DEPTH):
        i = layer // 2
        if layer % 2 == 0:
            h = h + hybrid_ab_mixer(rmsnorm(h, ab_norm_g[i]), ab_w_in[i], ab_w_out[i], cos, sin)
        else:
            h = h + diff_mixer(rmsnorm(h, diff_norm_g[i]), diff_w_in[i], diff_w_out[i],
                               diff_lambda_q1[i], diff_lambda_k1[i], diff_lambda_q2[i],
                               diff_lambda_k2[i], diff_subln_g[i], cos, sin,
                               lambda_init_fn(layer))
        h = h + swiglu(rmsnorm(h, ffn_norm_g[layer]), ffn_w_gate[layer], ffn_w_up[layer], ffn_w_down[layer])
    return rmsnorm(h, final_norm_g)
```

```cpp
#define PG8_ALIGN false
#include <hip/hip_runtime.h>
#include <hip/hip_bf16.h>
#include <cstdio>
#include <cstdint>
#include <cmath>
namespace pg8 {
#define PG8_LAS __attribute__((address_space(3)))
typedef unsigned short bf16_t;
typedef short bf16x8 __attribute__((ext_vector_type(8)));
typedef float f32x4 __attribute__((ext_vector_type(4)));
typedef unsigned u32x4 __attribute__((ext_vector_type(4)));
typedef unsigned u32x2 __attribute__((ext_vector_type(2)));
constexpr int BM = 256, BK = 64, HALF = 128, HTB = HALF * BK * 2  , STAGE_BYTES = 8 * HTB, NXCD = 8, WGM = 8;

__host__ __device__ __forceinline__ int lds_byte(int r, int c) { const int st = (r >> 4) * 2 + (c >> 5), rr = r & 15, cc = c & 31, ob = rr * 64 + cc * 2; return st * 1024 + (ob ^ (((ob >> 9) & 1) << 5)); }
__host__ __device__ __forceinline__ void stage_rc(int b, int& R, int& C) { const int st = b / 1024, sb = b % 1024, swz = sb ^ (((sb >> 9) & 1) << 5); R = (st >> 1) * 16 + swz / 64; C = (st & 1) * 32 + (swz % 64) / 2; }
__host__ __device__ __forceinline__ int perm32(int rho) { const int n = rho >> 4, i = rho & 15; return 8 * (i >> 2) + 4 * n + (i & 3); }

struct Unit { int pm, pn, idx; };
struct Gemm { const bf16_t* A; const bf16_t* Bt; int M, N, K; };

struct StaticOrder {
    int nM, nN, nwg, G, c;
    __host__ __device__ void init(int M, int N, int G_, int c_) { nM = M / BM; nN = N / BM; nwg = nM * nN; G = G_; c = c_; }
    __host__ __device__ bool next(int i, Unit& u) const {
        const long L = (long)i * G + c; if (L >= nwg) return false;
        int wgid = (int)L; { const int q = nwg / NXCD, r = nwg % NXCD, xcd = wgid % NXCD, off = wgid / NXCD; wgid = (xcd < r ? xcd * (q + 1) : r * (q + 1) + (xcd - r) * q) + off; }
        const int nig = WGM * nN, gid = wgid / nig, fm = gid * WGM, gsz = (nM - fm) < WGM ? (nM - fm) : WGM;
        u.pm = fm + ((wgid % nig) % gsz); u.pn = (wgid % nig) / gsz; u.idx = i; return true;
    }
    __device__ __forceinline__ void a_ready(const Unit&) const {}
    __device__ __forceinline__ void done(const Unit&) const {}
};

__device__ __forceinline__ unsigned cvt_pk_bf16(float lo, float hi) { unsigned r; asm volatile("v_cvt_pk_bf16_f32 %0, %1, %2" : "=v"(r) : "v"(lo), "v"(hi)); return r; }

constexpr int TOK = 32768;
__device__ __forceinline__ unsigned char* tab_ptr(volatile PG8_LAS unsigned* t, int k) {
    { unsigned a_ = (unsigned)(uintptr_t)t; asm volatile("" : "+v"(a_)); t = (volatile PG8_LAS unsigned*)a_; }
    const unsigned lo = (unsigned)__builtin_amdgcn_readfirstlane((int)t[2 * k]), hi = (unsigned)__builtin_amdgcn_readfirstlane((int)t[2 * k + 1]);
    unsigned long long v = (unsigned long long)lo | ((unsigned long long)hi << 32); asm volatile("" : "+s"(v)); return (unsigned char*)(__attribute__((address_space(1))) unsigned char*)v; }
constexpr size_t XWS_ROPE = (size_t)1 << 20, XWS_SSP = (size_t)3 << 20, XWS_KMP = (size_t)5 << 20, XWS_HB = (size_t)56 << 20, XWS_QKV = (size_t)184 << 20;

#ifndef EPI_NT
#define EPI_NT 2
#endif

#ifndef MEM_NT
#define MEM_NT 1
#endif
#define ST16_SC1(p, v) asm volatile("global_store_dwordx4 %0, %1, off sc1\n\ts_nop 1" :: "v"(p), "v"(v) : "memory")
#define ST8_SC1(p, v) asm volatile("global_store_dwordx2 %0, %1, off sc1\n\ts_nop 1" :: "v"(p), "v"(v) : "memory")
#ifndef PG8_AUX_A
#define PG8_AUX_A 0
#endif
#ifndef PG8_AUX_B
#define PG8_AUX_B 0
#endif
#ifndef RES_PF
#define RES_PF 1
#endif
#ifndef RES_LD
#define RES_LD 0
#endif
#ifndef EPI_QKV
#define EPI_QKV EPI_NT
#endif
#ifndef EPI_UP
#define EPI_UP EPI_NT
#endif
#ifndef EPI_RES
#define EPI_RES EPI_NT
#endif
template <int MODE> __device__ __forceinline__ void epi_st(void* p, const u32x4& v) {
    if constexpr (MODE == 2) asm volatile("global_store_dwordx4 %0, %1, off sc1\n\ts_nop 1" :: "v"((u32x4*)p), "v"(v) : "memory");
    else if constexpr (MODE == 3) asm volatile("global_store_dwordx4 %0, %1, off sc1 nt\n\ts_nop 1" :: "v"((u32x4*)p), "v"(v) : "memory");
    else if constexpr (MODE == 4) asm volatile("global_store_dwordx4 %0, %1, off sc0 sc1\n\ts_nop 1" :: "v"((u32x4*)p), "v"(v) : "memory");
    else if constexpr (MODE == 1) __builtin_nontemporal_store(v, (u32x4*)p);
    else *(u32x4*)p = v;
}
struct EpiQKV {
    static constexpr bool PERM = true, AFTER_DRAIN = false, PREFETCH = false;
    volatile PG8_LAS unsigned* pt; const PG8_LAS float* rt; unsigned ropemask, qmask, kmmask; float qscale;
    __device__ __forceinline__ void operator()(const f32x4 (&acc)[2][2][4][2], const Unit& u, int wr, int wc, int fr, int fq) const {
        unsigned char* ws = tab_ptr(pt, 19); bf16_t* O = (bf16_t*)(ws + XWS_QKV); const float* rope = (const float*)(ws + XWS_ROPE); float* kmp = (float*)(ws + XWS_KMP);
        const bool do_rope = (((ropemask >> u.pn) & 1u) != 0u) && ((wc & 1) == 0);
        const bool do_km = ((kmmask >> u.pn) & 1u) != 0u;
        const float sc = ((qmask >> u.pn) & 1u) ? qscale : 1.f;
        const int col0 = u.pn * BM + wc * 32 + 8 * fq;
        const float sgn = (fq == 0) ? -1.f : 1.f;
        f32x4 cs[2][2];
#pragma unroll
        for (int bj = 0; bj < 2; ++bj)
#pragma unroll
            for (int n = 0; n < 2; ++n) cs[bj][n] = (f32x4){0.f, 0.f, 0.f, 0.f};
#pragma unroll
        for (int ai = 0; ai < 2; ++ai) {
            f32x4 cc[4][2], sn[4][2];
            if (do_rope) {
#pragma unroll
                for (int m = 0; m < 4; ++m) { const f32x4* rp = (const f32x4*)(rope + (size_t)(u.pm * BM + ai * HALF + wr * 64 + m * 16 + fr) * 16);
                    cc[m][0] = rp[0]; cc[m][1] = rp[1]; sn[m][0] = rp[2]; sn[m][1] = rp[3]; }
            }
#pragma unroll
            for (int m = 0; m < 4; ++m) {
                const int rl = ai * HALF + wr * 64 + m * 16 + fr; const int row = u.pm * BM + rl;
                const float r = rt[u.idx * BM + rl];
                f32x4 v[2][2];
#pragma unroll
                for (int bj = 0; bj < 2; ++bj)
#pragma unroll
                    for (int n = 0; n < 2; ++n) v[bj][n] = acc[ai][bj][m][n] * r;
                if (do_rope) {
#pragma unroll
                    for (int bj = 0; bj < 2; ++bj)
#pragma unroll
                        for (int n = 0; n < 2; ++n)
#pragma unroll
                            for (int e = 0; e < 4; ++e) {
                                const float p = __shfl_xor(v[bj][n][e], 16);
                                const float rot = v[bj][n][e] * cc[m][n][e] + sgn * p * sn[m][n][e];
                                if (fq < 2) v[bj][n][e] = rot;
                            }
                }
                if (do_km) {
#pragma unroll
                    for (int bj = 0; bj < 2; ++bj)
#pragma unroll
                        for (int n = 0; n < 2; ++n) cs[bj][n] += v[bj][n];
                }
                bf16_t* rowp = O + (size_t)row * 3072 + col0;
#pragma unroll
                for (int bj = 0; bj < 2; ++bj) { const f32x4 v0 = v[bj][0] * sc, v1 = v[bj][1] * sc;
                    u32x4 w; w.x = cvt_pk_bf16(v0[0], v0[1]); w.y = cvt_pk_bf16(v0[2], v0[3]); w.z = cvt_pk_bf16(v1[0], v1[1]); w.w = cvt_pk_bf16(v1[2], v1[3]);
                    epi_st<EPI_QKV>(rowp + bj * HALF, w); }
            }
        }
        if (do_km) {
#pragma unroll
            for (int bj = 0; bj < 2; ++bj)
#pragma unroll
                for (int n = 0; n < 2; ++n)
#pragma unroll
                    for (int e = 0; e < 4; ++e) { float s = cs[bj][n][e]; s += __shfl_xor(s, 1); s += __shfl_xor(s, 2); s += __shfl_xor(s, 4); s += __shfl_xor(s, 8); cs[bj][n][e] = s; }
            if (fr == 0) {
                float* kp = kmp + ((size_t)wr * 128 + u.pm) * 512 + (u.pn - 8) * BM + wc * 32 + 8 * fq;
#pragma unroll
                for (int bj = 0; bj < 2; ++bj)
#pragma unroll
                    for (int n = 0; n < 2; ++n) *(f32x4*)(kp + bj * HALF + 4 * n) = cs[bj][n];
            }
        }
    }
};

template <int SCR>
struct EpiResidT {
    static constexpr bool PERM = true, AFTER_DRAIN = false, PREFETCH = (RES_PF != 0);
    volatile PG8_LAS unsigned* pt;
    __device__ __forceinline__ void prefetch(const Unit& u, int tid, int r, PG8_LAS unsigned char* junk) const {
        const unsigned char* ws = tab_ptr(pt, 19); const int li = r * 512 + tid, row = li >> 2, seg = li & 3;
        const unsigned char* p = ws + (SCR ? ((size_t)376 << 20) : XWS_HB) + ((size_t)(u.pm * BM + row) * 1024 + u.pn * BM + seg * 64) * 2;
        __builtin_amdgcn_global_load_lds((const unsigned*)p, (PG8_LAS unsigned*)junk, 4, 0, 0);
    }
    __device__ __forceinline__ void operator()(const f32x4 (&acc)[2][2][4][2], const Unit& u, int wr, int wc, int fr, int fq) const {
        unsigned char* ws = tab_ptr(pt, 19);
        bf16_t* hb = (bf16_t*)(ws + (SCR ? ((size_t)376 << 20) : XWS_HB)); float* ssp = (float*)(ws + (SCR ? ((size_t)440 << 20) : XWS_SSP));
        const int col0 = u.pn * BM + wc * 32 + 8 * fq;
        u32x4 bw[2][4][2];
#pragma unroll
        for (int ai = 0; ai < 2; ++ai)
#pragma unroll
            for (int m = 0; m < 4; ++m) {
                const size_t off = (size_t)(u.pm * BM + ai * HALF + wr * 64 + m * 16 + fr) * 1024 + col0;
#pragma unroll
                for (int bj = 0; bj < 2; ++bj) { if constexpr (SCR == 2 || SCR == 4) bw[ai][m][bj] = (u32x4){0u, 0u, 0u, 0u}; else bw[ai][m][bj] = RES_LD ? __builtin_nontemporal_load((const u32x4*)(hb + off + bj * HALF)) : *(const u32x4*)(hb + off + bj * HALF); }
            }
#pragma unroll
        for (int ai = 0; ai < 2; ++ai)
#pragma unroll
            for (int m = 0; m < 4; ++m) {
                const int row = u.pm * BM + ai * HALF + wr * 64 + m * 16 + fr; const size_t off = (size_t)row * 1024 + col0; float ss = 0.f;
#pragma unroll
                for (int bj = 0; bj < 2; ++bj) {
                    const u32x4 w0 = bw[ai][m][bj];
                    const f32x4 b0 = (f32x4){__uint_as_float(w0.x << 16), __uint_as_float(w0.x & 0xffff0000u), __uint_as_float(w0.y << 16), __uint_as_float(w0.y & 0xffff0000u)};
                    const f32x4 b1 = (f32x4){__uint_as_float(w0.z << 16), __uint_as_float(w0.z & 0xffff0000u), __uint_as_float(w0.w << 16), __uint_as_float(w0.w & 0xffff0000u)};
                    const f32x4 o0 = b0 + acc[ai][bj][m][0], o1 = b1 + acc[ai][bj][m][1];
                    ss += ((o0[0] * o0[0] + o0[1] * o0[1]) + (o0[2] * o0[2] + o0[3] * o0[3])) + ((o1[0] * o1[0] + o1[1] * o1[1]) + (o1[2] * o1[2] + o1[3] * o1[3]));
                    u32x4 w; w.x = cvt_pk_bf16(o0[0], o0[1]); w.y = cvt_pk_bf16(o0[2], o0[3]); w.z = cvt_pk_bf16(o1[0], o1[1]); w.w = cvt_pk_bf16(o1[2], o1[3]);
                    if constexpr (SCR == 3 || SCR == 4) { ss += __uint_as_float(w.x ^ w.y ^ w.z ^ w.w) * 1e-30f; } else epi_st<EPI_RES>(hb + off + bj * HALF, w);
                }
                ss += __shfl_xor(ss, 16); ss += __shfl_xor(ss, 32);
                if (fq == 0) ssp[(size_t)(u.pn * 4 + wc) * TOK + row] = ss;
            }
    }
};
typedef EpiResidT<0> EpiResid;

struct EpiSwiGLU {
    static constexpr bool PERM = true, AFTER_DRAIN = false, PREFETCH = false;
    volatile PG8_LAS unsigned* pt; const PG8_LAS float* rt;
    __device__ __forceinline__ void operator()(const f32x4 (&acc)[2][2][4][2], const Unit& u, int wr, int wc, int fr, int fq) const {
        bf16_t* O = (bf16_t*)(tab_ptr(pt, 19) + XWS_QKV);
        const int col0 = u.pn * HALF + wc * 32 + 8 * fq;
#pragma unroll
        for (int ai = 0; ai < 2; ++ai)
#pragma unroll
            for (int m = 0; m < 4; ++m) {
                const int rl = ai * HALF + wr * 64 + m * 16 + fr; const int row = u.pm * BM + rl;
                const float r = rt[u.idx * BM + rl];
                float a[8];
                typedef float f32x2_e __attribute__((ext_vector_type(2)));
                const float r2 = r * r, ncr = -1.4426950408889634f * r;
#pragma unroll
                for (int n = 0; n < 2; ++n)
#pragma unroll
                    for (int e = 0; e < 4; e += 2) { const f32x2_e g2 = {acc[ai][0][m][n][e], acc[ai][0][m][n][e + 1]}, u2 = {acc[ai][1][m][n][e], acc[ai][1][m][n][e + 1]};
                        f32x2_e p = g2 * u2; p = p * r2; const f32x2_e x = g2 * ncr;
                        f32x2_e d = {__builtin_amdgcn_exp2f(x.x), __builtin_amdgcn_exp2f(x.y)}; d = d + 1.0f;
                        const f32x2_e rc = {__builtin_amdgcn_rcpf(d.x), __builtin_amdgcn_rcpf(d.y)}; p = p * rc; a[4 * n + e] = p.x; a[4 * n + e + 1] = p.y; }
                u32x4 w; w.x = cvt_pk_bf16(a[0], a[1]); w.y = cvt_pk_bf16(a[2], a[3]); w.z = cvt_pk_bf16(a[4], a[5]); w.w = cvt_pk_bf16(a[6], a[7]);
                epi_st<EPI_UP>(O + (size_t)row * 2816 + col0, w);
            }
    }
};

template <class Epi, class Sched, bool ALIGN_EPI = false, bool SP2 = false>
__device__ __forceinline__ void gemm_phase(PG8_LAS unsigned char* lds, const Gemm g, const Sched& S, const Epi& E) {
    int tid_ = threadIdx.x; asm volatile("" : "+v"(tid_));
    const int tid = tid_, wid = __builtin_amdgcn_readfirstlane(tid >> 6), lane = tid & 63, wr = wid >> 2, wc = wid & 3, fr = lane & 15, fq = lane >> 4;
    const int K = g.K, nt = K / BK;
    unsigned voffA[2], voffB[2];
#pragma unroll
    for (int i = 0; i < 2; ++i) { int R, C; stage_rc(tid * 16 + i * 8192, R, C); const int Rb = Epi::PERM ? ((R & ~31) + perm32(R & 31)) : R;
        voffA[i] = (unsigned)(R * K + C) * 2u; voffB[i] = (unsigned)(Rb * K + C) * 2u; }
    const size_t kstep = (size_t)(BK * 2);
    const size_t hstep = (size_t)HALF * K * 2;
    const size_t tstep = 2 * hstep;
    const unsigned ldsw = (unsigned)wid * 1024u;
    const int aoff = lds_byte(wr * 64 + fr, fq * 8), boff = lds_byte(wc * 32 + fr, fq * 8);
#define PG8_SA(b, h) (((b) * 2 + (h)) * HTB)
#define PG8_SB(b, h) ((4 + (b) * 2 + (h)) * HTB)
#define PG8_STAGE(bufoff, gbase, voff) do { _Pragma("unroll") for (int _i = 0; _i < 2; ++_i) \
        __builtin_amdgcn_global_load_lds((const unsigned*)((const char*)(gbase) + (voff)[_i]), (PG8_LAS unsigned*)(lds + (bufoff) + ldsw + _i * 8192), 16, 0, ((bufoff) < 4 * HTB) ? PG8_AUX_A : PG8_AUX_B); } while (0)
#define PG8_LDA(dst, b, h) do { _Pragma("unroll") for (int m = 0; m < 4; ++m) _Pragma("unroll") for (int k = 0; k < 2; ++k) dst[m][k] = *(const PG8_LAS bf16x8*)(lds + PG8_SA(b, h) + aoff + m * 2048 + k * 1024); } while (0)
#define PG8_LDB(dst, b, h) do { _Pragma("unroll") for (int n = 0; n < 2; ++n) _Pragma("unroll") for (int k = 0; k < 2; ++k) dst[n][k] = *(const PG8_LAS bf16x8*)(lds + PG8_SB(b, h) + boff + n * 2048 + k * 1024); } while (0)
#define PG8_MMA(ai, bj, At, Bt) do { __builtin_amdgcn_s_setprio(1); _Pragma("unroll") for (int m = 0; m < 4; ++m) _Pragma("unroll") for (int n = 0; n < 2; ++n) _Pragma("unroll") for (int k = 0; k < 2; ++k) \
        acc[ai][bj][m][n] = __builtin_amdgcn_mfma_f32_16x16x32_bf16(Bt[n][k], At[m][k], acc[ai][bj][m][n], 0, 0, 0); __builtin_amdgcn_s_setprio(0); } while (0)
#define PG8_WAIT_V(n) asm volatile("s_waitcnt vmcnt(" #n ")" ::: "memory")
#define PG8_WAIT_L(n) asm volatile("s_waitcnt lgkmcnt(" #n ")" ::: "memory")
#define PG8_BAR __builtin_amdgcn_s_barrier()
#define PG8_SCHED __builtin_amdgcn_sched_barrier(0)
    Unit cur, nxt; int ui = 0;
    if (!S.next(0, cur)) return;
    f32x4 acc[2][2][4][2];
#pragma unroll
    for (int a = 0; a < 2; ++a)
#pragma unroll
        for (int b = 0; b < 2; ++b)
#pragma unroll
            for (int m = 0; m < 4; ++m)
#pragma unroll
                for (int n = 0; n < 2; ++n) acc[a][b][m][n] = (f32x4){0.f, 0.f, 0.f, 0.f};
    bf16x8 At[4][2], B0[2][2], B1[2][2];
    const char* cA = (const char*)g.A + (size_t)cur.pm * tstep; const char* cB = (const char*)g.Bt + (size_t)cur.pn * tstep;
    S.a_ready(cur);
    if constexpr (SP2) {
        PG8_STAGE(PG8_SB(0, 0), cB, voffB); PG8_STAGE(PG8_SB(0, 1), cB + hstep, voffB); PG8_STAGE(PG8_SA(0, 0), cA, voffA); PG8_STAGE(PG8_SA(0, 1), cA + hstep, voffA);
        if (wr == 1) PG8_BAR;
        PG8_WAIT_V(2); PG8_BAR;
        PG8_STAGE(PG8_SB(1, 0), cB + kstep, voffB); PG8_STAGE(PG8_SA(1, 0), cA + kstep, voffA); PG8_STAGE(PG8_SB(1, 1), cB + hstep + kstep, voffB);
        PG8_WAIT_V(6); PG8_BAR;
    } else {
        PG8_STAGE(PG8_SB(0, 0), cB, voffB); PG8_STAGE(PG8_SA(0, 0), cA, voffA); PG8_STAGE(PG8_SB(0, 1), cB + hstep, voffB); PG8_STAGE(PG8_SA(0, 1), cA + hstep, voffA);
        if (wr == 1) PG8_BAR;
        PG8_WAIT_V(4); PG8_BAR;
        PG8_STAGE(PG8_SB(1, 0), cB + kstep, voffB); PG8_STAGE(PG8_SA(1, 0), cA + kstep, voffA); PG8_STAGE(PG8_SB(1, 1), cB + hstep + kstep, voffB);
        PG8_WAIT_V(6); PG8_BAR;
    }
    for (;;) {
        const bool has_next = S.next(ui + 1, nxt);
        const char* nA = has_next ? (const char*)g.A + (size_t)nxt.pm * tstep : cA; const char* nB = has_next ? (const char*)g.Bt + (size_t)nxt.pn * tstep : cB;
        for (int t = 0; t < nt; t += 2) {
            const bool last = (t == nt - 2);
            const char* a1 = cA + (size_t)(t + 1) * kstep;
            const char* a2 = last ? nA : cA + (size_t)(t + 2) * kstep; const char* b2 = last ? nB : cB + (size_t)(t + 2) * kstep;
            const char* a3 = a2 + kstep; const char* b3 = b2 + kstep;
            if (last && has_next) S.a_ready(nxt);
            if constexpr (Epi::PREFETCH) { if (t == nt - 6 || t == nt - 4) E.prefetch(cur, tid, t == nt - 6 ? 0 : 1, lds + 131072 + wid * 256); }
            if constexpr (SP2) {
            PG8_LDB(B0, 0, 0); PG8_LDB(B1, 0, 1); PG8_SCHED; PG8_LDA(At, 0, 0); PG8_STAGE(PG8_SA(1, 1), a1 + hstep, voffA);
            PG8_WAIT_V(8); PG8_WAIT_L(0); PG8_BAR; PG8_MMA(0, 0, At, B0); PG8_MMA(0, 1, At, B1); PG8_BAR; PG8_SCHED;
            PG8_LDA(At, 0, 1); PG8_STAGE(PG8_SB(0, 0), b2, voffB); PG8_STAGE(PG8_SB(0, 1), b2 + hstep, voffB); PG8_STAGE(PG8_SA(0, 0), a2, voffA);
            PG8_WAIT_V(8); PG8_WAIT_L(0); PG8_BAR; PG8_MMA(1, 0, At, B0); PG8_MMA(1, 1, At, B1); PG8_BAR; PG8_SCHED;
            PG8_LDB(B0, 1, 0); PG8_LDB(B1, 1, 1); PG8_SCHED; PG8_LDA(At, 1, 0); PG8_STAGE(PG8_SA(0, 1), a2 + hstep, voffA);
            PG8_WAIT_V(8); PG8_WAIT_L(0); PG8_BAR; PG8_MMA(0, 0, At, B0); PG8_MMA(0, 1, At, B1); PG8_BAR; PG8_SCHED;
            PG8_LDA(At, 1, 1); PG8_STAGE(PG8_SB(1, 0), b3, voffB); PG8_STAGE(PG8_SB(1, 1), b3 + hstep, voffB); PG8_STAGE(PG8_SA(1, 0), a3, voffA);
            PG8_WAIT_V(8); PG8_WAIT_L(0); PG8_BAR; PG8_MMA(1, 0, At, B0); PG8_MMA(1, 1, At, B1); PG8_BAR; PG8_SCHED;
            } else {
            PG8_LDB(B0, 0, 0); PG8_SCHED; PG8_LDA(At, 0, 0); PG8_STAGE(PG8_SA(1, 1), a1 + hstep, voffA);
            PG8_WAIT_L(8); PG8_BAR; PG8_WAIT_L(0); PG8_MMA(0, 0, At, B0); PG8_BAR; PG8_SCHED;
            PG8_LDB(B1, 0, 1); PG8_STAGE(PG8_SB(0, 0), b2, voffB);
            PG8_BAR; PG8_WAIT_L(0); PG8_MMA(0, 1, At, B1); PG8_BAR;
            PG8_LDA(At, 0, 1); PG8_STAGE(PG8_SA(0, 0), a2, voffA);
            PG8_BAR; PG8_WAIT_L(0); PG8_MMA(1, 0, At, B0); PG8_BAR; PG8_SCHED;
            PG8_STAGE(PG8_SB(0, 1), b2 + hstep, voffB);
            PG8_WAIT_V(6); PG8_BAR; PG8_MMA(1, 1, At, B1); PG8_BAR;
            PG8_LDB(B0, 1, 0); PG8_SCHED; PG8_LDA(At, 1, 0); PG8_STAGE(PG8_SA(0, 1), a2 + hstep, voffA);
            PG8_WAIT_L(8); PG8_BAR; PG8_WAIT_L(0); PG8_MMA(0, 0, At, B0); PG8_BAR; PG8_SCHED;
            PG8_LDB(B1, 1, 1); PG8_STAGE(PG8_SB(1, 0), b3, voffB);
            PG8_BAR; PG8_WAIT_L(0); PG8_MMA(0, 1, At, B1); PG8_BAR;
            PG8_LDA(At, 1, 1); PG8_STAGE(PG8_SA(1, 0), a3, voffA);
            PG8_BAR; PG8_WAIT_L(0); PG8_MMA(1, 0, At, B0); PG8_BAR; PG8_SCHED;
            PG8_STAGE(PG8_SB(1, 1), b3 + hstep, voffB);
            PG8_WAIT_V(6); PG8_BAR; PG8_MMA(1, 1, At, B1); PG8_BAR;
            }
        }
        if constexpr (ALIGN_EPI) { if (wr == 0) PG8_BAR; }
        if constexpr (!Epi::AFTER_DRAIN) { E(acc, cur, wr, wc, fr, fq); S.done(cur); }
        if (!has_next) break;
#pragma unroll
        for (int a = 0; a < 2; ++a)
#pragma unroll
            for (int b = 0; b < 2; ++b)
#pragma unroll
                for (int m = 0; m < 4; ++m)
#pragma unroll
                    for (int n = 0; n < 2; ++n) acc[a][b][m][n] = (f32x4){0.f, 0.f, 0.f, 0.f};
        cur = nxt; cA = nA; cB = nB; ++ui;
        if constexpr (ALIGN_EPI) { if (wr == 1) PG8_BAR; }
    }
    PG8_WAIT_V(0);
    if constexpr (!ALIGN_EPI) { if (wr == 0) PG8_BAR; }
    PG8_BAR;
    if constexpr (Epi::AFTER_DRAIN) { E.fused(acc, cur, wr, wc, fr, fq, lds, wid, lane); S.done(cur); }
#undef PG8_SA
#undef PG8_SB
#undef PG8_STAGE
#undef PG8_LDA
#undef PG8_LDB
#undef PG8_MMA
#undef PG8_WAIT_V
#undef PG8_WAIT_L
#undef PG8_BAR
#undef PG8_SCHED
}
}

#ifndef PG8_SP2
#define PG8_SP2 true
#endif
#ifndef PG8_ALIGN
#define PG8_ALIGN true
#endif
#ifndef ATT_NOREF
#define ATT_NOREF 1
#endif
namespace attn_body {
constexpr bool NOREF = ATT_NOREF != 0;
using bf16=__hip_bfloat16;
using bf16x8=__attribute__((ext_vector_type(8)))short;
using s16x4=__attribute__((ext_vector_type(4)))short;
using f32x16=__attribute__((ext_vector_type(16)))float;
using f32x4=__attribute__((ext_vector_type(4)))float;
using u32x4=__attribute__((ext_vector_type(4)))unsigned;
constexpr int SEQ=2048,D=64,LDQ=3072;
constexpr int NW=8,QBLK=32,QB=QBLK*NW,KVBLK=64,NQB=SEQ/QB;
__device__ __forceinline__ int crow(int r,int hi){return (r&3)+8*(r>>2)+4*hi;}
#define SBAR() __builtin_amdgcn_sched_barrier(0)
__device__ __forceinline__ void cmask(f32x16&p0,f32x16&p1,int jb,int qrel,int hi){
  const float NEG=-INFINITY; int kb=64*jb+4*hi;
  #pragma unroll
  for(int r=0;r<16;++r){int kv=kb+(r&3)+8*(r>>2); if(kv>qrel)p0[r]=NEG; if(kv+32>qrel)p1[r]=NEG;}
}
__device__ __forceinline__ float dil_bias(int d){
  const unsigned u=(unsigned)d;
  const int c=(int)(u<=128u)+(int)((u<=512u)&&((u&3u)==0u))+(int)((d>=0)&&((u&15u)==0u));
  return c==0?-INFINITY:(c==1?0.f:(c==2?1.0f:1.5849625007211562f));
}
constexpr int DIL_LUT_OFF=144384, DIL_LUT_N=2336;
__device__ __forceinline__ void dil_hook(f32x16&p0,f32x16&p1,int dt,const char*shm){
#ifdef DIL_NO_LUT
  #pragma unroll
  for(int r=0;r<16;++r){const int d=dt-((r&3)+8*(r>>2)); p0[r]+=dil_bias(d); p1[r]+=dil_bias(d-32);}
#else
  const __attribute__((address_space(3))) float*Tl=(const __attribute__((address_space(3))) float*)(shm+DIL_LUT_OFF)+(dt+197);
  #pragma unroll
  for(int r=0;r<16;++r){const int off=(r&3)+8*(r>>2); float a0=Tl[59-off],a1=Tl[27-off],x0=p0[r],x1=p1[r],y0,y1;
    asm volatile("v_add_f32_e32 %0, %1, %2":"=v"(y0):"v"(x0),"v"(a0)); asm volatile("v_add_f32_e32 %0, %1, %2":"=v"(y1):"v"(x1),"v"(a1)); p0[r]=y0; p1[r]=y1;}
#endif
}
__device__ __forceinline__ void all_neg(f32x16&p0,f32x16&p1){
  #pragma unroll
  for(int r=0;r<16;++r){p0[r]=-INFINITY;p1[r]=-INFINITY;}
}

constexpr int NSLOT=3, SLOTB=8192;
constexpr int LDS_K=0, LDS_V=NSLOT*SLOTB, LDS_WS=2*NSLOT*SLOTB, LDS_OST=LDS_WS+NW*64*4, LDS_BYTES=LDS_OST+NW*4096;
constexpr float C2=0.125f*1.4426950408889634f;
__device__ __forceinline__ void glds16(const void*sbase,unsigned voff,unsigned lds_dst){unsigned keep;
  asm volatile("s_nop 4\n\ts_mov_b32 %0, m0\n\ts_mov_b32 m0, %3\n\ts_nop 0\n\tglobal_load_lds_dwordx4 %1, %2\n\ts_mov_b32 m0, %0":"=&s"(keep):"v"(voff),"s"(sbase),"s"(lds_dst):"memory");}
__device__ __forceinline__ float max3f(float a,float b,float c){float r;asm("v_max3_f32 %0, %1, %2, %3":"=v"(r):"v"(a),"v"(b),"v"(c));return r;}
__device__ __forceinline__ float max2f(float a,float b){float r;asm("v_max_f32_e32 %0, %1, %2":"=v"(r):"v"(a),"v"(b));return r;}
__device__ __forceinline__ float fadd_s(float a,float b){float r;asm("v_add_f32_e32 %0, %1, %2":"=v"(r):"v"(a),"v"(b));return r;}
__device__ __forceinline__ float fsub_s(float a,float b){float r;asm("v_sub_f32_e32 %0, %1, %2":"=v"(r):"v"(a),"v"(b));return r;}
typedef float f32x2_t __attribute__((ext_vector_type(2))); typedef __bf16 bf16x2_t __attribute__((ext_vector_type(2)));
__device__ __forceinline__ unsigned cvtpk_s(float lo,float hi){f32x2_t v={lo,hi};bf16x2_t b=__builtin_convertvector(v,bf16x2_t);return __builtin_bit_cast(unsigned,b);}
#define WAIT_BAR(N) asm volatile("s_waitcnt vmcnt(" #N ") lgkmcnt(0)\n\ts_barrier":::"memory")

__device__ __forceinline__ void qkt(f32x16&p0,f32x16&p1,const char*Kslot,const bf16x8*qr,int r32,int hi){
  const f32x16 negm=f32x16{};
  const char*kb=Kslot+hi*1024+r32*16;
  #pragma unroll
  for(int d0=0;d0<4;++d0){
    const bf16x8 b0=*reinterpret_cast<const bf16x8*>(kb+d0*2048);
    const bf16x8 b1=*reinterpret_cast<const bf16x8*>(kb+d0*2048+512);
    if(d0==0){p0=__builtin_amdgcn_mfma_f32_32x32x16_bf16(b0,qr[0],negm,0,0,0);p1=__builtin_amdgcn_mfma_f32_32x32x16_bf16(b1,qr[0],negm,0,0,0);}
    else{p0=__builtin_amdgcn_mfma_f32_32x32x16_bf16(b0,qr[d0],p0,0,0,0);p1=__builtin_amdgcn_mfma_f32_32x32x16_bf16(b1,qr[d0],p1,0,0,0);}}
}
typedef __attribute__((address_space(3))) const char* lds_cptr;
typedef short v4i16_t __attribute__((ext_vector_type(4)));
__device__ __forceinline__ void kload8(bf16x8*kf,lds_cptr kp){
  kf[0]=*(const __attribute__((address_space(3))) bf16x8*)(kp);      kf[1]=*(const __attribute__((address_space(3))) bf16x8*)(kp+512);
  kf[2]=*(const __attribute__((address_space(3))) bf16x8*)(kp+2048); kf[3]=*(const __attribute__((address_space(3))) bf16x8*)(kp+2560);
  kf[4]=*(const __attribute__((address_space(3))) bf16x8*)(kp+4096); kf[5]=*(const __attribute__((address_space(3))) bf16x8*)(kp+4608);
  kf[6]=*(const __attribute__((address_space(3))) bf16x8*)(kp+6144); kf[7]=*(const __attribute__((address_space(3))) bf16x8*)(kp+6656);
}
__device__ __forceinline__ void kload2(bf16x8*kf,lds_cptr kp,int j){ kf[2*j]=*(const __attribute__((address_space(3))) bf16x8*)(kp+j*2048); kf[2*j+1]=*(const __attribute__((address_space(3))) bf16x8*)(kp+j*2048+512); }
__device__ __forceinline__ s16x4 vtr(lds_cptr p){ return __builtin_bit_cast(s16x4,__builtin_amdgcn_ds_read_tr16_b64_v4i16((__attribute__((address_space(3))) v4i16_t*)p)); }
__device__ __forceinline__ float rowmax(const f32x16&p0,const f32x16&p1){
  float a=max3f(p0[0],p0[1],p1[0]),b=max3f(p0[2],p0[3],p1[1]);a=max3f(a,p1[2],p1[3]);
  #pragma unroll
  for(int r=4;r<16;r+=4){a=max3f(a,p0[r],p0[r+1]);b=max3f(b,p0[r+2],p0[r+3]);a=max3f(a,p1[r],p1[r+1]);b=max3f(b,p1[r+2],p1[r+3]);}
  const float m=max2f(a,b);
  auto rr=__builtin_amdgcn_permlane32_swap(__float_as_uint(m),__float_as_uint(m),false,false);
  return max2f(__uint_as_float(rr[0]),__uint_as_float(rr[1]));
}
__device__ __forceinline__ void pv(f32x16*o,int vb,bf16x8 pa0,bf16x8 pa1,bf16x8 pa2,bf16x8 pa3){
  #pragma unroll
  for(int d0=0;d0<2;++d0){s16x4 lo[4],hi[4];
    #pragma unroll
    for(int ks=0;ks<4;++ks){
      asm volatile("ds_read_b64_tr_b16 %0,%1 offset:%c2":"=&v"(lo[ks]):"v"(vb),"i"(d0*4096+ks*1024):"memory");
      asm volatile("ds_read_b64_tr_b16 %0,%1 offset:%c2":"=&v"(hi[ks]):"v"(vb),"i"(d0*4096+ks*1024+512):"memory");}
    asm volatile("s_waitcnt lgkmcnt(0)":::"memory");SBAR();
    #define PK(k) (bf16x8){lo[k][0],lo[k][1],lo[k][2],lo[k][3],hi[k][0],hi[k][1],hi[k][2],hi[k][3]}
    o[d0]=__builtin_amdgcn_mfma_f32_32x32x16_bf16(pa0,PK(0),o[d0],0,0,0);
    o[d0]=__builtin_amdgcn_mfma_f32_32x32x16_bf16(pa1,PK(1),o[d0],0,0,0);
    o[d0]=__builtin_amdgcn_mfma_f32_32x32x16_bf16(pa2,PK(2),o[d0],0,0,0);
    o[d0]=__builtin_amdgcn_mfma_f32_32x32x16_bf16(pa3,PK(3),o[d0],0,0,0);
    #undef PK
  }
}

#ifndef ATTN_STORE16
#ifndef ATT_ST
#define ATT_ST 1
#endif
#define ATTN_STORE16(p,v) do{ if(ATT_ST==2){ const u32x4 v__=(v); ST16_SC1((u32x4*)(p),v__); } else if(ATT_ST) __builtin_nontemporal_store((v),(u32x4*)(p)); else *(u32x4*)(p)=(v); }while(0)
#endif
constexpr int LDS_S1=83968, LDS_SSB=LDS_S1+NW*4096, LDS_DC=LDS_SSB+NW*128, ATTN_LDS_BYTES_DIFF=LDS_DC+544;
template<int MODE,int THRL,int ABL=0>
__device__ __forceinline__ void attn_unit(int qb,const bf16*__restrict__ QKVb,int qcol,int kcol,int vcol,bf16*Og,int ldo,const float*km0,char*shm,int est,int kncol,int vncol,int first,int&ring,int qncol,int qbn,bf16x8&qp0,bf16x8&qp1,bf16x8&qp2,bf16x8&qp3){
  const bf16*Qg=QKVb+qcol,*Kg=QKVb+kcol,*Vg=QKVb+vcol,*Kn=QKVb+kncol,*Vn=QKVb+vncol,*Qn=QKVb+qncol; const float*km1=km0+128*512;
  int tid_=threadIdx.x; asm volatile("":"+v"(tid_));
  #define CLOSE_BAR() do{ if constexpr((ABL&2048)!=0){ asm volatile("s_waitcnt lgkmcnt(0)\n\ts_barrier":::"memory"); } else if constexpr((ABL&32)!=0){ if(wid<4){ WBX(2); } } else { WBX(2); } }while(0)
  #define WBX(N) do{ if constexpr((ABL&8)!=0){ asm volatile("s_waitcnt vmcnt(" #N ") lgkmcnt(0)":::"memory"); } else { WAIT_BAR(N); } }while(0)
  const int tid=tid_,lane=tid&63,r32=lane&31,hi=lane>>5; const int wid=__builtin_amdgcn_readfirstlane(tid>>6);
  const int q0=qb*QB;
  const bf16*Qw=Qg+(long)(q0+wid*QBLK)*LDQ;
  const bf16*Kh=Kg,*Vh=Vg;
  const unsigned lds0=(unsigned)(uintptr_t)shm;
  float*wsf=(float*)(shm+LDS_WS)+wid*64;
  const bf16*ksrc=Kh+wid*8;
  const bf16*vsrc=Vh+(long)(16*(wid&3))*LDQ+(wid>>2)*32;
  const bf16*knsrc=Kn+wid*8; const bf16*vnsrc=Vn+(long)(16*(wid&3))*LDQ+(wid>>2)*32;
  const unsigned koff=(unsigned)lane*(LDQ*2u), voff=(unsigned)(lane>>2)*(LDQ*2u)+(unsigned)(lane&3)*16u;
  const unsigned kdst=lds0+LDS_K+wid*1024, vdst=lds0+LDS_V+wid*1024;
  #define DMA_K(t,slot) glds16(ksrc+(long)(t)*KVBLK*LDQ,koff,(unsigned)__builtin_amdgcn_readfirstlane(kdst+(slot)))
  #define DMA_V(t,slot) glds16(vsrc+(long)(t)*KVBLK*LDQ,voff,(unsigned)__builtin_amdgcn_readfirstlane(vdst+(slot)))
  #define DMA_KX(t,slot) do{ const int t_=(t); const bf16*s_=(t_<NT)?(ksrc+(long)t_*KVBLK*LDQ):(knsrc+(long)(t_-NT)*KVBLK*LDQ); glds16(s_,koff,(unsigned)__builtin_amdgcn_readfirstlane(kdst+(slot))); }while(0)
  #define DMA_VX(t,slot) do{ const int t_=(t); const bf16*s_=(t_<NT)?(vsrc+(long)t_*KVBLK*LDQ):(vnsrc+(long)(t_-NT)*KVBLK*LDQ); glds16(s_,voff,(unsigned)__builtin_amdgcn_readfirstlane(vdst+(slot))); }while(0)
  const int vb0=(int)(lds0+LDS_V)+((lane>>4)&1)*32+(lane&3)*8+(4*hi+((lane&15)>>2))*64;
  const int s0=ring, s1=(s0==(NSLOT-1)*SLOTB)?0:s0+SLOTB, s2=(s1==(NSLOT-1)*SLOTB)?0:s1+SLOTB;
  const char*Kbase=shm+LDS_K+s0; bf16x8 kf[8];
  const lds_cptr shm3=(lds_cptr)shm; const lds_cptr kp0=shm3+LDS_K+hi*1024+r32*16; const lds_cptr vp0=shm3+LDS_V+((lane>>4)&1)*32+(lane&3)*8+(4*hi+((lane&15)>>2))*64;
  const int NT=(q0+QB)/KVBLK;
  if(first){DMA_K(0,s0);DMA_V(0,s0);DMA_K(1,s1);}
  bf16x8 qr[4];
  if(first){
    #pragma unroll
    for(int d0=0;d0<4;++d0)qr[d0]=*reinterpret_cast<const bf16x8*>(&Qw[(long)r32*LDQ+d0*16+hi*8]); }
  else{
    qr[0]=qp0;qr[1]=qp1;qr[2]=qp2;qr[3]=qp3; }
  float mhat=0.f,l_reg=0.f;f32x16 o[2];o[0]=f32x16{};o[1]=f32x16{};const f32x16 zero16=f32x16{};
  const int qrel=wid*QBLK+r32;
  unsigned selmask=0u;
  if constexpr(MODE==2){
    if(qb<=3)selmask=(1u<<qb)-1u;
    else{
      float g[8];
      #pragma unroll
      for(int n=0;n<8;++n){
        if(n<qb){ float s=0.f;
          #pragma unroll
          for(int d0=0;d0<4;++d0){
            const f32x4 a0=*(const f32x4*)(km0+(long)n*512+d0*16+hi*8),a1=*(const f32x4*)(km0+(long)n*512+d0*16+hi*8+4);
            const f32x4 b0=*(const f32x4*)(km1+(long)n*512+d0*16+hi*8),b1=*(const f32x4*)(km1+(long)n*512+d0*16+hi*8+4);
            const f32x4 k0=a0+b0,k1=a1+b1;
            #pragma unroll
            for(int e=0;e<4;++e){
              const unsigned w=(unsigned)(unsigned short)qr[d0][e],w2=(unsigned)(unsigned short)qr[d0][4+e];
              s+=__uint_as_float(w<<16)*k0[e]; s+=__uint_as_float(w2<<16)*k1[e]; } }
          s+=__shfl_xor(s,32); g[n]=s; }
        else g[n]=-INFINITY; }
      #pragma unroll
      for(int n=0;n<8;++n){ int rank=0;
        #pragma unroll
        for(int m=0;m<8;++m){ if(m!=n){ rank+=(g[m]>g[n]||(g[m]==g[n]&&m<n))?1:0; } }
        if(n<qb&&rank<3)selmask|=(1u<<n); }
    }
    ((unsigned*)(shm+LDS_OST))[wid*1024+lane]=selmask;
  }
  const int dq=q0+qrel-4*hi;
  #define MHOOK(P0,P1,t) do{ if constexpr(MODE==1){ dil_hook(P0,P1,dq-64*(t),shm); } \
      else if constexpr(MODE==2){ if((t)<NT-4){ const unsigned sm_=((const unsigned*)(shm+LDS_OST))[wid*1024+lane]; if(!((sm_>>((t)>>2))&1u)) all_neg(P0,P1); } } }while(0)
  #define CMASK(P0,P1,t) do{ if constexpr(MODE!=1){ int jb_=(t)-(NT-4); if(jb_>=0)cmask(P0,P1,jb_,qrel,hi);} }while(0)
  bool resc=false;
  #define START(P0,P1) do{ resc=false; \
    if constexpr(!NOREF){ const float rm=rowmax(P0,P1); const float dl=(rm>-1e30f)?rm:0.f; mhat=fadd_s(mhat,dl); \
      _Pragma("unroll") for(int r=0;r<16;++r){P0[r]=fsub_s(P0[r],dl);P1[r]=fsub_s(P1[r],dl);} \
      } \
    _Pragma("unroll") for(int r=0;r<16;++r)P0[r]=__builtin_amdgcn_exp2f(P0[r]); }while(0)
  #define RESC() do{ if(resc){ asm volatile("s_waitcnt lgkmcnt(0)":::"memory"); \
      _Pragma("unroll") for(int d_=0;d_<2;++d_) _Pragma("unroll") for(int r=0;r<16;++r)o[d_][r]*=wsf[crow(r,hi)]; } }while(0)
  f32x16 pA0,pA1,pB0,pB1;
  int sl_prev=s0,sl_cur=s0,sl_next=s1;
  #define ROT() do{sl_prev=sl_cur;sl_cur=sl_next;sl_next=(sl_next==(NSLOT-1)*SLOTB)?0:sl_next+SLOTB;}while(0)
  if(first){DMA_K(2,s2);}
  WBX(3);
  qkt(pA0,pA1,Kbase,qr,r32,hi);asm volatile("s_nop 15\n\ts_nop 7":"+v"(pA0),"+v"(pA1));CMASK(pA0,pA1,0);MHOOK(pA0,pA1,0);
  START(pA0,pA1);
  _Pragma("unroll") for(int r=0;r<16;++r)pA1[r]=__builtin_amdgcn_exp2f(pA1[r]);
  WBX(0);
  DMA_K(3,s0);DMA_V(1,s1);
  ROT();
  kload8(kf,kp0+sl_cur);
  WBX(2);
  s16x4 vlo[8],vhi[8]; u32x4 pw0,pw1,pw2,pw3;
  if constexpr((ABL&16)!=0){ _Pragma("unroll") for(int i_=0;i_<8;++i_){vlo[i_]=s16x4{};vhi[i_]=s16x4{};} }
  if constexpr((ABL&4)!=0){ pA0=f32x16{};pA1=f32x16{};pB0=f32x16{};pB1=f32x16{}; }
  if constexpr((ABL&512)!=0){ pw0=u32x4{};pw1=u32x4{};pw2=u32x4{};pw3=u32x4{}; }
  #define PKW(P,B) cvtpk_s(P[B],P[B+1])
  #define PAF(k) __builtin_bit_cast(bf16x8,pw##k)
  #define VFR(i) (bf16x8){vlo[i][0],vlo[i][1],vlo[i][2],vlo[i][3],vhi[i][0],vhi[i][1],vhi[i][2],vhi[i][3]}
  #define PIN(x) asm volatile("":"+v"(x))
  #define MX3(a,b,c) __builtin_fmaxf(__builtin_fmaxf((a),(b)),(c))
  #define GAPA(MF,A0,A1,A2,A3,W0,W1,PW) do{ if constexpr((ABL&4)==0){ MF; } if constexpr((ABL&512)==0){ sacc+=A0; sacc+=A1; sacc+=A2; sacc+=A3; PIN(sacc); W0; W1; PIN(PW); } if constexpr((ABL&1024)!=0){ rmx_=MX3(rmx_,A0,A1); rmx_=MX3(rmx_,A2,A3); PIN(rmx_); } SBAR(); }while(0)
  #define EX(v) (((ABL&1)!=0)?(v):__builtin_amdgcn_exp2f(v))
  #define GAPB(MF,X,B) do{ if constexpr((ABL&2)==0){ MF; } if constexpr((ABL&1024)!=0){ X[B]=fsub_s(X[B],mhat);X[B+1]=fsub_s(X[B+1],mhat);X[B+2]=fsub_s(X[B+2],mhat);X[B+3]=fsub_s(X[B+3],mhat); } X[B]=EX(X[B]); X[B+1]=EX(X[B+1]); X[B+2]=EX(X[B+2]); X[B+3]=EX(X[B+3]); PIN(X); SBAR(); }while(0)
  #define VRD(i) do{ if constexpr((ABL&16)!=0) break; vlo[i]=vtr(vp_+(((i)>>2)*4096+((i)&3)*1024)); vhi[i]=vtr(vp_+(((i)>>2)*4096+((i)&3)*1024+512)); }while(0)
  #define KRD(G,j) do{ if constexpr((ABL&128)==0){ if(G){ kload2(kf,kp0+sl_next,j); SBAR(); } } }while(0)
  #define STEP(C0,C1,P0,P1,t,GL) do{ SBAR(); \
    const lds_cptr vp_=vp0+sl_prev; \
    VRD(0); SBAR(); float sacc=(P0[0]+P0[1]); float rmx_=0.f; \
    GAPA(C0=__builtin_amdgcn_mfma_f32_32x32x16_bf16(kf[0],qr[0],zero16,0,0,0), P0[2],P0[3],P0[4],P0[5],     pw0[0]=PKW(P0,0), pw0[1]=PKW(P0,2), pw0); \
    VRD(4); SBAR(); GAPA(C1=__builtin_amdgcn_mfma_f32_32x32x16_bf16(kf[1],qr[0],zero16,0,0,0), P0[6],P0[7],P0[8],P0[9],     pw0[2]=PKW(P0,4), pw0[3]=PKW(P0,6), pw0); \
    VRD(1); SBAR(); GAPA(C0=__builtin_amdgcn_mfma_f32_32x32x16_bf16(kf[2],qr[1],C0,0,0,0),   P0[10],P0[11],P0[12],P0[13], pw1[0]=PKW(P0,8), pw1[1]=PKW(P0,10), pw1); \
    VRD(5); SBAR(); GAPA(C1=__builtin_amdgcn_mfma_f32_32x32x16_bf16(kf[3],qr[1],C1,0,0,0),   P0[14],P0[15],P1[0],P1[1],   pw1[2]=PKW(P0,12),pw1[3]=PKW(P0,14), pw1); \
    VRD(2); SBAR(); GAPA(C0=__builtin_amdgcn_mfma_f32_32x32x16_bf16(kf[4],qr[2],C0,0,0,0),   P1[2],P1[3],P1[4],P1[5],     pw2[0]=PKW(P1,0), pw2[1]=PKW(P1,2), pw2); \
    VRD(6); SBAR(); GAPA(C1=__builtin_amdgcn_mfma_f32_32x32x16_bf16(kf[5],qr[2],C1,0,0,0),   P1[6],P1[7],P1[8],P1[9],     pw2[2]=PKW(P1,4), pw2[3]=PKW(P1,6), pw2); \
    VRD(3); SBAR(); GAPA(C0=__builtin_amdgcn_mfma_f32_32x32x16_bf16(kf[6],qr[3],C0,0,0,0),   P1[10],P1[11],P1[12],P1[13], pw3[0]=PKW(P1,8), pw3[1]=PKW(P1,10), pw3); \
    VRD(7); SBAR(); GAPA(C1=__builtin_amdgcn_mfma_f32_32x32x16_bf16(kf[7],qr[3],C1,0,0,0),   P1[14],P1[15],0.f,0.f,       pw3[2]=PKW(P1,12),pw3[3]=PKW(P1,14), pw3); \
    l_reg+=sacc; if constexpr((ABL&1024)!=0){ asm volatile(""::"v"(rmx_)); } \
    if constexpr((ABL&64)==0){ STEP_DMA(t); } \
    if constexpr((ABL&32)!=0){ if(wid>=4){ WAIT_BAR(2); } } \
    if constexpr(NOREF){ if constexpr(MODE==1){ asm volatile("s_nop 7\n\ts_nop 7":"+v"(C0),"+v"(C1)); } CMASKX(C0,C1,t); MHOOK(C0,C1,t); resc=false; } else \
    if constexpr((ABL&256)==0){ \
    asm volatile("s_nop 7\n\ts_nop 7":"+v"(C0),"+v"(C1)); \
    _Pragma("unroll") for(int r=0;r<16;++r){C0[r]=fsub_s(C0[r],mhat);C1[r]=fsub_s(C1[r],mhat);} \
    CMASKX(C0,C1,t); MHOOK(C0,C1,t); \
    { float a=MX3(C0[0],C0[1],C1[0]),b=MX3(C0[2],C0[3],C1[1]); a=MX3(a,C1[2],C1[3]); \
      _Pragma("unroll") for(int r=4;r<16;r+=4){a=MX3(a,C0[r],C0[r+1]);b=MX3(b,C0[r+2],C0[r+3]);a=MX3(a,C1[r],C1[r+1]);b=MX3(b,C1[r+2],C1[r+3]);} \
      float rm=__builtin_fmaxf(a,b); { auto rr=__builtin_amdgcn_permlane32_swap(__float_as_uint(rm),__float_as_uint(rm),false,false); rm=__builtin_fmaxf(__uint_as_float(rr[0]),__uint_as_float(rr[1])); } \
      resc=false; \
      if(__builtin_expect(__any(rm>(float)THRL),0)){ const float dl=__builtin_fmaxf(rm,0.f); mhat+=dl; \
        _Pragma("unroll") for(int r=0;r<16;++r){C0[r]-=dl;C1[r]-=dl;} \
        const float f=__builtin_amdgcn_exp2f(-dl); l_reg*=f; if(hi==0)wsf[r32]=f; resc=true; } } \
    } else { resc=false; } \
    SBAR(); \
    GAPB(o[0]=__builtin_amdgcn_mfma_f32_32x32x16_bf16(PAF(0),VFR(0),o[0],0,0,0), C0,0); \
    GAPB(o[1]=__builtin_amdgcn_mfma_f32_32x32x16_bf16(PAF(0),VFR(4),o[1],0,0,0), C0,4); \
    KRD(GL,0); GAPB(o[0]=__builtin_amdgcn_mfma_f32_32x32x16_bf16(PAF(1),VFR(1),o[0],0,0,0), C0,8); \
    KRD(GL,1); GAPB(o[1]=__builtin_amdgcn_mfma_f32_32x32x16_bf16(PAF(1),VFR(5),o[1],0,0,0), C0,12); \
    KRD(GL,2); GAPB(o[0]=__builtin_amdgcn_mfma_f32_32x32x16_bf16(PAF(2),VFR(2),o[0],0,0,0), C1,0); \
    KRD(GL,3); GAPB(o[1]=__builtin_amdgcn_mfma_f32_32x32x16_bf16(PAF(2),VFR(6),o[1],0,0,0), C1,4); \
    GAPB(o[0]=__builtin_amdgcn_mfma_f32_32x32x16_bf16(PAF(3),VFR(3),o[0],0,0,0), C1,8); \
    GAPB(o[1]=__builtin_amdgcn_mfma_f32_32x32x16_bf16(PAF(3),VFR(7),o[1],0,0,0), C1,12); \
    }while(0)
  int t=1;
  #define CMASKX(P0,P1,t) do{}while(0)
  #define STEP_DMA(t) DMA_K((t)+3,sl_cur); DMA_V((t)+1,sl_next)
  for(;t+5<NT;t+=2){
    STEP(pB0,pB1,pA0,pA1,t,true);     CLOSE_BAR(); RESC(); ROT();
    STEP(pA0,pA1,pB0,pB1,t+1,true);   CLOSE_BAR(); RESC(); ROT();
  }
  #undef STEP_DMA
  #define STEP_DMA(t) DMA_KX((t)+3,sl_cur); DMA_VX((t)+1,sl_next)
  #undef CMASKX
  #define CMASKX(P0,P1,t) CMASK(P0,P1,t)
  for(;t+1<NT;t+=2){
    STEP(pB0,pB1,pA0,pA1,t,(t+1<NT));       CLOSE_BAR(); RESC(); ROT();
    STEP(pA0,pA1,pB0,pB1,t+1,(t+2<NT));     CLOSE_BAR(); RESC(); ROT();
  }
  STEP(pB0,pB1,pA0,pA1,NT-1,false); CLOSE_BAR(); RESC();
  ring=sl_next;
  #undef STEP_DMA
  { float sacc=pB0[0]+pB0[1]; _Pragma("unroll") for(int r=2;r<16;++r)sacc+=pB0[r]; _Pragma("unroll") for(int r=0;r<16;++r)sacc+=pB1[r]; l_reg+=sacc;
    pw0=(u32x4){PKW(pB0,0),PKW(pB0,2),PKW(pB0,4),PKW(pB0,6)};pw1=(u32x4){PKW(pB0,8),PKW(pB0,10),PKW(pB0,12),PKW(pB0,14)};pw2=(u32x4){PKW(pB1,0),PKW(pB1,2),PKW(pB1,4),PKW(pB1,6)};pw3=(u32x4){PKW(pB1,8),PKW(pB1,10),PKW(pB1,12),PKW(pB1,14)};
    SBAR(); pv(o,vb0+sl_cur,PAF(0),PAF(1),PAF(2),PAF(3)); }
  #undef PKW
  #undef PAF
  #undef VFR
  #undef PIN
  #undef MX3
  #undef GAPA
  #undef GAPB
  #undef EX
  #undef VRD
  #undef KRD
  #undef STEP
  #undef CMASKX
  { const bf16*Qnw=Qn+(long)(qbn*QB+wid*QBLK)*LDQ;
    qp0=*reinterpret_cast<const bf16x8*>(&Qnw[(long)r32*LDQ+0*16+hi*8]); qp1=*reinterpret_cast<const bf16x8*>(&Qnw[(long)r32*LDQ+1*16+hi*8]);
    qp2=*reinterpret_cast<const bf16x8*>(&Qnw[(long)r32*LDQ+2*16+hi*8]); qp3=*reinterpret_cast<const bf16x8*>(&Qnw[(long)r32*LDQ+3*16+hi*8]); }
  {auto rr=__builtin_amdgcn_permlane32_swap(__float_as_uint(l_reg),__float_as_uint(l_reg),false,false);l_reg=__uint_as_float(rr[0])+__uint_as_float(rr[1]);}
  if(hi==0)wsf[32+r32]=l_reg;asm volatile("s_waitcnt lgkmcnt(0)":::"memory");
  float rli[16];
  #pragma unroll
  for(int r=0;r<16;++r)rli[r]=__builtin_amdgcn_rcpf(wsf[32+crow(r,hi)]);
  bf16*Ow=Og+(long)(q0+wid*QBLK)*ldo;
  if(est==0){ bf16*stg=(bf16*)(shm+LDS_OST)+wid*2048;
    #pragma unroll
    for(int r=0;r<16;++r){const int orow=crow(r,hi);
      #pragma unroll
      for(int d0=0;d0<2;++d0)stg[orow*64+d0*32+r32]=__float2bfloat16(o[d0][r]*rli[r]);}
    asm volatile("s_waitcnt lgkmcnt(0)":::"memory");
    #pragma unroll
    for(int i=0;i<4;++i){const int row=i*8+(lane>>3),ch=lane&7; const u32x4 v=*(const u32x4*)(stg+row*64+ch*8); ATTN_STORE16(Ow+(long)row*ldo+ch*8,v);} }
  else if(est==1){ bf16*s1=(bf16*)(shm+LDS_S1)+wid*2048;
    #pragma unroll
    for(int r=0;r<16;++r){const int orow=crow(r,hi);
      #pragma unroll
      for(int d0=0;d0<2;++d0)s1[orow*64+d0*32+r32]=__float2bfloat16(o[d0][r]*rli[r]);} }
  else{ bf16*s1=(bf16*)(shm+LDS_S1)+wid*2048; bf16*stg=(bf16*)(shm+LDS_OST)+wid*2048; bf16*dst=(est==2)?stg:s1;
    const float*dc=(const float*)(shm+LDS_DC); float*ssb=(float*)(shm+LDS_SSB)+wid*32; const float lam=dc[128];
    #pragma unroll
    for(int r=0;r<16;++r){const int orow=crow(r,hi);
      #pragma unroll
      for(int d0=0;d0<2;++d0){const int idx=orow*64+d0*32+r32; const float o1=__bfloat162float(s1[idx]); dst[idx]=__float2bfloat16(o1-lam*(o[d0][r]*rli[r]));}}
    asm volatile("s_waitcnt lgkmcnt(0)":::"memory");
    const int ch=lane&7;
    #pragma unroll
    for(int i=0;i<4;++i){const int row=i*8+(lane>>3); const u32x4 v=*(const u32x4*)(dst+row*64+ch*8);
      float dv[8];
      #pragma unroll
      for(int e=0;e<4;++e){dv[2*e]=__uint_as_float(v[e]<<16);dv[2*e+1]=__uint_as_float(v[e]&0xffff0000u);}
      float ss=0.f;
      #pragma unroll
      for(int e=0;e<8;++e)ss+=dv[e]*dv[e];
      ss+=__shfl_xor(ss,1);ss+=__shfl_xor(ss,2);ss+=__shfl_xor(ss,4);
      if(est==2){ if(ch==0)ssb[row]=ss; }
      else{ const float rs=1.0f/sqrtf((ss+ssb[row])*(1.0f/128.0f)+1e-5f);
        const u32x4 v0=*(const u32x4*)(stg+row*64+ch*8);
        const f32x4 g0a=*(const f32x4*)(dc+ch*8),g0b=*(const f32x4*)(dc+ch*8+4),g1a=*(const f32x4*)(dc+64+ch*8),g1b=*(const f32x4*)(dc+64+ch*8+4);
        u32x4 w0,w1;
        #pragma unroll
        for(int e=0;e<4;++e){ const float ga=(e<2)?g0a[2*e]:g0b[2*e-4], gb=(e<2)?g0a[2*e+1]:g0b[2*e-3], ha=(e<2)?g1a[2*e]:g1b[2*e-4], hb=(e<2)?g1a[2*e+1]:g1b[2*e-3];
          w0[e]=cvtpk_s(__uint_as_float(v0[e]<<16)*rs*ga,__uint_as_float(v0[e]&0xffff0000u)*rs*gb);
          w1[e]=cvtpk_s(dv[2*e]*rs*ha,dv[2*e+1]*rs*hb); }
        ATTN_STORE16(Ow+(long)row*ldo+ch*8,w0); ATTN_STORE16(Ow+(long)row*ldo+64+ch*8,w1); } } }
  asm volatile("s_waitcnt lgkmcnt(0)\n\ts_barrier":::"memory");
  #undef DMA_K
  #undef DMA_V
  #undef DMA_KX
  #undef DMA_VX
  #undef CMASK
  #undef MHOOK
  #undef START
  #undef RESC
  #undef ROT
  #undef WBX
  #undef CLOSE_BAR
}
constexpr int V_SLOTB=16384;
constexpr int X_K=0, X_V=NSLOT*SLOTB, X_WS=X_V+NSLOT*V_SLOTB, X_ST=X_WS+NW*256, X_DC=X_ST+NW*8192, X_BYTES=X_DC+544;
__device__ __forceinline__ void pv128(f32x16*o,int vb,bf16x8 pa0,bf16x8 pa1,bf16x8 pa2,bf16x8 pa3){
  #pragma unroll
  for(int d0=0;d0<4;++d0){s16x4 lo[4],hi[4];
    #pragma unroll
    for(int ks=0;ks<4;++ks){
      asm volatile("ds_read_b64_tr_b16 %0,%1 offset:%c2":"=&v"(lo[ks]):"v"(vb),"i"(d0*4096+ks*1024):"memory");
      asm volatile("ds_read_b64_tr_b16 %0,%1 offset:%c2":"=&v"(hi[ks]):"v"(vb),"i"(d0*4096+ks*1024+512):"memory");}
    asm volatile("s_waitcnt lgkmcnt(0)":::"memory");SBAR();
    #define PK(k) (bf16x8){lo[k][0],lo[k][1],lo[k][2],lo[k][3],hi[k][0],hi[k][1],hi[k][2],hi[k][3]}
    o[d0]=__builtin_amdgcn_mfma_f32_32x32x16_bf16(pa0,PK(0),o[d0],0,0,0);
    o[d0]=__builtin_amdgcn_mfma_f32_32x32x16_bf16(pa1,PK(1),o[d0],0,0,0);
    o[d0]=__builtin_amdgcn_mfma_f32_32x32x16_bf16(pa2,PK(2),o[d0],0,0,0);
    o[d0]=__builtin_amdgcn_mfma_f32_32x32x16_bf16(pa3,PK(3),o[d0],0,0,0);
    #undef PK
  }
}
template<int THRL> __device__ __forceinline__ void attn_unit_dv128(int qb,const bf16*__restrict__ QKVb,int qcol,int kcol,int vcol,bf16*Og,int ldo,char*shm,int est,int kncol,int first,int&ring,int qncol,int qbn,bf16x8&qp0,bf16x8&qp1,bf16x8&qp2,bf16x8&qp3){
  const bf16*Qg=QKVb+qcol,*Kg=QKVb+kcol,*Vg=QKVb+vcol,*Kn=QKVb+kncol,*Qn=QKVb+qncol;
  int tid_=threadIdx.x; asm volatile("":"+v"(tid_));
  const int tid=tid_,lane=tid&63,r32=lane&31,hi=lane>>5; const int wid=__builtin_amdgcn_readfirstlane(tid>>6);
  const int q0=qb*QB;
  const bf16*Qw=Qg+(long)(q0+wid*QBLK)*LDQ;
  const unsigned lds0=(unsigned)(uintptr_t)shm;
  float*wsf=(float*)(shm+X_WS)+wid*64;
  const bf16*ksrc=Kg+wid*8, *knsrc=Kn+wid*8;
  const bf16*vsrc=Vg+(long)(16*(wid&3))*LDQ+(wid>>2)*32;
  const unsigned koff=(unsigned)lane*(LDQ*2u), voff=(unsigned)(lane>>2)*(LDQ*2u)+(unsigned)(lane&3)*16u;
  const unsigned kdst=lds0+X_K+wid*1024, vdst=lds0+X_V+wid*1024;
  const int NT=(q0+QB)/KVBLK;
  #define DMA_K(t,slot) glds16(ksrc+(long)(t)*KVBLK*LDQ,koff,(unsigned)__builtin_amdgcn_readfirstlane(kdst+(slot)))
  #define DMA_V(t,vslot) do{ const bf16*s_=vsrc+(long)(t)*KVBLK*LDQ; glds16(s_,voff,(unsigned)__builtin_amdgcn_readfirstlane(vdst+(vslot))); glds16(s_+64,voff,(unsigned)__builtin_amdgcn_readfirstlane(vdst+(vslot)+8192)); }while(0)
  #define DMA_KX(t,slot) do{ const int t_=(t); const bf16*s_=(t_<NT)?(ksrc+(long)t_*KVBLK*LDQ):(knsrc+(long)(t_-NT)*KVBLK*LDQ); glds16(s_,koff,(unsigned)__builtin_amdgcn_readfirstlane(kdst+(slot))); }while(0)
  #define DMA_VX(t,vslot) do{ const int t_=(t); DMA_V((t_<NT)?t_:(t_-NT),vslot); }while(0)
  const int vb0=(int)(lds0+X_V)+((lane>>4)&1)*32+(lane&3)*8+(4*hi+((lane&15)>>2))*64;
  const int s0=ring, s1=(s0==(NSLOT-1)*SLOTB)?0:s0+SLOTB, s2=(s1==(NSLOT-1)*SLOTB)?0:s1+SLOTB;
  const char*Kbase=shm+X_K+s0; bf16x8 kf[8];
  const lds_cptr shm3=(lds_cptr)shm; const lds_cptr kp0=shm3+X_K+hi*1024+r32*16; const lds_cptr vp0=shm3+X_V+((lane>>4)&1)*32+(lane&3)*8+(4*hi+((lane&15)>>2))*64;
  if(first){DMA_K(0,s0);DMA_V(0,2*s0);DMA_K(1,s1);}
  bf16x8 qr[4];
  if(first){
    #pragma unroll
    for(int d0=0;d0<4;++d0)qr[d0]=*reinterpret_cast<const bf16x8*>(&Qw[(long)r32*LDQ+d0*16+hi*8]); }
  else{ qr[0]=qp0;qr[1]=qp1;qr[2]=qp2;qr[3]=qp3; }
  float mhat=0.f,l_reg=0.f;f32x16 o[4];o[0]=f32x16{};o[1]=f32x16{};o[2]=f32x16{};o[3]=f32x16{};const f32x16 zero16=f32x16{};
  const int qrel=wid*QBLK+r32;
  #define CMASK(P0,P1,t) do{ int jb_=(t)-(NT-4); if(jb_>=0)cmask(P0,P1,jb_,qrel,hi); }while(0)
  bool resc=false;
  #define RESC() do{ if(resc){ asm volatile("s_waitcnt lgkmcnt(0)":::"memory"); \
      _Pragma("unroll") for(int d_=0;d_<4;++d_) _Pragma("unroll") for(int r=0;r<16;++r)o[d_][r]*=wsf[crow(r,hi)]; } }while(0)
  f32x16 c0,c1; u32x4 pw0,pw1,pw2,pw3;
  int sl_prev=s0,sl_cur=s0,sl_next=s1;
  #define ROT() do{sl_prev=sl_cur;sl_cur=sl_next;sl_next=(sl_next==(NSLOT-1)*SLOTB)?0:sl_next+SLOTB;}while(0)
  if(first){DMA_K(2,s2);}
  WAIT_BAR(4);
  #define PKW(P,B) cvtpk_s(P[B],P[B+1])
  qkt(c0,c1,Kbase,qr,r32,hi);asm volatile("s_nop 15\n\ts_nop 7":"+v"(c0),"+v"(c1));CMASK(c0,c1,0);
  { float dl=0.f; if constexpr(!NOREF){ const float rm=rowmax(c0,c1); dl=(rm>-1e30f)?rm:0.f; } mhat=dl;
    #pragma unroll
    for(int r=0;r<16;++r){c0[r]=__builtin_amdgcn_exp2f(c0[r]-dl);c1[r]=__builtin_amdgcn_exp2f(c1[r]-dl);}
    float sa=0.f,sb=0.f;
    #pragma unroll
    for(int r=0;r<16;++r){sa+=c0[r];sb+=c1[r];}
    l_reg=sa+sb;
    pw0=(u32x4){PKW(c0,0),PKW(c0,2),PKW(c0,4),PKW(c0,6)};pw1=(u32x4){PKW(c0,8),PKW(c0,10),PKW(c0,12),PKW(c0,14)};pw2=(u32x4){PKW(c1,0),PKW(c1,2),PKW(c1,4),PKW(c1,6)};pw3=(u32x4){PKW(c1,8),PKW(c1,10),PKW(c1,12),PKW(c1,14)}; }
  WAIT_BAR(0);
  DMA_K(3,s0);DMA_V(1,2*s1);
  ROT();
  kload8(kf,kp0+sl_cur);
  WAIT_BAR(3);
  s16x4 vlo[4],vhi[4];
  #define PAF(k) __builtin_bit_cast(bf16x8,pw##k)
  #define VFR(i) (bf16x8){vlo[i][0],vlo[i][1],vlo[i][2],vlo[i][3],vhi[i][0],vhi[i][1],vhi[i][2],vhi[i][3]}
  #define PIN(x) asm volatile("":"+v"(x))
  #define MX3(a,b,c) __builtin_fmaxf(__builtin_fmaxf((a),(b)),(c))
  #define EX(v) __builtin_amdgcn_exp2f(v)
  #define VRDX(s,KS) do{ vlo[s]=vtr(vp_+((s)*4096+(KS)*1024)); vhi[s]=vtr(vp_+((s)*4096+(KS)*1024+512)); }while(0)
  #define QKA(MF) do{ MF; SBAR(); }while(0)
  #define GAPX(MF,X,B,RF) do{ MF; RF; X[B]=EX(X[B]); X[B+1]=EX(X[B+1]); sacc+=X[B]; sacc+=X[B+1]; PIN(sacc); PIN(X); SBAR(); }while(0)
  #define PACKW(PW,W,X,B) do{ PW[W]=PKW(X,B); PIN(PW); }while(0)
  #define KRD(G,j) do{ if(G){ kload2(kf,kp0+sl_next,j); SBAR(); } }while(0)
  #define STEP(t,GL) do{ SBAR(); \
    const lds_cptr vp_=vp0+2*sl_prev; \
    VRDX(0,0); SBAR(); QKA(c0=__builtin_amdgcn_mfma_f32_32x32x16_bf16(kf[0],qr[0],zero16,0,0,0)); \
    QKA(c1=__builtin_amdgcn_mfma_f32_32x32x16_bf16(kf[1],qr[0],zero16,0,0,0)); \
    VRDX(1,0); SBAR(); QKA(c0=__builtin_amdgcn_mfma_f32_32x32x16_bf16(kf[2],qr[1],c0,0,0,0)); \
    QKA(c1=__builtin_amdgcn_mfma_f32_32x32x16_bf16(kf[3],qr[1],c1,0,0,0)); \
    VRDX(2,0); SBAR(); QKA(c0=__builtin_amdgcn_mfma_f32_32x32x16_bf16(kf[4],qr[2],c0,0,0,0)); \
    QKA(c1=__builtin_amdgcn_mfma_f32_32x32x16_bf16(kf[5],qr[2],c1,0,0,0)); \
    VRDX(3,0); SBAR(); QKA(c0=__builtin_amdgcn_mfma_f32_32x32x16_bf16(kf[6],qr[3],c0,0,0,0)); \
    QKA(c1=__builtin_amdgcn_mfma_f32_32x32x16_bf16(kf[7],qr[3],c1,0,0,0)); \
    STEP_DMA(t); \
    if constexpr(NOREF){ CMASKX(c0,c1,t); resc=false; } else { \
    asm volatile("s_nop 7\n\ts_nop 7":"+v"(c0),"+v"(c1)); \
    _Pragma("unroll") for(int r=0;r<16;++r){c0[r]=fsub_s(c0[r],mhat);c1[r]=fsub_s(c1[r],mhat);} \
    CMASKX(c0,c1,t); \
    { float a=MX3(c0[0],c0[1],c1[0]),b=MX3(c0[2],c0[3],c1[1]); a=MX3(a,c1[2],c1[3]); \
      _Pragma("unroll") for(int r=4;r<16;r+=4){a=MX3(a,c0[r],c0[r+1]);b=MX3(b,c0[r+2],c0[r+3]);a=MX3(a,c1[r],c1[r+1]);b=MX3(b,c1[r+2],c1[r+3]);} \
      float rm=__builtin_fmaxf(a,b); { auto rr=__builtin_amdgcn_permlane32_swap(__float_as_uint(rm),__float_as_uint(rm),false,false); rm=__builtin_fmaxf(__uint_as_float(rr[0]),__uint_as_float(rr[1])); } \
      resc=false; \
      if(__builtin_expect(__any(rm>(float)THRL),0)){ const float dl=__builtin_fmaxf(rm,0.f); mhat+=dl; \
        _Pragma("unroll") for(int r=0;r<16;++r){c0[r]-=dl;c1[r]-=dl;} \
        const float f=__builtin_amdgcn_exp2f(-dl); l_reg*=f; if(hi==0)wsf[r32]=f; resc=true; } } \
    } \
    SBAR(); float sacc=0.f; \
    GAPX(o[0]=__builtin_amdgcn_mfma_f32_32x32x16_bf16(PAF(0),VFR(0),o[0],0,0,0), c0,0,  VRDX(0,1)); \
    GAPX(o[1]=__builtin_amdgcn_mfma_f32_32x32x16_bf16(PAF(0),VFR(1),o[1],0,0,0), c0,2,  VRDX(1,1)); \
    GAPX(o[2]=__builtin_amdgcn_mfma_f32_32x32x16_bf16(PAF(0),VFR(2),o[2],0,0,0), c0,4,  VRDX(2,1)); \
    GAPX(o[3]=__builtin_amdgcn_mfma_f32_32x32x16_bf16(PAF(0),VFR(3),o[3],0,0,0), c0,6,  VRDX(3,1)); \
    GAPX(o[0]=__builtin_amdgcn_mfma_f32_32x32x16_bf16(PAF(1),VFR(0),o[0],0,0,0), c0,8,  VRDX(0,2)); PACKW(pw0,0,c0,0); SBAR(); \
    GAPX(o[1]=__builtin_amdgcn_mfma_f32_32x32x16_bf16(PAF(1),VFR(1),o[1],0,0,0), c0,10, VRDX(1,2)); PACKW(pw0,1,c0,2); SBAR(); \
    GAPX(o[2]=__builtin_amdgcn_mfma_f32_32x32x16_bf16(PAF(1),VFR(2),o[2],0,0,0), c0,12, VRDX(2,2)); PACKW(pw0,2,c0,4); SBAR(); \
    GAPX(o[3]=__builtin_amdgcn_mfma_f32_32x32x16_bf16(PAF(1),VFR(3),o[3],0,0,0), c0,14, VRDX(3,2)); PACKW(pw0,3,c0,6); SBAR(); \
    KRD(GL,0); GAPX(o[0]=__builtin_amdgcn_mfma_f32_32x32x16_bf16(PAF(2),VFR(0),o[0],0,0,0), c1,0,  VRDX(0,3)); PACKW(pw1,0,c0,8);  SBAR(); \
    KRD(GL,1); GAPX(o[1]=__builtin_amdgcn_mfma_f32_32x32x16_bf16(PAF(2),VFR(1),o[1],0,0,0), c1,2,  VRDX(1,3)); PACKW(pw1,1,c0,10); SBAR(); \
    KRD(GL,2); GAPX(o[2]=__builtin_amdgcn_mfma_f32_32x32x16_bf16(PAF(2),VFR(2),o[2],0,0,0), c1,4,  VRDX(2,3)); PACKW(pw1,2,c0,12); SBAR(); \
    KRD(GL,3); GAPX(o[3]=__builtin_amdgcn_mfma_f32_32x32x16_bf16(PAF(2),VFR(3),o[3],0,0,0), c1,6,  VRDX(3,3)); PACKW(pw1,3,c0,14); SBAR(); \
    GAPX(o[0]=__builtin_amdgcn_mfma_f32_32x32x16_bf16(PAF(3),VFR(0),o[0],0,0,0), c1,8,  (void)0); PACKW(pw2,0,c1,0); SBAR(); \
    GAPX(o[1]=__builtin_amdgcn_mfma_f32_32x32x16_bf16(PAF(3),VFR(1),o[1],0,0,0), c1,10, (void)0); PACKW(pw2,1,c1,2); SBAR(); \
    GAPX(o[2]=__builtin_amdgcn_mfma_f32_32x32x16_bf16(PAF(3),VFR(2),o[2],0,0,0), c1,12, (void)0); PACKW(pw2,2,c1,4); SBAR(); \
    GAPX(o[3]=__builtin_amdgcn_mfma_f32_32x32x16_bf16(PAF(3),VFR(3),o[3],0,0,0), c1,14, (void)0); PACKW(pw2,3,c1,6); SBAR(); \
    PACKW(pw3,0,c1,8); PACKW(pw3,1,c1,10); PACKW(pw3,2,c1,12); PACKW(pw3,3,c1,14); \
    l_reg+=sacc; \
    }while(0)
  int t=1;
  #define CMASKX(P0,P1,t) do{}while(0)
  #define STEP_DMA(t) DMA_K((t)+3,sl_cur); DMA_V((t)+1,2*sl_next)
  for(;t+5<NT;t+=2){
    STEP(t,true);     WAIT_BAR(3); RESC(); ROT();
    STEP(t+1,true);   WAIT_BAR(3); RESC(); ROT();
  }
  #undef CMASKX
  #undef STEP_DMA
  #define CMASKX(P0,P1,t) CMASK(P0,P1,t)
  #define STEP_DMA(t) DMA_KX((t)+3,sl_cur); DMA_VX((t)+1,2*sl_next)
  for(;t+1<NT;t+=2){
    STEP(t,(t+1<NT));       WAIT_BAR(3); RESC(); ROT();
    STEP(t+1,(t+2<NT));     WAIT_BAR(3); RESC(); ROT();
  }
  STEP(NT-1,false); WAIT_BAR(3); RESC();
  ring=sl_next;
  #undef STEP_DMA
  #undef CMASKX
  SBAR(); pv128(o,vb0+2*sl_cur,PAF(0),PAF(1),PAF(2),PAF(3));
  #undef PKW
  #undef PAF
  #undef PACKW
  #undef VFR
  #undef PIN
  #undef MX3
  #undef EX
  #undef VRDX
  #undef QKA
  #undef GAPX
  #undef KRD
  #undef STEP
  { const bf16*Qnw=Qn+(long)(qbn*QB+wid*QBLK)*LDQ;
    qp0=*reinterpret_cast<const bf16x8*>(&Qnw[(long)r32*LDQ+0*16+hi*8]); qp1=*reinterpret_cast<const bf16x8*>(&Qnw[(long)r32*LDQ+1*16+hi*8]);
    qp2=*reinterpret_cast<const bf16x8*>(&Qnw[(long)r32*LDQ+2*16+hi*8]); qp3=*reinterpret_cast<const bf16x8*>(&Qnw[(long)r32*LDQ+3*16+hi*8]); }
  {auto rr=__builtin_amdgcn_permlane32_swap(__float_as_uint(l_reg),__float_as_uint(l_reg),false,false);l_reg=__uint_as_float(rr[0])+__uint_as_float(rr[1]);}
  if(hi==0)wsf[32+r32]=l_reg;asm volatile("s_waitcnt lgkmcnt(0)":::"memory");
  float rli[16];
  #pragma unroll
  for(int r=0;r<16;++r)rli[r]=__builtin_amdgcn_rcpf(wsf[32+crow(r,hi)]);
  bf16*st=(bf16*)(shm+X_ST)+wid*4096;
  if(est==1){
    #pragma unroll
    for(int r=0;r<16;++r){const int orow=crow(r,hi);
      #pragma unroll
      for(int d0=0;d0<4;++d0)st[orow*128+d0*32+r32]=__float2bfloat16(o[d0][r]*rli[r]);} }
  else{ const float*dc=(const float*)(shm+X_DC); const float lam=dc[128];
    #pragma unroll
    for(int r=0;r<16;++r){const int orow=crow(r,hi);
      #pragma unroll
      for(int d0=0;d0<4;++d0){const int idx=orow*128+d0*32+r32; const float o1=__bfloat162float(st[idx]); st[idx]=__float2bfloat16(o1-lam*(o[d0][r]*rli[r]));}}
    asm volatile("s_waitcnt lgkmcnt(0)":::"memory");
    bf16*Ow=Og+(long)(q0+wid*QBLK)*ldo; const int ch=lane&15;
    const f32x4 ga=*(const f32x4*)(dc+ch*8),gb=*(const f32x4*)(dc+ch*8+4);
    #pragma unroll
    for(int i=0;i<8;++i){const int row=i*4+(lane>>4); const u32x4 v=*(const u32x4*)(st+row*128+ch*8);
      float dv[8];
      #pragma unroll
      for(int e=0;e<4;++e){dv[2*e]=__uint_as_float(v[e]<<16);dv[2*e+1]=__uint_as_float(v[e]&0xffff0000u);}
      float ss=0.f;
      #pragma unroll
      for(int e=0;e<8;++e)ss+=dv[e]*dv[e];
      ss+=__shfl_xor(ss,1);ss+=__shfl_xor(ss,2);ss+=__shfl_xor(ss,4);ss+=__shfl_xor(ss,8);
      const float rs=1.0f/sqrtf(ss*(1.0f/128.0f)+1e-5f);
      u32x4 w; w[0]=cvtpk_s(dv[0]*rs*ga[0],dv[1]*rs*ga[1]); w[1]=cvtpk_s(dv[2]*rs*ga[2],dv[3]*rs*ga[3]); w[2]=cvtpk_s(dv[4]*rs*gb[0],dv[5]*rs*gb[1]); w[3]=cvtpk_s(dv[6]*rs*gb[2],dv[7]*rs*gb[3]);
      ATTN_STORE16(Ow+(long)row*ldo+ch*8,w); } }
  asm volatile("s_waitcnt lgkmcnt(0)\n\ts_barrier":::"memory");
  #undef DMA_K
  #undef DMA_V
  #undef DMA_KX
  #undef DMA_VX
  #undef CMASK
  #undef RESC
  #undef ROT
}
constexpr int ATTN_LDS_BYTES=LDS_BYTES;
#undef SBAR
#undef WAIT_BAR
}
#ifndef ATT_A_MODE
#define ATT_A_MODE 1
#endif
#ifndef ATT_B_MODE
#define ATT_B_MODE 2
#endif
#ifndef ATT_THRL
#define ATT_THRL 8
#endif

constexpr int NWAVES = 8;
constexpr int BATCH = 16, T = 2048, D = 1024, HD = 64, FF = 2816, NQKV = 3072;
constexpr int M = BATCH * T;
constexpr float NORM_EPS = 1e-5f;
constexpr float LAMBDA_INIT = 0.35550906759096934f;
static_assert(M == pg8::TOK, "row count");

constexpr size_t MiB = 1u << 20;
constexpr size_t WS_CTL = 0, CTL_ZERO_BYTES = 1 * MiB;
constexpr size_t WS_ROPE = 1 * MiB;
constexpr size_t WS_SSP = 3 * MiB;
constexpr size_t WS_KMP = 5 * MiB;
constexpr size_t WS_W = 6 * MiB, W_LAYER = 25 * MiB;
constexpr size_t W_IN = 0, W_OUT = 6 * MiB, W_GU = 8 * MiB, W_DN = 19 * MiB;
constexpr size_t WS_HB = 56 * MiB;
constexpr size_t WS_OB = 120 * MiB;
constexpr size_t WS_QKV = 184 * MiB;
constexpr size_t WS_OS = 376 * MiB;
constexpr size_t WS_END = 504 * MiB;
static_assert(WS_ROPE == pg8::XWS_ROPE && WS_SSP == pg8::XWS_SSP && WS_KMP == pg8::XWS_KMP && WS_HB == pg8::XWS_HB && WS_QKV == pg8::XWS_QKV, "d_ws map vs epilogues");
constexpr int CW_BAR = 4096;
constexpr int RING_OFF = 0, RING_BYTES = 131072;
constexpr int LDSCTL_OFF = 143360, MISC_OFF = LDSCTL_OFF + 320;
constexpr int PTAB_OFF = LDSCTL_OFF + 512;
constexpr int RTAB_OFF = LDSCTL_OFF + 1024;
constexpr int LDS_BYTES = 163840;
static_assert(attn_body::X_BYTES <= LDSCTL_OFF && attn_body::DIL_LUT_OFF == RTAB_OFF && attn_body::DIL_LUT_OFF + 4 * attn_body::DIL_LUT_N <= LDS_BYTES && attn_body::ATTN_LDS_BYTES_DIFF <= RING_BYTES && RTAB_OFF + 11 * 1024 <= LDS_BYTES && MISC_OFF + 128 <= PTAB_OFF && PTAB_OFF + 160 <= RTAB_OFF, "LDS map");

#define GAS __attribute__((address_space(1)))
#define LAS __attribute__((address_space(3)))
typedef unsigned short bf16;
typedef unsigned v4u __attribute__((ext_vector_type(4)));
typedef unsigned v2u __attribute__((ext_vector_type(2)));
typedef float f32x4 __attribute__((ext_vector_type(4)));
typedef GAS unsigned gu32;
#define RLX_AGENT __ATOMIC_RELAXED, __HIP_MEMORY_SCOPE_AGENT
#define LDS_WAIT() asm volatile("s_waitcnt lgkmcnt(0)" ::: "memory")
#define VM_WAIT() asm volatile("s_waitcnt vmcnt(0)" ::: "memory")
__device__ __forceinline__ unsigned f2bf(float f) { unsigned u = __builtin_bit_cast(unsigned, f); return (u + 0x7fffu + ((u >> 16) & 1u)) >> 16; }
__device__ __forceinline__ unsigned pk2(float lo, float hi) { return f2bf(lo) | (f2bf(hi) << 16); }
__device__ __forceinline__ float bf_lo(unsigned w) { return __uint_as_float(w << 16); }
__device__ __forceinline__ float bf_hi(unsigned w) { return __uint_as_float(w & 0xffff0000u); }

#define XB_TMO      128
#define XB_XCNT(j)  (256  + 64 * (j))
#define XB_XSUB(j)  (1280 + 64 * (j))
#define XB_XGEN(j)  (2304 + 64 * (j))
#define XB_TOP      3328
#define XB_TOPGEN   3392
#define XCD_BAR_WORDS 3456
#define XB_SPIN_CAP (1u << 18)

__device__ __forceinline__ unsigned xb_ld(unsigned* p)              { return __hip_atomic_load(p, __ATOMIC_RELAXED, __HIP_MEMORY_SCOPE_AGENT); }
__device__ __forceinline__ unsigned xb_add(unsigned* p, unsigned v) { return __hip_atomic_fetch_add(p, v, __ATOMIC_RELAXED, __HIP_MEMORY_SCOPE_AGENT); }
__device__ __forceinline__ unsigned xb_xcc_id() { return (unsigned)__builtin_amdgcn_s_getreg((3 << 11) | 20) & 0xFu; }
#define XB_SPIN(cond, bar) do { unsigned _sp = 0; while (cond) { __builtin_amdgcn_s_sleep(1); \
    if ((++_sp & 255u) == 0u) { if (xb_ld(&(bar)[XB_TMO])) break; if (_sp > XB_SPIN_CAP) { atomicAdd(&(bar)[XB_TMO], 1u); break; } } } } while (0)

struct XcdBarrier {
    unsigned* bar; unsigned x;
    volatile LAS unsigned* st;
};

__device__ __forceinline__ XcdBarrier xcd_barrier_post(unsigned* bar, volatile LAS unsigned* st) {
    XcdBarrier b; b.bar = bar; b.x = xb_xcc_id(); b.st = st;
    if (threadIdx.x == 0) (void)xb_add(&bar[XB_XCNT(b.x)], 1u);
    return b;
}
__device__ __forceinline__ void xcd_barrier_complete(unsigned* bar, unsigned x, unsigned& nloc, unsigned& nx) {
    const unsigned G = gridDim.x * gridDim.y * gridDim.z;
    unsigned sum, cnt, mine, sp = 0u;
    for (;;) {
        sum = 0u; cnt = 0u; mine = 0u;
#pragma unroll
        for (unsigned j = 0; j < 16; ++j) { const unsigned c = xb_ld(&bar[XB_XCNT(j)]); sum += c; cnt += (c > 0u) ? 1u : 0u; mine = (j == x) ? c : mine; }
        if (sum == G) break;
        __builtin_amdgcn_s_sleep(1);
        if ((++sp & 255u) == 0u) { if (xb_ld(&bar[XB_TMO])) break; if (sp > XB_SPIN_CAP) { atomicAdd(&bar[XB_TMO], 1u); break; } }
    }
    nloc = mine > 0u ? mine : 1u; nx = cnt > 0u ? cnt : 1u;
}

__device__ __forceinline__ void xcd_barrier(const XcdBarrier& b) {
    asm volatile("s_waitcnt vmcnt(0)" ::: "memory");
    __syncthreads();
    if (threadIdx.x == 0) {
        unsigned* bar = b.bar;
        __builtin_amdgcn_s_waitcnt(0);
        unsigned nloc = b.st[0], nx = b.st[1];
        if (nloc == 0u) { xcd_barrier_complete(bar, b.x, nloc, nx); b.st[0] = nloc; b.st[1] = nx; }
        const unsigned old = xb_add(&bar[XB_XSUB(b.x)], 1u);
        const unsigned gen = old / nloc;
        if (old + 1u == (gen + 1u) * nloc) {
            __builtin_amdgcn_fence(__ATOMIC_RELEASE, "agent");
            asm volatile("s_waitcnt vmcnt(0)" ::: "memory");
            const unsigned og = xb_add(&bar[XB_TOP], 1u);
            const unsigned tg = og / nx;
            if (og + 1u == (tg + 1u) * nx) xb_add(&bar[XB_TOPGEN], 1u);
            else XB_SPIN(xb_ld(&bar[XB_TOPGEN]) == tg, bar);
            __builtin_amdgcn_fence(__ATOMIC_ACQUIRE, "agent");
            xb_add(&bar[XB_XGEN(b.x)], 1u);
            asm volatile("s_waitcnt vmcnt(0)" ::: "memory");
        } else {
            XB_SPIN(xb_ld(&bar[XB_XGEN(b.x)]) == gen, bar);
            __builtin_amdgcn_fence(__ATOMIC_ACQUIRE, "agent");
            asm volatile("s_waitcnt vmcnt(0)" ::: "memory");
        }
    }
    __syncthreads();
}


struct Frame {
    LAS unsigned char* lds;
    volatile LAS unsigned* MISC;
    gu32* ctl;
    int tid, lane, wave;
    int vcu, G, bx;
};
#ifndef FIN_ST
#define FIN_ST 1
#endif
#ifndef P0_ST
#define P0_ST 0
#endif
__device__ __forceinline__ float wave_sum(float v) {
#pragma unroll
    for (int o = 1; o < 64; o <<= 1) v += __shfl_xor(v, o);
    return v;
}
__device__ __forceinline__ void p0_transpose_item(const float* W, const float* g, int K, int N, bf16* WT, int mode, LAS float* scr, int item, int lane) {
    const int nblk = N / 32, kb = item / nblk, nb = item % nblk, k0 = 64 * kb, n0 = 32 * nb;
    const int orow = (mode == 0) ? n0 : (256 * (n0 >> 7) + (n0 & 127) + (mode == 2 ? 128 : 0));
    f32x4 w[8];
#pragma unroll
    for (int i = 0; i < 8; ++i) w[i] = MEM_NT ? __builtin_nontemporal_load((const GAS f32x4*)(W + (size_t)(k0 + 8 * i + (lane >> 3)) * N + n0 + 4 * (lane & 7))) : *(const GAS f32x4*)(W + (size_t)(k0 + 8 * i + (lane >> 3)) * N + n0 + 4 * (lane & 7));
    if (g) {
#pragma unroll
        for (int i = 0; i < 8; ++i) w[i] = w[i] * g[k0 + 8 * i + (lane >> 3)];
    }
#pragma unroll
    for (int i = 0; i < 8; ++i) { LAS float* d = scr + (8 * i + (lane >> 3)) * 33 + 4 * (lane & 7); d[0] = w[i].x; d[1] = w[i].y; d[2] = w[i].z; d[3] = w[i].w; }
    LDS_WAIT(); asm volatile("" ::: "memory");
    const int c = lane & 7;
#pragma unroll
    for (int j = 0; j < 4; ++j) { const int n = (lane >> 3) + 8 * j; const LAS float* s = scr + (8 * c) * 33 + n;
        v4u o; o.x = pk2(s[0 * 33], s[1 * 33]); o.y = pk2(s[2 * 33], s[3 * 33]); o.z = pk2(s[4 * 33], s[5 * 33]); o.w = pk2(s[6 * 33], s[7 * 33]);
        if (P0_ST == 2) ST16_SC1((GAS v4u*)(WT + (size_t)(orow + n) * K + k0 + 8 * c), o); else *(GAS v4u*)(WT + (size_t)(orow + n) * K + k0 + 8 * c) = o; }
    LDS_WAIT(); asm volatile("" ::: "memory");
}

struct Args { const void* in[18]; float* out; unsigned char* ws; };

template <class Sched> __device__ __forceinline__ void prep_rtab(Frame& F, const Sched& S, const float* ssp, int nparts) {
    LAS float* rt = (LAS float*)(F.lds + RTAB_OFF);
    pg8::Unit u;
    for (int i = 0; S.next(i, u); ++i) {
        if ((i & 1) == (F.tid >> 8)) {
            const int rl = F.tid & 255; const int row = u.pm * 256 + rl; float s = 0.f;
            for (int j = 0; j < nparts; ++j) s += ssp[(size_t)j * M + row];
            rt[i * 256 + rl] = 1.0f / sqrtf(s * (1.0f / D) + NORM_EPS);
        }
    }
    LDS_WAIT(); __syncthreads();
}


__device__ __forceinline__ unsigned char* get_ptr(volatile LAS unsigned* t, int k) {
    { unsigned a_ = (unsigned)(uintptr_t)t; asm volatile("" : "+v"(a_)); t = (volatile LAS unsigned*)a_; }
    const unsigned lo = (unsigned)__builtin_amdgcn_readfirstlane((int)t[2 * k]), hi = (unsigned)__builtin_amdgcn_readfirstlane((int)t[2 * k + 1]);
    unsigned long long v = (unsigned long long)lo | ((unsigned long long)hi << 32); asm volatile("" : "+s"(v)); return (unsigned char*)(GAS unsigned char*)v; }
#define PTAB ((volatile LAS unsigned*)((LAS unsigned char*)lds + PTAB_OFF))
#define IN_PTR(T, k) ((T*)get_ptr(PTAB, (k)))
#define OUT_PTR() ((float*)get_ptr(PTAB, 18))
#define WS_BASE() (get_ptr(PTAB, 19))
#define WS_PTR(T, off) ((T*)(WS_BASE() + (off)))
__device__ __forceinline__ int vcu_of(int bx, int G) { return (G % 8 == 0) ? (bx % 8) * (G / 8) + bx / 8 : bx; }
#define GRID_BAR() do { XcdBarrier b_; b_.bar = WS_PTR(unsigned, WS_CTL) + CW_BAR; b_.x = xb_xcc_id(); b_.st = (volatile LAS unsigned*)((LAS unsigned char*)lds + MISC_OFF) + 8; xcd_barrier(b_); } while (0)
__device__ __forceinline__ int opq_s(int v) { asm volatile("" : "+s"(v)); return v; }
__device__ __forceinline__ int opq_v(int v) { asm volatile("" : "+v"(v)); return v; }
#define MK_FRAME() Frame F; F.lds = (LAS unsigned char*)lds; F.MISC = (volatile LAS unsigned*)(F.lds + MISC_OFF); F.ctl = nullptr; F.tid = opq_v(threadIdx.x); F.lane = F.tid & 63; \
    F.wave = __builtin_amdgcn_readfirstlane(F.tid >> 6); F.G = opq_s(gridDim.x); F.bx = opq_s(blockIdx.x); F.vcu = vcu_of(F.bx, F.G)


#ifndef REP_P0
#define REP_P0 1
#endif
#ifndef REP_QKV
#define REP_QKV 1
#endif
#ifndef REP_ATTN0
#define REP_ATTN0 1
#endif
#ifndef REP_ATTN1
#define REP_ATTN1 1
#endif
#ifndef REP_COMB
#define REP_COMB 1
#endif
#ifndef REP_OUT0
#define REP_OUT0 1
#endif
#ifndef REP_UP
#define REP_UP 1
#endif
#define REPEAT(n) for (int rep_ = 0; rep_ < opq_s(n); ++rep_)
__global__ void __launch_bounds__(NWAVES * 64, 2) mk_fwd(Args args) {
    extern __shared__ __attribute__((aligned(16))) unsigned char lds[];
    for (int u = threadIdx.x; u < (LDS_BYTES - LDSCTL_OFF) / 4; u += NWAVES * 64) ((LAS unsigned*)((LAS unsigned char*)lds + LDSCTL_OFF))[u] = 0u;
    __syncthreads();
    if (threadIdx.x < 20) { const unsigned long long v = threadIdx.x < 18 ? (unsigned long long)args.in[threadIdx.x < 18 ? threadIdx.x : 0] : (threadIdx.x == 18 ? (unsigned long long)args.out : (unsigned long long)args.ws);
        PTAB[2 * threadIdx.x] = (unsigned)v; PTAB[2 * threadIdx.x + 1] = (unsigned)(v >> 32); }
    LDS_WAIT(); __syncthreads();
    (void)xcd_barrier_post(WS_PTR(unsigned, WS_CTL) + CW_BAR, (volatile LAS unsigned*)((LAS unsigned char*)lds + MISC_OFF) + 8);

#ifndef SKIP_P0
    REPEAT(REP_P0) {
        MK_FRAME();
        unsigned char* ws = WS_BASE();
        const int gw = F.vcu * NWAVES + F.wave, NGW = F.G * NWAVES;
        LAS float* scr = (LAS float*)(F.lds + RING_OFF + F.wave * 16384);
        constexpr int I_IN = (D / 64) * (NQKV / 32), I_OUT = (D / 64) * (D / 32), I_G = (D / 64) * (FF / 32), I_D = (FF / 64) * (D / 32);
        constexpr int I_LAYER = I_IN + I_OUT + 2 * I_G + I_D, NITEMS = 2 * I_LAYER;
        for (int it = gw; it < NITEMS; it += NGW) {
            const int L = it / I_LAYER; int r = it % I_LAYER;
            unsigned char* wl = ws + WS_W + (size_t)L * W_LAYER;
            const float* ffn_g = IN_PTR(const float, 13) + (size_t)L * D;
            if (r < I_IN) { p0_transpose_item(IN_PTR(const float, L ? 6 : 3), IN_PTR(const float, L ? 5 : 2), D, NQKV, (bf16*)(wl + W_IN), 0, scr, r, F.lane); continue; } r -= I_IN;
            if (r < I_OUT) { p0_transpose_item(IN_PTR(const float, L ? 7 : 4), nullptr, D, D, (bf16*)(wl + W_OUT), 0, scr, r, F.lane); continue; } r -= I_OUT;
            if (r < I_G) { p0_transpose_item(IN_PTR(const float, 14) + (size_t)L * D * FF, ffn_g, D, FF, (bf16*)(wl + W_GU), 1, scr, r, F.lane); continue; } r -= I_G;
            if (r < I_G) { p0_transpose_item(IN_PTR(const float, 15) + (size_t)L * D * FF, ffn_g, D, FF, (bf16*)(wl + W_GU), 2, scr, r, F.lane); continue; } r -= I_G;
            p0_transpose_item(IN_PTR(const float, 16) + (size_t)L * FF * D, nullptr, FF, D, (bf16*)(wl + W_DN), 0, scr, r, F.lane);
        }
        const float* x = IN_PTR(const float, 0);
        bf16* HB = (bf16*)(ws + WS_HB); float* ssp = (float*)(ws + WS_SSP);
        for (int m0 = gw; m0 < M; m0 += 2 * NGW) {
            f32x4 v[2][4];
#pragma unroll
            for (int q = 0; q < 2; ++q) { const int mq = (m0 + q * NGW < M) ? m0 + q * NGW : m0; const GAS f32x4* xr = (const GAS f32x4*)(x + (size_t)mq * D) + F.lane;
#pragma unroll
                for (int j = 0; j < 4; ++j) v[q][j] = MEM_NT ? __builtin_nontemporal_load(xr + 64 * j) : xr[64 * j]; }
#pragma unroll
            for (int q = 0; q < 2; ++q) { const int m = (m0 + q * NGW < M) ? m0 + q * NGW : m0; float s = 0.f;
#pragma unroll
                for (int j = 0; j < 4; ++j) s += (v[q][j].x * v[q][j].x + v[q][j].y * v[q][j].y) + (v[q][j].z * v[q][j].z + v[q][j].w * v[q][j].w);
                s = wave_sum(s);
                GAS unsigned long long* o8 = (GAS unsigned long long*)(HB + (size_t)m * D) + F.lane;
#pragma unroll
                for (int j = 0; j < 4; ++j) { const unsigned long long pv = (unsigned long long)pk2(v[q][j].x, v[q][j].y) | ((unsigned long long)pk2(v[q][j].z, v[q][j].w) << 32); if (P0_ST == 2) ST8_SC1(o8 + 64 * j, pv); else if (P0_ST == 1) __builtin_nontemporal_store(pv, o8 + 64 * j); else o8[64 * j] = pv; }
                if (F.lane == 0) ssp[m] = s; }
        }
        const int* pos = IN_PTR(const int, 1); float* rope = (float*)(ws + WS_ROPE);
        for (int idx = gw * 64 + F.lane; idx < M * 8; idx += NGW * 64) {
            const int row = idx >> 3, i = idx & 7;
            const float invf = i == 0 ? 1.0f : i == 1 ? 0.1939227432012558f : i == 2 ? 0.03760603070259094f : i == 3 ? 0.007292664609849453f :
                               i == 4 ? 0.0014142135623842478f : i == 5 ? 0.00027424818836152554f : i == 6 ? 5.3182957344688475e-05f : 1.0313385246263351e-05f;
            const float ang = (float)pos[row] * invf;
            float sn, cs; sincosf(ang, &sn, &cs);
            rope[(size_t)row * 16 + i] = cs; rope[(size_t)row * 16 + 8 + i] = sn;
        }
    }
#endif
    GRID_BAR();

#pragma unroll 1
    for (int L = 0; L < 2; ++L) {
#ifndef SKIP_QKV
        REPEAT(REP_QKV) {
            MK_FRAME();
            unsigned char* ws = WS_BASE();
            pg8::Gemm g{(const bf16*)(ws + WS_HB), (const bf16*)(ws + WS_W + (size_t)L * W_LAYER + W_IN), M, NQKV, D}; pg8::StaticOrder S; S.init(M, NQKV, F.G, F.bx);
            prep_rtab(F, S, (const float*)(ws + WS_SSP), L == 0 ? 1 : 16);
            pg8::EpiQKV E{PTAB, (const LAS float*)(F.lds + RTAB_OFF), L == 0 ? 0x3CFu : 0xFFu, L == 0 ? 0xC3u : 0x0Fu, L == 0 ? 0x300u : 0u, attn_body::C2};
            pg8::gemm_phase<pg8::EpiQKV, pg8::StaticOrder, PG8_ALIGN, PG8_SP2>(F.lds + RING_OFF, g, S, E);
        }
#endif
        GRID_BAR();
        if (L == 0) {
#ifndef SKIP_ATTN0
            const int G = opq_s(gridDim.x);
            {
                LAS float* lut = (LAS float*)((LAS unsigned char*)lds + RING_OFF + attn_body::DIL_LUT_OFF);
#pragma clang loop vectorize(disable) unroll(disable)
                for (int i = opq_v(threadIdx.x); i < attn_body::DIL_LUT_N; i += NWAVES * 64) ((volatile LAS float*)lut)[i] = attn_body::dil_bias(opq_v(i) - 256);
                LDS_WAIT(); __syncthreads();
            }
            REPEAT(REP_ATTN0) for (int it = vcu_of(opq_s(blockIdx.x), G); it < 256; it += G) {
                const int p = it >> 1, par = it & 1, b = p >> 3, hh = p & 7;
                int ring = 0, first = 1;
                attn_body::bf16x8 qp0 = {}, qp1 = {}, qp2 = {}, qp3 = {};
#pragma unroll 1
                for (int k = 0; k < 4; ++k) {
                    const int qb = par == 0 ? (k == 0 ? 7 : k == 1 ? 4 : k == 2 ? 3 : 0) : (k == 0 ? 6 : k == 1 ? 5 : k == 2 ? 2 : 1);
                    const int k1 = k < 3 ? k + 1 : 3, qb1 = par == 0 ? (k1 == 0 ? 7 : k1 == 1 ? 4 : k1 == 2 ? 3 : 0) : (k1 == 0 ? 6 : k1 == 1 ? 5 : k1 == 2 ? 2 : 1);
                    {
                        const attn_body::bf16* qkvb = WS_PTR(const attn_body::bf16, WS_QKV) + (size_t)b * T * NQKV + 64 * hh;
                        attn_body::bf16* ob = WS_PTR(attn_body::bf16, WS_OB) + (size_t)b * T * D + 64 * hh;
                        attn_body::attn_unit<ATT_A_MODE, ATT_THRL>(qb, qkvb, 0, 512, 1024, ob, D, nullptr, (char*)lds + RING_OFF, 0, 2048, 2560, first, ring, 1536, qb, qp0, qp1, qp2, qp3);
                        first = 0;
                    }
                    {
                        const attn_body::bf16* qkvb = WS_PTR(const attn_body::bf16, WS_QKV) + (size_t)b * T * NQKV + 64 * hh;
                        attn_body::bf16* ob = WS_PTR(attn_body::bf16, WS_OB) + (size_t)b * T * D + 64 * hh;
                        const float* km0 = WS_PTR(const float, WS_KMP) + (size_t)(b * 8) * 512 + 64 * hh;
                        attn_body::attn_unit<ATT_B_MODE, ATT_THRL>(qb, qkvb, 1536, 2048, 2560, ob + 512, D, km0, (char*)lds + RING_OFF, 0, 512, 1024, 0, ring, 0, qb1, qp0, qp1, qp2, qp3);
                    }
                }
                VM_WAIT(); __syncthreads();
            }
#ifdef XABL
            for (int it = vcu_of(opq_s(blockIdx.x), G); it < 256; it += G) {
                const int p = it >> 1, b = p >> 3, hh = p & 7;
                int ring = 0; attn_body::bf16x8 qp0 = {}, qp1 = {}, qp2 = {}, qp3 = {};
#pragma unroll 1
                for (int k = 0; k < 8; ++k) {
                    const attn_body::bf16* qkvb = WS_PTR(const attn_body::bf16, WS_QKV) + (size_t)b * T * NQKV + 64 * hh;
                    attn_body::bf16* osb = WS_PTR(attn_body::bf16, WS_OS) + (size_t)b * T * 2048 + 64 * hh;
                    attn_body::attn_unit<0, 8, XABL>(7, qkvb, 0, 512, 1024, osb, 2048, nullptr, (char*)lds + RING_OFF, 0, 512, 1024, k == 0 ? 1 : 0, ring, 0, 7, qp0, qp1, qp2, qp3);
                }
                VM_WAIT(); __syncthreads();
            }
#endif
#endif
        } else {
#ifndef SKIP_ATTN1
            const int G = opq_s(gridDim.x);
            {
                LAS float* dc = (LAS float*)((LAS unsigned char*)lds + RING_OFF + attn_body::X_DC);
                const int tid = opq_v(threadIdx.x);
                if (tid < 128) dc[tid] = IN_PTR(const float, 12)[tid] * (1.0f - LAMBDA_INIT);
                if (tid < 64) {
                    const float s1 = wave_sum(IN_PTR(const float, 8)[tid] * IN_PTR(const float, 9)[tid]), s2 = wave_sum(IN_PTR(const float, 10)[tid] * IN_PTR(const float, 11)[tid]);
                    if (tid == 0) dc[128] = expf(s1) - expf(s2) + LAMBDA_INIT;
                }
                LDS_WAIT(); __syncthreads();
            }
            REPEAT(REP_ATTN1) for (int it = vcu_of(opq_s(blockIdx.x), G); it < 256; it += G) {
                const int p = it >> 1, par = it & 1, b = p >> 3, h = p & 7;
                int ring = 0; attn_body::bf16x8 qp0 = {}, qp1 = {}, qp2 = {}, qp3 = {};
#pragma unroll 1
                for (int k = 0; k < 8; ++k) {
                    const int kq = k >> 1, i = k & 1, in_ = (k + 1) & 1;
                    const int qb = par == 0 ? (kq == 0 ? 7 : kq == 1 ? 4 : kq == 2 ? 3 : 0) : (kq == 0 ? 6 : kq == 1 ? 5 : kq == 2 ? 2 : 1);
                    const int kqn = (k < 7 ? k + 1 : 7) >> 1, qbn = par == 0 ? (kqn == 0 ? 7 : kqn == 1 ? 4 : kqn == 2 ? 3 : 0) : (kqn == 0 ? 6 : kqn == 1 ? 5 : kqn == 2 ? 2 : 1);
                    const attn_body::bf16* qkvb = WS_PTR(const attn_body::bf16, WS_QKV) + (size_t)b * T * NQKV;
                    attn_body::bf16* ob = WS_PTR(attn_body::bf16, WS_OB) + (size_t)b * T * D + 128 * h;
                    attn_body::attn_unit_dv128<ATT_THRL>(qb, qkvb, 64 * (2 * h + i), 1024 + 64 * (2 * h + i), 2048 + 128 * h, ob, D, (char*)lds + RING_OFF, i == 0 ? 1 : 3,
                                                  1024 + 64 * (2 * h + in_), k == 0 ? 1 : 0, ring, 64 * (2 * h + in_), qbn, qp0, qp1, qp2, qp3);
                }
                VM_WAIT(); __syncthreads();
            }
#endif
        }
        GRID_BAR();
#ifndef SKIP_OUT
        {
            MK_FRAME();
            unsigned char* ws = WS_BASE();
            pg8::Gemm g{(const bf16*)(ws + WS_OB), (const bf16*)(ws + WS_W + (size_t)L * W_LAYER + W_OUT), M, D, D}; pg8::StaticOrder S; S.init(M, D, F.G, F.bx);
            pg8::EpiResid E{PTAB};
            pg8::gemm_phase<pg8::EpiResid, pg8::StaticOrder, PG8_ALIGN, PG8_SP2>(F.lds + RING_OFF, g, S, E);
        }
#endif
#ifndef XEPI
#define XEPI 1
#endif
#ifdef XOUT
        for (int xr = 0; xr < opq_s(XOUT); ++xr) {
            GRID_BAR();
            MK_FRAME();
            unsigned char* ws = WS_BASE();
            pg8::Gemm g{(const bf16*)(ws + WS_OB), (const bf16*)(ws + WS_W + (size_t)L * W_LAYER + W_OUT), M, D, D}; pg8::StaticOrder S; S.init(M, D, F.G, F.bx);
            pg8::EpiResidT<XEPI> E{PTAB};
            pg8::gemm_phase<pg8::EpiResidT<XEPI>, pg8::StaticOrder, PG8_ALIGN, PG8_SP2>(F.lds + RING_OFF, g, S, E);
        }
#endif
#ifndef XCLK_SRC
#define XCLK_SRC WS_HB
#endif
#ifdef XCLK
        {
            MK_FRAME();
            unsigned char* ws = WS_BASE();
            attn_body::bf16x8 xa = *(const GAS attn_body::bf16x8*)(ws + XCLK_SRC + (size_t)F.tid * 16), xb = *(const GAS attn_body::bf16x8*)(ws + XCLK_SRC + 65536 + (size_t)F.tid * 16);
            attn_body::f32x16 c0 = {}, c1 = {}, c2 = {}, c3 = {};
            for (int i = 0; i < opq_s(XCLK); ++i) {
                c0 = __builtin_amdgcn_mfma_f32_32x32x16_bf16(xa, xb, c0, 0, 0, 0); c1 = __builtin_amdgcn_mfma_f32_32x32x16_bf16(xb, xa, c1, 0, 0, 0);
                c2 = __builtin_amdgcn_mfma_f32_32x32x16_bf16(xa, xa, c2, 0, 0, 0); c3 = __builtin_amdgcn_mfma_f32_32x32x16_bf16(xb, xb, c3, 0, 0, 0);
            }
            asm volatile("" :: "v"(c0), "v"(c1), "v"(c2), "v"(c3));
        }
#endif
#ifdef XDOWN
        for (int xr = 0; xr < opq_s(XDOWN); ++xr) {
            GRID_BAR();
            MK_FRAME();
            unsigned char* ws = WS_BASE();
            pg8::Gemm g{(const bf16*)(ws + WS_QKV), (const bf16*)(ws + WS_W + (size_t)L * W_LAYER + W_DN), M, D, FF}; pg8::StaticOrder S; S.init(M, D, F.G, F.bx);
            pg8::EpiResidT<XEPI> E{PTAB};
            pg8::gemm_phase<pg8::EpiResidT<XEPI>, pg8::StaticOrder, PG8_ALIGN, PG8_SP2>(F.lds + RING_OFF, g, S, E);
        }
#endif
        GRID_BAR();
#ifndef SKIP_UP
        REPEAT(REP_UP) {
            MK_FRAME();
            unsigned char* ws = WS_BASE();
            pg8::Gemm g{(const bf16*)(ws + WS_HB), (const bf16*)(ws + WS_W + (size_t)L * W_LAYER + W_GU), M, 2 * FF, D}; pg8::StaticOrder S; S.init(M, 2 * FF, F.G, F.bx);
            prep_rtab(F, S, (const float*)(ws + WS_SSP), 16);
            pg8::EpiSwiGLU E{PTAB, (const LAS float*)(F.lds + RTAB_OFF)};
            pg8::gemm_phase<pg8::EpiSwiGLU, pg8::StaticOrder, PG8_ALIGN, PG8_SP2>(F.lds + RING_OFF, g, S, E);
        }
#endif
        GRID_BAR();
#ifndef SKIP_DOWN
        {
            MK_FRAME();
            unsigned char* ws = WS_BASE();
            pg8::Gemm g{(const bf16*)(ws + WS_QKV), (const bf16*)(ws + WS_W + (size_t)L * W_LAYER + W_DN), M, D, FF}; pg8::StaticOrder S; S.init(M, D, F.G, F.bx);
            pg8::EpiResid E{PTAB};
            pg8::gemm_phase<pg8::EpiResid, pg8::StaticOrder, PG8_ALIGN, PG8_SP2>(F.lds + RING_OFF, g, S, E);
        }
#endif
        GRID_BAR();
    }
#ifndef SKIP_FINAL
    {
        MK_FRAME();
        unsigned char* ws = WS_BASE();
        const int gw = F.vcu * NWAVES + F.wave, NGW = F.G * NWAVES;
        float* out = OUT_PTR();
        const bf16* HB = (const bf16*)(ws + WS_HB); const float* ssp = (const float*)(ws + WS_SSP);
        const float* gf = IN_PTR(const float, 17);
        f32x4 gv[2][2];
#pragma unroll
        for (int j = 0; j < 2; ++j) { gv[j][0] = *(const GAS f32x4*)(gf + 512 * j + 8 * F.lane); gv[j][1] = *(const GAS f32x4*)(gf + 512 * j + 8 * F.lane + 4); }
        for (int m = gw; m < M; m += NGW) {
            float s = 0.f;
#pragma unroll
            for (int j = 0; j < 16; ++j) s += ssp[(size_t)j * M + m];
            const float rs = 1.0f / sqrtf(s * (1.0f / D) + NORM_EPS);
#pragma unroll
            for (int j = 0; j < 2; ++j) {
                const v4u w = MEM_NT ? __builtin_nontemporal_load((const GAS v4u*)(HB + (size_t)m * D + 512 * j + 8 * F.lane)) : *(const GAS v4u*)(HB + (size_t)m * D + 512 * j + 8 * F.lane);
                const f32x4 a = (f32x4){bf_lo(w.x), bf_hi(w.x), bf_lo(w.y), bf_hi(w.y)}, b = (f32x4){bf_lo(w.z), bf_hi(w.z), bf_lo(w.w), bf_hi(w.w)};
                GAS f32x4* po = (GAS f32x4*)(out + (size_t)m * D + 512 * j + 8 * F.lane);
                if (FIN_ST == 2) { const f32x4 o0 = a * rs * gv[j][0], o1 = b * rs * gv[j][1]; ST16_SC1(po, o0); ST16_SC1(po + 1, o1); } else if (FIN_ST) { __builtin_nontemporal_store(a * rs * gv[j][0], po); __builtin_nontemporal_store(b * rs * gv[j][1], po + 1); } else { po[0] = a * rs * gv[j][0]; po[1] = b * rs * gv[j][1]; }
            }
        }
    }
#endif
}

extern "C" void kernel_launch(void* const* d_in, const int* in_sizes, int n_in, void* d_out, int out_size, void* d_ws, size_t ws_size, hipStream_t stream) {
    static int grid = 0;
    if (grid == 0) {
        if (n_in != 18 || in_sizes[0] != M * D || out_size != M * D || ws_size < WS_END) { fprintf(stderr, "kernel_launch: unexpected problem shape / workspace (n_in %d, in0 %d, out %d, ws %zu)\n", n_in, n_in > 0 ? in_sizes[0] : -1, out_size, ws_size); grid = -1; return; }
        int dev = 0, cus = 0, per_cu = 0;
        if (hipGetDevice(&dev) != hipSuccess || hipDeviceGetAttribute(&cus, hipDeviceAttributeMultiprocessorCount, dev) != hipSuccess) { grid = -1; return; }
        if (hipFuncSetAttribute((const void*)mk_fwd, hipFuncAttributeMaxDynamicSharedMemorySize, LDS_BYTES) != hipSuccess) { fprintf(stderr, "kernel_launch: hipFuncSetAttribute failed\n"); grid = -1; return; }
        if (hipOccupancyMaxActiveBlocksPerMultiprocessor(&per_cu, (const void*)mk_fwd, NWAVES * 64, LDS_BYTES) != hipSuccess || per_cu < 1) { fprintf(stderr, "kernel_launch: occupancy query says %d blocks per CU\n", per_cu); per_cu = 1; }
        (void)hipGetLastError();
        grid = cus;
    }
    if (grid < 0) return;
    if (hipMemsetAsync((char*)d_ws + WS_CTL, 0, CTL_ZERO_BYTES, stream) != hipSuccess) { fprintf(stderr, "kernel_launch: hipMemsetAsync failed\n"); return; }
    Args a{};
    for (int i = 0; i < 18; ++i) a.in[i] = d_in[i];
    a.out = (float*)d_out; a.ws = (unsigned char*)d_ws;
    hipLaunchKernelGGL(mk_fwd, dim3(grid), dim3(NWAVES * 64), LDS_BYTES, stream, a);
}
```

```cpp
#include <hip/hip_runtime.h>
#include <hip/hip_bf16.h>
#include <cstdio>
#include <cstdint>
#include <cmath>
namespace pg8 {
#define PG8_LAS __attribute__((address_space(3)))
typedef unsigned short bf16_t;
typedef short bf16x8 __attribute__((ext_vector_type(8)));
typedef float f32x4 __attribute__((ext_vector_type(4)));
typedef unsigned u32x4 __attribute__((ext_vector_type(4)));
typedef unsigned u32x2 __attribute__((ext_vector_type(2)));
constexpr int BM = 256, BK = 64, HALF = 128, HTB = HALF * BK * 2  , STAGE_BYTES = 8 * HTB, NXCD = 8, WGM = 8;

__host__ __device__ __forceinline__ int lds_byte(int r, int c) { const int st = (r >> 4) * 2 + (c >> 5), rr = r & 15, cc = c & 31, ob = rr * 64 + cc * 2; return st * 1024 + (ob ^ (((ob >> 9) & 1) << 5)); }
__host__ __device__ __forceinline__ void stage_rc(int b, int& R, int& C) { const int st = b / 1024, sb = b % 1024, swz = sb ^ (((sb >> 9) & 1) << 5); R = (st >> 1) * 16 + swz / 64; C = (st & 1) * 32 + (swz % 64) / 2; }
__host__ __device__ __forceinline__ int perm32(int rho) { const int n = rho >> 4, i = rho & 15; return 8 * (i >> 2) + 4 * n + (i & 3); }

struct Unit { int pm, pn, idx; };
struct Gemm { const bf16_t* A; const bf16_t* Bt; int M, N, K; };

struct StaticOrder {
    int nM, nN, nwg, G, c;
    __host__ __device__ void init(int M, int N, int G_, int c_) { nM = M / BM; nN = N / BM; nwg = nM * nN; G = G_; c = c_; }
    __host__ __device__ bool next(int i, Unit& u) const {
        const long L = (long)i * G + c; if (L >= nwg) return false;
        int wgid = (int)L; { const int q = nwg / NXCD, r = nwg % NXCD, xcd = wgid % NXCD, off = wgid / NXCD; wgid = (xcd < r ? xcd * (q + 1) : r * (q + 1) + (xcd - r) * q) + off; }
        const int nig = WGM * nN, gid = wgid / nig, fm = gid * WGM, gsz = (nM - fm) < WGM ? (nM - fm) : WGM;
        u.pm = fm + ((wgid % nig) % gsz); u.pn = (wgid % nig) / gsz; u.idx = i; return true;
    }
    __device__ __forceinline__ void a_ready(const Unit&) const {}
    __device__ __forceinline__ void done(const Unit&) const {}
};
struct GroupOrder {
    int nN, gb, mb, per;
    __host__ __device__ void init(int, int N, int, int c_) { nN = N / BM; gb = 2 * (c_ & 7) + ((c_ >> 3) >> 4); mb = (c_ >> 3) & 15; per = nN >> 1; }
    __host__ __device__ bool next(int i, Unit& u) const {
        if (i >= per) return false;
        const int L = i * 16 + mb, nig = 4 * nN, gid = L / nig, r = L % nig;
        u.pm = 8 * gb + 4 * gid + (r & 3); u.pn = r >> 2; u.idx = i; return true;
    }
    __device__ __forceinline__ void a_ready(const Unit&) const {}
    __device__ __forceinline__ void done(const Unit&) const {}
};
#ifndef GRP
#define GRP 1
#endif
#ifdef DBG_QKV_GROUP
typedef GroupOrder QkvOrder;
#define QKV_ORDER_DEFINED 1
#endif
#ifndef GRP_ORDER
#define GRP_ORDER 1
#endif
#if GRP && GRP_ORDER
typedef GroupOrder PhaseOrder;
#else
typedef StaticOrder PhaseOrder;
#endif
#ifndef QKV_ORDER_DEFINED
typedef PhaseOrder QkvOrder;
#endif

__device__ __forceinline__ unsigned cvt_pk_bf16(float lo, float hi) { unsigned r; asm volatile("v_cvt_pk_bf16_f32 %0, %1, %2" : "=v"(r) : "v"(lo), "v"(hi)); return r; }

constexpr int TOK = 32768;
__device__ __forceinline__ unsigned char* tab_ptr(volatile PG8_LAS unsigned* t, int k) {
    { unsigned a_ = (unsigned)(uintptr_t)t; asm volatile("" : "+v"(a_)); t = (volatile PG8_LAS unsigned*)a_; }
    const unsigned lo = (unsigned)__builtin_amdgcn_readfirstlane((int)t[2 * k]), hi = (unsigned)__builtin_amdgcn_readfirstlane((int)t[2 * k + 1]);
    unsigned long long v = (unsigned long long)lo | ((unsigned long long)hi << 32); asm volatile("" : "+s"(v)); return (unsigned char*)(__attribute__((address_space(1))) unsigned char*)v; }
constexpr size_t XWS_ROPE = (size_t)1 << 20, XWS_SSP = (size_t)3 << 20, XWS_KMP = (size_t)5 << 20, XWS_HB = (size_t)56 << 20, XWS_QKV = (size_t)184 << 20;

#ifndef EPI_NT
#define EPI_NT 2
#endif

#ifndef MEM_NT
#define MEM_NT 1
#endif
#define ST16_SC1(p, v) asm volatile("global_store_dwordx4 %0, %1, off sc1\n\ts_nop 1" :: "v"(p), "v"(v) : "memory")
#define ST8_SC1(p, v) asm volatile("global_store_dwordx2 %0, %1, off sc1\n\ts_nop 1" :: "v"(p), "v"(v) : "memory")
#ifndef PG8_AUX_A
#define PG8_AUX_A 0
#endif
#ifndef PG8_AUX_B
#define PG8_AUX_B 0
#endif
#ifndef RES_PF
#define RES_PF 1
#endif
#ifndef RES_LD
#define RES_LD 0
#endif
#ifndef EPI_QKV
#define EPI_QKV EPI_NT
#endif
#ifndef EPI_UP
#define EPI_UP EPI_NT
#endif
#ifndef EPI_RES
#define EPI_RES EPI_NT
#endif
template <int MODE> __device__ __forceinline__ void epi_st(void* p, const u32x4& v) {
    if constexpr (MODE == 2) asm volatile("global_store_dwordx4 %0, %1, off sc1\n\ts_nop 1" :: "v"((u32x4*)p), "v"(v) : "memory");
    else if constexpr (MODE == 3) asm volatile("global_store_dwordx4 %0, %1, off sc1 nt\n\ts_nop 1" :: "v"((u32x4*)p), "v"(v) : "memory");
    else if constexpr (MODE == 4) asm volatile("global_store_dwordx4 %0, %1, off sc0 sc1\n\ts_nop 1" :: "v"((u32x4*)p), "v"(v) : "memory");
    else if constexpr (MODE == 1) __builtin_nontemporal_store(v, (u32x4*)p);
    else *(u32x4*)p = v;
}
struct EpiQKV {
    static constexpr bool PERM = true, AFTER_DRAIN = false, PREFETCH = false;
    volatile PG8_LAS unsigned* pt; const PG8_LAS float* rt; unsigned ropemask, qmask, kmmask; float qscale;
    __device__ __forceinline__ void operator()(const f32x4 (&acc)[2][2][4][2], const Unit& u, int wr, int wc, int fr, int fq) const {
        unsigned char* ws = tab_ptr(pt, 19); bf16_t* O = (bf16_t*)(ws + XWS_QKV); const float* rope = (const float*)(ws + XWS_ROPE); float* kmp = (float*)(ws + XWS_KMP);
        const bool do_rope = (((ropemask >> u.pn) & 1u) != 0u) && ((wc & 1) == 0);
        const bool do_km = ((kmmask >> u.pn) & 1u) != 0u;
        const float sc = ((qmask >> u.pn) & 1u) ? qscale : 1.f;
        const int col0 = u.pn * BM + wc * 32 + 8 * fq;
        const float sgn = (fq == 0) ? -1.f : 1.f;
        f32x4 cs[2][2];
#pragma unroll
        for (int bj = 0; bj < 2; ++bj)
#pragma unroll
            for (int n = 0; n < 2; ++n) cs[bj][n] = (f32x4){0.f, 0.f, 0.f, 0.f};
#pragma unroll
        for (int ai = 0; ai < 2; ++ai) {
            f32x4 cc[4][2], sn[4][2];
            if (do_rope) {
#pragma unroll
                for (int m = 0; m < 4; ++m) { const f32x4* rp = (const f32x4*)(rope + (size_t)(u.pm * BM + ai * HALF + wr * 64 + m * 16 + fr) * 16);
                    cc[m][0] = rp[0]; cc[m][1] = rp[1]; sn[m][0] = rp[2]; sn[m][1] = rp[3]; }
            }
#pragma unroll
            for (int m = 0; m < 4; ++m) {
                const int rl = ai * HALF + wr * 64 + m * 16 + fr; const int row = u.pm * BM + rl;
                const float r = rt[u.idx * BM + rl];
                f32x4 v[2][2];
#pragma unroll
                for (int bj = 0; bj < 2; ++bj)
#pragma unroll
                    for (int n = 0; n < 2; ++n) v[bj][n] = acc[ai][bj][m][n] * r;
                if (do_rope) {
#pragma unroll
                    for (int bj = 0; bj < 2; ++bj)
#pragma unroll
                        for (int n = 0; n < 2; ++n)
#pragma unroll
                            for (int e = 0; e < 4; ++e) {
                                const float p = __shfl_xor(v[bj][n][e], 16);
                                const float rot = v[bj][n][e] * cc[m][n][e] + sgn * p * sn[m][n][e];
                                if (fq < 2) v[bj][n][e] = rot;
                            }
                }
                if (do_km) {
#pragma unroll
                    for (int bj = 0; bj < 2; ++bj)
#pragma unroll
                        for (int n = 0; n < 2; ++n) cs[bj][n] += v[bj][n];
                }
                bf16_t* rowp = O + (size_t)row * 3072 + col0;
#pragma unroll
                for (int bj = 0; bj < 2; ++bj) { const f32x4 v0 = v[bj][0] * sc, v1 = v[bj][1] * sc;
                    u32x4 w; w.x = cvt_pk_bf16(v0[0], v0[1]); w.y = cvt_pk_bf16(v0[2], v0[3]); w.z = cvt_pk_bf16(v1[0], v1[1]); w.w = cvt_pk_bf16(v1[2], v1[3]);
                    epi_st<EPI_QKV>(rowp + bj * HALF, w); }
            }
        }
        if (do_km) {
#pragma unroll
            for (int bj = 0; bj < 2; ++bj)
#pragma unroll
                for (int n = 0; n < 2; ++n)
#pragma unroll
                    for (int e = 0; e < 4; ++e) { float s = cs[bj][n][e]; s += __shfl_xor(s, 1); s += __shfl_xor(s, 2); s += __shfl_xor(s, 4); s += __shfl_xor(s, 8); cs[bj][n][e] = s; }
            if (fr == 0) {
                float* kp = kmp + ((size_t)wr * 128 + u.pm) * 512 + (u.pn - 8) * BM + wc * 32 + 8 * fq;
#pragma unroll
                for (int bj = 0; bj < 2; ++bj)
#pragma unroll
                    for (int n = 0; n < 2; ++n) *(f32x4*)(kp + bj * HALF + 4 * n) = cs[bj][n];
            }
        }
    }
};

template <int SCR>
struct EpiResidT {
    static constexpr bool PERM = true, AFTER_DRAIN = false, PREFETCH = (RES_PF != 0);
    volatile PG8_LAS unsigned* pt;
    __device__ __forceinline__ void prefetch(const Unit& u, int tid, int r, PG8_LAS unsigned char* junk) const {
        const unsigned char* ws = tab_ptr(pt, 19); const int li = r * 512 + tid, row = li >> 2, seg = li & 3;
        const unsigned char* p = ws + (SCR ? ((size_t)376 << 20) : XWS_HB) + ((size_t)(u.pm * BM + row) * 1024 + u.pn * BM + seg * 64) * 2;
        __builtin_amdgcn_global_load_lds((const unsigned*)p, (PG8_LAS unsigned*)junk, 4, 0, 0);
    }
    __device__ __forceinline__ void operator()(const f32x4 (&acc)[2][2][4][2], const Unit& u, int wr, int wc, int fr, int fq) const {
        unsigned char* ws = tab_ptr(pt, 19);
        bf16_t* hb = (bf16_t*)(ws + (SCR ? ((size_t)376 << 20) : XWS_HB)); float* ssp = (float*)(ws + (SCR ? ((size_t)440 << 20) : XWS_SSP));
        const int col0 = u.pn * BM + wc * 32 + 8 * fq;
        u32x4 bw[2][4][2];
#pragma unroll
        for (int ai = 0; ai < 2; ++ai)
#pragma unroll
            for (int m = 0; m < 4; ++m) {
                const size_t off = (size_t)(u.pm * BM + ai * HALF + wr * 64 + m * 16 + fr) * 1024 + col0;
#pragma unroll
                for (int bj = 0; bj < 2; ++bj) { if constexpr (SCR == 2 || SCR == 4) bw[ai][m][bj] = (u32x4){0u, 0u, 0u, 0u}; else bw[ai][m][bj] = RES_LD ? __builtin_nontemporal_load((const u32x4*)(hb + off + bj * HALF)) : *(const u32x4*)(hb + off + bj * HALF); }
            }
#pragma unroll
        for (int ai = 0; ai < 2; ++ai)
#pragma unroll
            for (int m = 0; m < 4; ++m) {
                const int row = u.pm * BM + ai * HALF + wr * 64 + m * 16 + fr; const size_t off = (size_t)row * 1024 + col0; float ss = 0.f;
#pragma unroll
                for (int bj = 0; bj < 2; ++bj) {
                    const u32x4 w0 = bw[ai][m][bj];
                    const f32x4 b0 = (f32x4){__uint_as_float(w0.x << 16), __uint_as_float(w0.x & 0xffff0000u), __uint_as_float(w0.y << 16), __uint_as_float(w0.y & 0xffff0000u)};
                    const f32x4 b1 = (f32x4){__uint_as_float(w0.z << 16), __uint_as_float(w0.z & 0xffff0000u), __uint_as_float(w0.w << 16), __uint_as_float(w0.w & 0xffff0000u)};
                    const f32x4 o0 = b0 + acc[ai][bj][m][0], o1 = b1 + acc[ai][bj][m][1];
                    ss += ((o0[0] * o0[0] + o0[1] * o0[1]) + (o0[2] * o0[2] + o0[3] * o0[3])) + ((o1[0] * o1[0] + o1[1] * o1[1]) + (o1[2] * o1[2] + o1[3] * o1[3]));
                    u32x4 w; w.x = cvt_pk_bf16(o0[0], o0[1]); w.y = cvt_pk_bf16(o0[2], o0[3]); w.z = cvt_pk_bf16(o1[0], o1[1]); w.w = cvt_pk_bf16(o1[2], o1[3]);
                    if constexpr (SCR == 3 || SCR == 4) { ss += __uint_as_float(w.x ^ w.y ^ w.z ^ w.w) * 1e-30f; } else epi_st<EPI_RES>(hb + off + bj * HALF, w);
                }
                ss += __shfl_xor(ss, 16); ss += __shfl_xor(ss, 32);
                if (fq == 0) ssp[(size_t)(u.pn * 4 + wc) * TOK + row] = ss;
            }
    }
};
typedef EpiResidT<0> EpiResid;

struct EpiSwiGLU {
    static constexpr bool PERM = true, AFTER_DRAIN = false, PREFETCH = false;
    volatile PG8_LAS unsigned* pt; const PG8_LAS float* rt;
    __device__ __forceinline__ void operator()(const f32x4 (&acc)[2][2][4][2], const Unit& u, int wr, int wc, int fr, int fq) const {
        bf16_t* O = (bf16_t*)(tab_ptr(pt, 19) + XWS_QKV + (GRP ? (size_t)(u.pm >> 3) * ((size_t)1 << 20) : (size_t)0));
        const int col0 = u.pn * HALF + wc * 32 + 8 * fq;
#pragma unroll
        for (int ai = 0; ai < 2; ++ai)
#pragma unroll
            for (int m = 0; m < 4; ++m) {
                const int rl = ai * HALF + wr * 64 + m * 16 + fr; const int row = u.pm * BM + rl;
                const float r = rt[u.idx * BM + rl];
                float a[8];
                typedef float f32x2_e __attribute__((ext_vector_type(2)));
                const float r2 = r * r, ncr = -1.4426950408889634f * r;
#pragma unroll
                for (int n = 0; n < 2; ++n)
#pragma unroll
                    for (int e = 0; e < 4; e += 2) { const f32x2_e g2 = {acc[ai][0][m][n][e], acc[ai][0][m][n][e + 1]}, u2 = {acc[ai][1][m][n][e], acc[ai][1][m][n][e + 1]};
                        f32x2_e p = g2 * u2; p = p * r2; const f32x2_e x = g2 * ncr;
                        f32x2_e d = {__builtin_amdgcn_exp2f(x.x), __builtin_amdgcn_exp2f(x.y)}; d = d + 1.0f;
                        const f32x2_e rc = {__builtin_amdgcn_rcpf(d.x), __builtin_amdgcn_rcpf(d.y)}; p = p * rc; a[4 * n + e] = p.x; a[4 * n + e + 1] = p.y; }
                u32x4 w; w.x = cvt_pk_bf16(a[0], a[1]); w.y = cvt_pk_bf16(a[2], a[3]); w.z = cvt_pk_bf16(a[4], a[5]); w.w = cvt_pk_bf16(a[6], a[7]);
                epi_st<EPI_UP>(O + (size_t)row * 2816 + col0, w);
            }
    }
};

template <class Epi, class Sched, bool ALIGN_EPI = false, bool SP2 = false>
__device__ __forceinline__ void gemm_phase(PG8_LAS unsigned char* lds, const Gemm g, const Sched& S, const Epi& E) {
    int tid_ = threadIdx.x; asm volatile("" : "+v"(tid_));
    const int tid = tid_, wid = __builtin_amdgcn_readfirstlane(tid >> 6), lane = tid & 63, wr = wid >> 2, wc = wid & 3, fr = lane & 15, fq = lane >> 4;
    const int K = g.K, nt = K / BK;
    unsigned voffA[2], voffB[2];
#pragma unroll
    for (int i = 0; i < 2; ++i) { int R, C; stage_rc(tid * 16 + i * 8192, R, C); const int Rb = Epi::PERM ? ((R & ~31) + perm32(R & 31)) : R;
        voffA[i] = (unsigned)(R * K + C) * 2u; voffB[i] = (unsigned)(Rb * K + C) * 2u; }
    const size_t kstep = (size_t)(BK * 2);
    const size_t hstep = (size_t)HALF * K * 2;
    const size_t tstep = 2 * hstep;
    const unsigned ldsw = (unsigned)wid * 1024u;
    const int aoff = lds_byte(wr * 64 + fr, fq * 8), boff = lds_byte(wc * 32 + fr, fq * 8);
#define PG8_SA(b, h) (((b) * 2 + (h)) * HTB)
#define PG8_SB(b, h) ((4 + (b) * 2 + (h)) * HTB)
#define PG8_STAGE(bufoff, gbase, voff) do { _Pragma("unroll") for (int _i = 0; _i < 2; ++_i) \
        __builtin_amdgcn_global_load_lds((const unsigned*)((const char*)(gbase) + (voff)[_i]), (PG8_LAS unsigned*)(lds + (bufoff) + ldsw + _i * 8192), 16, 0, ((bufoff) < 4 * HTB) ? PG8_AUX_A : PG8_AUX_B); } while (0)
#define PG8_LDA(dst, b, h) do { _Pragma("unroll") for (int m = 0; m < 4; ++m) _Pragma("unroll") for (int k = 0; k < 2; ++k) dst[m][k] = *(const PG8_LAS bf16x8*)(lds + PG8_SA(b, h) + aoff + m * 2048 + k * 1024); } while (0)
#define PG8_LDB(dst, b, h) do { _Pragma("unroll") for (int n = 0; n < 2; ++n) _Pragma("unroll") for (int k = 0; k < 2; ++k) dst[n][k] = *(const PG8_LAS bf16x8*)(lds + PG8_SB(b, h) + boff + n * 2048 + k * 1024); } while (0)
#define PG8_MMA(ai, bj, At, Bt) do { __builtin_amdgcn_s_setprio(1); _Pragma("unroll") for (int m = 0; m < 4; ++m) _Pragma("unroll") for (int n = 0; n < 2; ++n) _Pragma("unroll") for (int k = 0; k < 2; ++k) \
        acc[ai][bj][m][n] = __builtin_amdgcn_mfma_f32_16x16x32_bf16(Bt[n][k], At[m][k], acc[ai][bj][m][n], 0, 0, 0); __builtin_amdgcn_s_setprio(0); } while (0)
#define PG8_WAIT_V(n) asm volatile("s_waitcnt vmcnt(" #n ")" ::: "memory")
#define PG8_WAIT_L(n) asm volatile("s_waitcnt lgkmcnt(" #n ")" ::: "memory")
#define PG8_BAR __builtin_amdgcn_s_barrier()
#define PG8_SCHED __builtin_amdgcn_sched_barrier(0)
    Unit cur, nxt; int ui = 0;
    if (!S.next(0, cur)) return;
    f32x4 acc[2][2][4][2];
#pragma unroll
    for (int a = 0; a < 2; ++a)
#pragma unroll
        for (int b = 0; b < 2; ++b)
#pragma unroll
            for (int m = 0; m < 4; ++m)
#pragma unroll
                for (int n = 0; n < 2; ++n) acc[a][b][m][n] = (f32x4){0.f, 0.f, 0.f, 0.f};
    bf16x8 At[4][2], B0[2][2], B1[2][2];
    const char* cA = (const char*)g.A + (size_t)cur.pm * tstep; const char* cB = (const char*)g.Bt + (size_t)cur.pn * tstep;
    S.a_ready(cur);
    if constexpr (SP2) {
        PG8_STAGE(PG8_SB(0, 0), cB, voffB); PG8_STAGE(PG8_SB(0, 1), cB + hstep, voffB); PG8_STAGE(PG8_SA(0, 0), cA, voffA); PG8_STAGE(PG8_SA(0, 1), cA + hstep, voffA);
        if (wr == 1) PG8_BAR;
        PG8_WAIT_V(2); PG8_BAR;
        PG8_STAGE(PG8_SB(1, 0), cB + kstep, voffB); PG8_STAGE(PG8_SA(1, 0), cA + kstep, voffA); PG8_STAGE(PG8_SB(1, 1), cB + hstep + kstep, voffB);
        PG8_WAIT_V(6); PG8_BAR;
    } else {
        PG8_STAGE(PG8_SB(0, 0), cB, voffB); PG8_STAGE(PG8_SA(0, 0), cA, voffA); PG8_STAGE(PG8_SB(0, 1), cB + hstep, voffB); PG8_STAGE(PG8_SA(0, 1), cA + hstep, voffA);
        if (wr == 1) PG8_BAR;
        PG8_WAIT_V(4); PG8_BAR;
        PG8_STAGE(PG8_SB(1, 0), cB + kstep, voffB); PG8_STAGE(PG8_SA(1, 0), cA + kstep, voffA); PG8_STAGE(PG8_SB(1, 1), cB + hstep + kstep, voffB);
        PG8_WAIT_V(6); PG8_BAR;
    }
    for (;;) {
        const bool has_next = S.next(ui + 1, nxt);
        const char* nA = has_next ? (const char*)g.A + (size_t)nxt.pm * tstep : cA; const char* nB = has_next ? (const char*)g.Bt + (size_t)nxt.pn * tstep : cB;
        for (int t = 0; t < nt; t += 2) {
            const bool last = (t == nt - 2);
            const char* a1 = cA + (size_t)(t + 1) * kstep;
            const char* a2 = last ? nA : cA + (size_t)(t + 2) * kstep; const char* b2 = last ? nB : cB + (size_t)(t + 2) * kstep;
            const char* a3 = a2 + kstep; const char* b3 = b2 + kstep;
            if (last && has_next) S.a_ready(nxt);
            if constexpr (Epi::PREFETCH) { if (t == nt - 6 || t == nt - 4) E.prefetch(cur, tid, t == nt - 6 ? 0 : 1, lds + 131072 + wid * 256); }
            if constexpr (SP2) {
            PG8_LDB(B0, 0, 0); PG8_LDB(B1, 0, 1); PG8_SCHED; PG8_LDA(At, 0, 0); PG8_STAGE(PG8_SA(1, 1), a1 + hstep, voffA);
            PG8_WAIT_V(8); PG8_WAIT_L(0); PG8_BAR; PG8_MMA(0, 0, At, B0); PG8_MMA(0, 1, At, B1); PG8_BAR; PG8_SCHED;
            PG8_LDA(At, 0, 1); PG8_STAGE(PG8_SB(0, 0), b2, voffB); PG8_STAGE(PG8_SB(0, 1), b2 + hstep, voffB); PG8_STAGE(PG8_SA(0, 0), a2, voffA);
            PG8_WAIT_V(8); PG8_WAIT_L(0); PG8_BAR; PG8_MMA(1, 0, At, B0); PG8_MMA(1, 1, At, B1); PG8_BAR; PG8_SCHED;
            PG8_LDB(B0, 1, 0); PG8_LDB(B1, 1, 1); PG8_SCHED; PG8_LDA(At, 1, 0); PG8_STAGE(PG8_SA(0, 1), a2 + hstep, voffA);
            PG8_WAIT_V(8); PG8_WAIT_L(0); PG8_BAR; PG8_MMA(0, 0, At, B0); PG8_MMA(0, 1, At, B1); PG8_BAR; PG8_SCHED;
            PG8_LDA(At, 1, 1); PG8_STAGE(PG8_SB(1, 0), b3, voffB); PG8_STAGE(PG8_SB(1, 1), b3 + hstep, voffB); PG8_STAGE(PG8_SA(1, 0), a3, voffA);
            PG8_WAIT_V(8); PG8_WAIT_L(0); PG8_BAR; PG8_MMA(1, 0, At, B0); PG8_MMA(1, 1, At, B1); PG8_BAR; PG8_SCHED;
            } else {
            PG8_LDB(B0, 0, 0); PG8_SCHED; PG8_LDA(At, 0, 0); PG8_STAGE(PG8_SA(1, 1), a1 + hstep, voffA);
            PG8_WAIT_L(8); PG8_BAR; PG8_WAIT_L(0); PG8_MMA(0, 0, At, B0); PG8_BAR; PG8_SCHED;
            PG8_LDB(B1, 0, 1); PG8_STAGE(PG8_SB(0, 0), b2, voffB);
            PG8_BAR; PG8_WAIT_L(0); PG8_MMA(0, 1, At, B1); PG8_BAR;
            PG8_LDA(At, 0, 1); PG8_STAGE(PG8_SA(0, 0), a2, voffA);
            PG8_BAR; PG8_WAIT_L(0); PG8_MMA(1, 0, At, B0); PG8_BAR; PG8_SCHED;
            PG8_STAGE(PG8_SB(0, 1), b2 + hstep, voffB);
            PG8_WAIT_V(6); PG8_BAR; PG8_MMA(1, 1, At, B1); PG8_BAR;
            PG8_LDB(B0, 1, 0); PG8_SCHED; PG8_LDA(At, 1, 0); PG8_STAGE(PG8_SA(0, 1), a2 + hstep, voffA);
            PG8_WAIT_L(8); PG8_BAR; PG8_WAIT_L(0); PG8_MMA(0, 0, At, B0); PG8_BAR; PG8_SCHED;
            PG8_LDB(B1, 1, 1); PG8_STAGE(PG8_SB(1, 0), b3, voffB);
            PG8_BAR; PG8_WAIT_L(0); PG8_MMA(0, 1, At, B1); PG8_BAR;
            PG8_LDA(At, 1, 1); PG8_STAGE(PG8_SA(1, 0), a3, voffA);
            PG8_BAR; PG8_WAIT_L(0); PG8_MMA(1, 0, At, B0); PG8_BAR; PG8_SCHED;
            PG8_STAGE(PG8_SB(1, 1), b3 + hstep, voffB);
            PG8_WAIT_V(6); PG8_BAR; PG8_MMA(1, 1, At, B1); PG8_BAR;
            }
        }
        if constexpr (ALIGN_EPI) { if (wr == 0) PG8_BAR; }
        if constexpr (!Epi::AFTER_DRAIN) { E(acc, cur, wr, wc, fr, fq); S.done(cur); }
        if (!has_next) break;
#pragma unroll
        for (int a = 0; a < 2; ++a)
#pragma unroll
            for (int b = 0; b < 2; ++b)
#pragma unroll
                for (int m = 0; m < 4; ++m)
#pragma unroll
                    for (int n = 0; n < 2; ++n) acc[a][b][m][n] = (f32x4){0.f, 0.f, 0.f, 0.f};
        cur = nxt; cA = nA; cB = nB; ++ui;
        if constexpr (ALIGN_EPI) { if (wr == 1) PG8_BAR; }
    }
    PG8_WAIT_V(0);
    if constexpr (!ALIGN_EPI) { if (wr == 0) PG8_BAR; }
    PG8_BAR;
    if constexpr (Epi::AFTER_DRAIN) { E.fused(acc, cur, wr, wc, fr, fq, lds, wid, lane); S.done(cur); }
#undef PG8_SA
#undef PG8_SB
#undef PG8_STAGE
#undef PG8_LDA
#undef PG8_LDB
#undef PG8_MMA
#undef PG8_WAIT_V
#undef PG8_WAIT_L
#undef PG8_BAR
#undef PG8_SCHED
}
}

#ifndef PG8_SP2
#define PG8_SP2 true
#endif
#ifndef PG8_ALIGN
#define PG8_ALIGN true
#endif
#ifndef ATT_NOREF
#define ATT_NOREF 1
#endif
namespace attn_body {
constexpr bool NOREF = ATT_NOREF != 0;
using bf16=__hip_bfloat16;
using bf16x8=__attribute__((ext_vector_type(8)))short;
using s16x4=__attribute__((ext_vector_type(4)))short;
using f32x16=__attribute__((ext_vector_type(16)))float;
using f32x4=__attribute__((ext_vector_type(4)))float;
using u32x4=__attribute__((ext_vector_type(4)))unsigned;
constexpr int SEQ=2048,D=64,LDQ=3072;
constexpr int NW=8,QBLK=32,QB=QBLK*NW,KVBLK=64,NQB=SEQ/QB;
__device__ __forceinline__ int crow(int r,int hi){return (r&3)+8*(r>>2)+4*hi;}
#define SBAR() __builtin_amdgcn_sched_barrier(0)
__device__ __forceinline__ void cmask(f32x16&p0,f32x16&p1,int jb,int qrel,int hi){
  const float NEG=-INFINITY; int kb=64*jb+4*hi;
  #pragma unroll
  for(int r=0;r<16;++r){int kv=kb+(r&3)+8*(r>>2); if(kv>qrel)p0[r]=NEG; if(kv+32>qrel)p1[r]=NEG;}
}
__device__ __forceinline__ float dil_bias(int d){
  const unsigned u=(unsigned)d;
  const int c=(int)(u<=128u)+(int)((u<=512u)&&((u&3u)==0u))+(int)((d>=0)&&((u&15u)==0u));
  return c==0?-INFINITY:(c==1?0.f:(c==2?1.0f:1.5849625007211562f));
}
constexpr int DIL_LUT_OFF=144384, DIL_LUT_N=2336;
__device__ __forceinline__ void dil_hook(f32x16&p0,f32x16&p1,int dt,const char*shm){
#ifdef DIL_NO_LUT
  #pragma unroll
  for(int r=0;r<16;++r){const int d=dt-((r&3)+8*(r>>2)); p0[r]+=dil_bias(d); p1[r]+=dil_bias(d-32);}
#else
  const __attribute__((address_space(3))) float*Tl=(const __attribute__((address_space(3))) float*)(shm+DIL_LUT_OFF)+(dt+197);
  #pragma unroll
  for(int r=0;r<16;++r){const int off=(r&3)+8*(r>>2); float a0=Tl[59-off],a1=Tl[27-off],x0=p0[r],x1=p1[r],y0,y1;
    asm volatile("v_add_f32_e32 %0, %1, %2":"=v"(y0):"v"(x0),"v"(a0)); asm volatile("v_add_f32_e32 %0, %1, %2":"=v"(y1):"v"(x1),"v"(a1)); p0[r]=y0; p1[r]=y1;}
#endif
}
__device__ __forceinline__ void all_neg(f32x16&p0,f32x16&p1){
  #pragma unroll
  for(int r=0;r<16;++r){p0[r]=-INFINITY;p1[r]=-INFINITY;}
}

constexpr int NSLOT=3, SLOTB=8192;
constexpr int LDS_K=0, LDS_V=NSLOT*SLOTB, LDS_WS=2*NSLOT*SLOTB, LDS_OST=LDS_WS+NW*64*4, LDS_BYTES=LDS_OST+NW*4096;
constexpr float C2=0.125f*1.4426950408889634f;
__device__ __forceinline__ void glds16(const void*sbase,unsigned voff,unsigned lds_dst){unsigned keep;
  asm volatile("s_nop 4\n\ts_mov_b32 %0, m0\n\ts_mov_b32 m0, %3\n\ts_nop 0\n\tglobal_load_lds_dwordx4 %1, %2\n\ts_mov_b32 m0, %0":"=&s"(keep):"v"(voff),"s"(sbase),"s"(lds_dst):"memory");}
__device__ __forceinline__ float max3f(float a,float b,float c){float r;asm("v_max3_f32 %0, %1, %2, %3":"=v"(r):"v"(a),"v"(b),"v"(c));return r;}
__device__ __forceinline__ float max2f(float a,float b){float r;asm("v_max_f32_e32 %0, %1, %2":"=v"(r):"v"(a),"v"(b));return r;}
__device__ __forceinline__ float fadd_s(float a,float b){float r;asm("v_add_f32_e32 %0, %1, %2":"=v"(r):"v"(a),"v"(b));return r;}
__device__ __forceinline__ float fsub_s(float a,float b){float r;asm("v_sub_f32_e32 %0, %1, %2":"=v"(r):"v"(a),"v"(b));return r;}
typedef float f32x2_t __attribute__((ext_vector_type(2))); typedef __bf16 bf16x2_t __attribute__((ext_vector_type(2)));
__device__ __forceinline__ unsigned cvtpk_s(float lo,float hi){f32x2_t v={lo,hi};bf16x2_t b=__builtin_convertvector(v,bf16x2_t);return __builtin_bit_cast(unsigned,b);}
#define WAIT_BAR(N) asm volatile("s_waitcnt vmcnt(" #N ") lgkmcnt(0)\n\ts_barrier":::"memory")

__device__ __forceinline__ void qkt(f32x16&p0,f32x16&p1,const char*Kslot,const bf16x8*qr,int r32,int hi){
  const f32x16 negm=f32x16{};
  const char*kb=Kslot+hi*1024+r32*16;
  #pragma unroll
  for(int d0=0;d0<4;++d0){
    const bf16x8 b0=*reinterpret_cast<const bf16x8*>(kb+d0*2048);
    const bf16x8 b1=*reinterpret_cast<const bf16x8*>(kb+d0*2048+512);
    if(d0==0){p0=__builtin_amdgcn_mfma_f32_32x32x16_bf16(b0,qr[0],negm,0,0,0);p1=__builtin_amdgcn_mfma_f32_32x32x16_bf16(b1,qr[0],negm,0,0,0);}
    else{p0=__builtin_amdgcn_mfma_f32_32x32x16_bf16(b0,qr[d0],p0,0,0,0);p1=__builtin_amdgcn_mfma_f32_32x32x16_bf16(b1,qr[d0],p1,0,0,0);}}
}
typedef __attribute__((address_space(3))) const char* lds_cptr;
typedef short v4i16_t __attribute__((ext_vector_type(4)));
__device__ __forceinline__ void kload8(bf16x8*kf,lds_cptr kp){
  kf[0]=*(const __attribute__((address_space(3))) bf16x8*)(kp);      kf[1]=*(const __attribute__((address_space(3))) bf16x8*)(kp+512);
  kf[2]=*(const __attribute__((address_space(3))) bf16x8*)(kp+2048); kf[3]=*(const __attribute__((address_space(3))) bf16x8*)(kp+2560);
  kf[4]=*(const __attribute__((address_space(3))) bf16x8*)(kp+4096); kf[5]=*(const __attribute__((address_space(3))) bf16x8*)(kp+4608);
  kf[6]=*(const __attribute__((address_space(3))) bf16x8*)(kp+6144); kf[7]=*(const __attribute__((address_space(3))) bf16x8*)(kp+6656);
}
__device__ __forceinline__ void kload2(bf16x8*kf,lds_cptr kp,int j){ kf[2*j]=*(const __attribute__((address_space(3))) bf16x8*)(kp+j*2048); kf[2*j+1]=*(const __attribute__((address_space(3))) bf16x8*)(kp+j*2048+512); }
__device__ __forceinline__ s16x4 vtr(lds_cptr p){ return __builtin_bit_cast(s16x4,__builtin_amdgcn_ds_read_tr16_b64_v4i16((__attribute__((address_space(3))) v4i16_t*)p)); }
__device__ __forceinline__ float rowmax(const f32x16&p0,const f32x16&p1){
  float a=max3f(p0[0],p0[1],p1[0]),b=max3f(p0[2],p0[3],p1[1]);a=max3f(a,p1[2],p1[3]);
  #pragma unroll
  for(int r=4;r<16;r+=4){a=max3f(a,p0[r],p0[r+1]);b=max3f(b,p0[r+2],p0[r+3]);a=max3f(a,p1[r],p1[r+1]);b=max3f(b,p1[r+2],p1[r+3]);}
  const float m=max2f(a,b);
  auto rr=__builtin_amdgcn_permlane32_swap(__float_as_uint(m),__float_as_uint(m),false,false);
  return max2f(__uint_as_float(rr[0]),__uint_as_float(rr[1]));
}
__device__ __forceinline__ void pv(f32x16*o,int vb,bf16x8 pa0,bf16x8 pa1,bf16x8 pa2,bf16x8 pa3){
  #pragma unroll
  for(int d0=0;d0<2;++d0){s16x4 lo[4],hi[4];
    #pragma unroll
    for(int ks=0;ks<4;++ks){
      asm volatile("ds_read_b64_tr_b16 %0,%1 offset:%c2":"=&v"(lo[ks]):"v"(vb),"i"(d0*4096+ks*1024):"memory");
      asm volatile("ds_read_b64_tr_b16 %0,%1 offset:%c2":"=&v"(hi[ks]):"v"(vb),"i"(d0*4096+ks*1024+512):"memory");}
    asm volatile("s_waitcnt lgkmcnt(0)":::"memory");SBAR();
    #define PK(k) (bf16x8){lo[k][0],lo[k][1],lo[k][2],lo[k][3],hi[k][0],hi[k][1],hi[k][2],hi[k][3]}
    o[d0]=__builtin_amdgcn_mfma_f32_32x32x16_bf16(pa0,PK(0),o[d0],0,0,0);
    o[d0]=__builtin_amdgcn_mfma_f32_32x32x16_bf16(pa1,PK(1),o[d0],0,0,0);
    o[d0]=__builtin_amdgcn_mfma_f32_32x32x16_bf16(pa2,PK(2),o[d0],0,0,0);
    o[d0]=__builtin_amdgcn_mfma_f32_32x32x16_bf16(pa3,PK(3),o[d0],0,0,0);
    #undef PK
  }
}

#ifndef ATTN_STORE16
#ifndef ATT_ST
#define ATT_ST 1
#endif
#define ATTN_STORE16(p,v) do{ if(ATT_ST==2){ const u32x4 v__=(v); ST16_SC1((u32x4*)(p),v__); } else if(ATT_ST) __builtin_nontemporal_store((v),(u32x4*)(p)); else *(u32x4*)(p)=(v); }while(0)
#endif
constexpr int LDS_S1=83968, LDS_SSB=LDS_S1+NW*4096, LDS_DC=LDS_SSB+NW*128, ATTN_LDS_BYTES_DIFF=LDS_DC+544;
template<int MODE,int THRL,int ABL=0>
__device__ __forceinline__ void attn_unit(int qb,const bf16*__restrict__ QKVb,int qcol,int kcol,int vcol,bf16*Og,int ldo,const float*km0,char*shm,int est,int kncol,int vncol,int first,int&ring,int qncol,int qbn,bf16x8&qp0,bf16x8&qp1,bf16x8&qp2,bf16x8&qp3){
  const bf16*Qg=QKVb+qcol,*Kg=QKVb+kcol,*Vg=QKVb+vcol,*Kn=QKVb+kncol,*Vn=QKVb+vncol,*Qn=QKVb+qncol; const float*km1=km0+128*512;
  int tid_=threadIdx.x; asm volatile("":"+v"(tid_));
  #define CLOSE_BAR() do{ if constexpr((ABL&2048)!=0){ asm volatile("s_waitcnt lgkmcnt(0)\n\ts_barrier":::"memory"); } else if constexpr((ABL&32)!=0){ if(wid<4){ WBX(2); } } else { WBX(2); } }while(0)
  #define WBX(N) do{ if constexpr((ABL&8)!=0){ asm volatile("s_waitcnt vmcnt(" #N ") lgkmcnt(0)":::"memory"); } else { WAIT_BAR(N); } }while(0)
  const int tid=tid_,lane=tid&63,r32=lane&31,hi=lane>>5; const int wid=__builtin_amdgcn_readfirstlane(tid>>6);
  const int q0=qb*QB;
  const bf16*Qw=Qg+(long)(q0+wid*QBLK)*LDQ;
  const bf16*Kh=Kg,*Vh=Vg;
  const unsigned lds0=(unsigned)(uintptr_t)shm;
  float*wsf=(float*)(shm+LDS_WS)+wid*64;
  const bf16*ksrc=Kh+wid*8;
  const bf16*vsrc=Vh+(long)(16*(wid&3))*LDQ+(wid>>2)*32;
  const bf16*knsrc=Kn+wid*8; const bf16*vnsrc=Vn+(long)(16*(wid&3))*LDQ+(wid>>2)*32;
  const unsigned koff=(unsigned)lane*(LDQ*2u), voff=(unsigned)(lane>>2)*(LDQ*2u)+(unsigned)(lane&3)*16u;
  const unsigned kdst=lds0+LDS_K+wid*1024, vdst=lds0+LDS_V+wid*1024;
  #define DMA_K(t,slot) glds16(ksrc+(long)(t)*KVBLK*LDQ,koff,(unsigned)__builtin_amdgcn_readfirstlane(kdst+(slot)))
  #define DMA_V(t,slot) glds16(vsrc+(long)(t)*KVBLK*LDQ,voff,(unsigned)__builtin_amdgcn_readfirstlane(vdst+(slot)))
  #define DMA_KX(t,slot) do{ const int t_=(t); const bf16*s_=(t_<NT)?(ksrc+(long)t_*KVBLK*LDQ):(knsrc+(long)(t_-NT)*KVBLK*LDQ); glds16(s_,koff,(unsigned)__builtin_amdgcn_readfirstlane(kdst+(slot))); }while(0)
  #define DMA_VX(t,slot) do{ const int t_=(t); const bf16*s_=(t_<NT)?(vsrc+(long)t_*KVBLK*LDQ):(vnsrc+(long)(t_-NT)*KVBLK*LDQ); glds16(s_,voff,(unsigned)__builtin_amdgcn_readfirstlane(vdst+(slot))); }while(0)
  const int vb0=(int)(lds0+LDS_V)+((lane>>4)&1)*32+(lane&3)*8+(4*hi+((lane&15)>>2))*64;
  const int s0=ring, s1=(s0==(NSLOT-1)*SLOTB)?0:s0+SLOTB, s2=(s1==(NSLOT-1)*SLOTB)?0:s1+SLOTB;
  const char*Kbase=shm+LDS_K+s0; bf16x8 kf[8];
  const lds_cptr shm3=(lds_cptr)shm; const lds_cptr kp0=shm3+LDS_K+hi*1024+r32*16; const lds_cptr vp0=shm3+LDS_V+((lane>>4)&1)*32+(lane&3)*8+(4*hi+((lane&15)>>2))*64;
  const int NT=(q0+QB)/KVBLK;
  if(first){DMA_K(0,s0);DMA_V(0,s0);DMA_K(1,s1);}
  bf16x8 qr[4];
  if(first){
    #pragma unroll
    for(int d0=0;d0<4;++d0)qr[d0]=*reinterpret_cast<const bf16x8*>(&Qw[(long)r32*LDQ+d0*16+hi*8]); }
  else{
    qr[0]=qp0;qr[1]=qp1;qr[2]=qp2;qr[3]=qp3; }
  float mhat=0.f,l_reg=0.f;f32x16 o[2];o[0]=f32x16{};o[1]=f32x16{};const f32x16 zero16=f32x16{};
  const int qrel=wid*QBLK+r32;
  unsigned selmask=0u;
  if constexpr(MODE==2){
    if(qb<=3)selmask=(1u<<qb)-1u;
    else{
      float g[8];
      #pragma unroll
      for(int n=0;n<8;++n){
        if(n<qb){ float s=0.f;
          #pragma unroll
          for(int d0=0;d0<4;++d0){
            const f32x4 a0=*(const f32x4*)(km0+(long)n*512+d0*16+hi*8),a1=*(const f32x4*)(km0+(long)n*512+d0*16+hi*8+4);
            const f32x4 b0=*(const f32x4*)(km1+(long)n*512+d0*16+hi*8),b1=*(const f32x4*)(km1+(long)n*512+d0*16+hi*8+4);
            const f32x4 k0=a0+b0,k1=a1+b1;
            #pragma unroll
            for(int e=0;e<4;++e){
              const unsigned w=(unsigned)(unsigned short)qr[d0][e],w2=(unsigned)(unsigned short)qr[d0][4+e];
              s+=__uint_as_float(w<<16)*k0[e]; s+=__uint_as_float(w2<<16)*k1[e]; } }
          s+=__shfl_xor(s,32); g[n]=s; }
        else g[n]=-INFINITY; }
      #pragma unroll
      for(int n=0;n<8;++n){ int rank=0;
        #pragma unroll
        for(int m=0;m<8;++m){ if(m!=n){ rank+=(g[m]>g[n]||(g[m]==g[n]&&m<n))?1:0; } }
        if(n<qb&&rank<3)selmask|=(1u<<n); }
    }
    ((unsigned*)(shm+LDS_OST))[wid*1024+lane]=selmask;
  }
  const int dq=q0+qrel-4*hi;
  #define MHOOK(P0,P1,t) do{ if constexpr(MODE==1){ dil_hook(P0,P1,dq-64*(t),shm); } \
      else if constexpr(MODE==2){ if((t)<NT-4){ const unsigned sm_=((const unsigned*)(shm+LDS_OST))[wid*1024+lane]; if(!((sm_>>((t)>>2))&1u)) all_neg(P0,P1); } } }while(0)
  #define CMASK(P0,P1,t) do{ if constexpr(MODE!=1){ int jb_=(t)-(NT-4); if(jb_>=0)cmask(P0,P1,jb_,qrel,hi);} }while(0)
  bool resc=false;
  #define START(P0,P1) do{ resc=false; \
    if constexpr(!NOREF){ const float rm=rowmax(P0,P1); const float dl=(rm>-1e30f)?rm:0.f; mhat=fadd_s(mhat,dl); \
      _Pragma("unroll") for(int r=0;r<16;++r){P0[r]=fsub_s(P0[r],dl);P1[r]=fsub_s(P1[r],dl);} \
      } \
    _Pragma("unroll") for(int r=0;r<16;++r)P0[r]=__builtin_amdgcn_exp2f(P0[r]); }while(0)
  #define RESC() do{ if(resc){ asm volatile("s_waitcnt lgkmcnt(0)":::"memory"); \
      _Pragma("unroll") for(int d_=0;d_<2;++d_) _Pragma("unroll") for(int r=0;r<16;++r)o[d_][r]*=wsf[crow(r,hi)]; } }while(0)
  f32x16 pA0,pA1,pB0,pB1;
  int sl_prev=s0,sl_cur=s0,sl_next=s1;
  #define ROT() do{sl_prev=sl_cur;sl_cur=sl_next;sl_next=(sl_next==(NSLOT-1)*SLOTB)?0:sl_next+SLOTB;}while(0)
  if(first){DMA_K(2,s2);}
  WBX(3);
  qkt(pA0,pA1,Kbase,qr,r32,hi);asm volatile("s_nop 15\n\ts_nop 7":"+v"(pA0),"+v"(pA1));CMASK(pA0,pA1,0);MHOOK(pA0,pA1,0);
  START(pA0,pA1);
  _Pragma("unroll") for(int r=0;r<16;++r)pA1[r]=__builtin_amdgcn_exp2f(pA1[r]);
  WBX(0);
  DMA_K(3,s0);DMA_V(1,s1);
  ROT();
  kload8(kf,kp0+sl_cur);
  WBX(2);
  s16x4 vlo[8],vhi[8]; u32x4 pw0,pw1,pw2,pw3;
  if constexpr((ABL&16)!=0){ _Pragma("unroll") for(int i_=0;i_<8;++i_){vlo[i_]=s16x4{};vhi[i_]=s16x4{};} }
  if constexpr((ABL&4)!=0){ pA0=f32x16{};pA1=f32x16{};pB0=f32x16{};pB1=f32x16{}; }
  if constexpr((ABL&512)!=0){ pw0=u32x4{};pw1=u32x4{};pw2=u32x4{};pw3=u32x4{}; }
  #define PKW(P,B) cvtpk_s(P[B],P[B+1])
  #define PAF(k) __builtin_bit_cast(bf16x8,pw##k)
  #define VFR(i) (bf16x8){vlo[i][0],vlo[i][1],vlo[i][2],vlo[i][3],vhi[i][0],vhi[i][1],vhi[i][2],vhi[i][3]}
  #define PIN(x) asm volatile("":"+v"(x))
  #define MX3(a,b,c) __builtin_fmaxf(__builtin_fmaxf((a),(b)),(c))
  #define GAPA(MF,A0,A1,A2,A3,W0,W1,PW) do{ if constexpr((ABL&4)==0){ MF; } if constexpr((ABL&512)==0){ sacc+=A0; sacc+=A1; sacc+=A2; sacc+=A3; PIN(sacc); W0; W1; PIN(PW); } if constexpr((ABL&1024)!=0){ rmx_=MX3(rmx_,A0,A1); rmx_=MX3(rmx_,A2,A3); PIN(rmx_); } SBAR(); }while(0)
  #define EX(v) (((ABL&1)!=0)?(v):__builtin_amdgcn_exp2f(v))
  #define GAPB(MF,X,B) do{ if constexpr((ABL&2)==0){ MF; } if constexpr((ABL&1024)!=0){ X[B]=fsub_s(X[B],mhat);X[B+1]=fsub_s(X[B+1],mhat);X[B+2]=fsub_s(X[B+2],mhat);X[B+3]=fsub_s(X[B+3],mhat); } X[B]=EX(X[B]); X[B+1]=EX(X[B+1]); X[B+2]=EX(X[B+2]); X[B+3]=EX(X[B+3]); PIN(X); SBAR(); }while(0)
  #define VRD(i) do{ if constexpr((ABL&16)!=0) break; vlo[i]=vtr(vp_+(((i)>>2)*4096+((i)&3)*1024)); vhi[i]=vtr(vp_+(((i)>>2)*4096+((i)&3)*1024+512)); }while(0)
  #define KRD(G,j) do{ if constexpr((ABL&128)==0){ if(G){ kload2(kf,kp0+sl_next,j); SBAR(); } } }while(0)
  #define STEP(C0,C1,P0,P1,t,GL) do{ SBAR(); \
    const lds_cptr vp_=vp0+sl_prev; \
    VRD(0); SBAR(); float sacc=(P0[0]+P0[1]); float rmx_=0.f; \
    GAPA(C0=__builtin_amdgcn_mfma_f32_32x32x16_bf16(kf[0],qr[0],zero16,0,0,0), P0[2],P0[3],P0[4],P0[5],     pw0[0]=PKW(P0,0), pw0[1]=PKW(P0,2), pw0); \
    VRD(4); SBAR(); GAPA(C1=__builtin_amdgcn_mfma_f32_32x32x16_bf16(kf[1],qr[0],zero16,0,0,0), P0[6],P0[7],P0[8],P0[9],     pw0[2]=PKW(P0,4), pw0[3]=PKW(P0,6), pw0); \
    VRD(1); SBAR(); GAPA(C0=__builtin_amdgcn_mfma_f32_32x32x16_bf16(kf[2],qr[1],C0,0,0,0),   P0[10],P0[11],P0[12],P0[13], pw1[0]=PKW(P0,8), pw1[1]=PKW(P0,10), pw1); \
    VRD(5); SBAR(); GAPA(C1=__builtin_amdgcn_mfma_f32_32x32x16_bf16(kf[3],qr[1],C1,0,0,0),   P0[14],P0[15],P1[0],P1[1],   pw1[2]=PKW(P0,12),pw1[3]=PKW(P0,14), pw1); \
    VRD(2); SBAR(); GAPA(C0=__builtin_amdgcn_mfma_f32_32x32x16_bf16(kf[4],qr[2],C0,0,0,0),   P1[2],P1[3],P1[4],P1[5],     pw2[0]=PKW(P1,0), pw2[1]=PKW(P1,2), pw2); \
    VRD(6); SBAR(); GAPA(C1=__builtin_amdgcn_mfma_f32_32x32x16_bf16(kf[5],qr[2],C1,0,0,0),   P1[6],P1[7],P1[8],P1[9],     pw2[2]=PKW(P1,4), pw2[3]=PKW(P1,6), pw2); \
    VRD(3); SBAR(); GAPA(C0=__builtin_amdgcn_mfma_f32_32x32x16_bf16(kf[6],qr[3],C0,0,0,0),   P1[10],P1[11],P1[12],P1[13], pw3[0]=PKW(P1,8), pw3[1]=PKW(P1,10), pw3); \
    VRD(7); SBAR(); GAPA(C1=__builtin_amdgcn_mfma_f32_32x32x16_bf16(kf[7],qr[3],C1,0,0,0),   P1[14],P1[15],0.f,0.f,       pw3[2]=PKW(P1,12),pw3[3]=PKW(P1,14), pw3); \
    l_reg+=sacc; if constexpr((ABL&1024)!=0){ asm volatile(""::"v"(rmx_)); } \
    if constexpr((ABL&64)==0){ STEP_DMA(t); } \
    if constexpr((ABL&32)!=0){ if(wid>=4){ WAIT_BAR(2); } } \
    if constexpr(NOREF){ if constexpr(MODE==1){ asm volatile("s_nop 7\n\ts_nop 7":"+v"(C0),"+v"(C1)); } CMASKX(C0,C1,t); MHOOK(C0,C1,t); resc=false; } else \
    if constexpr((ABL&256)==0){ \
    asm volatile("s_nop 7\n\ts_nop 7":"+v"(C0),"+v"(C1)); \
    _Pragma("unroll") for(int r=0;r<16;++r){C0[r]=fsub_s(C0[r],mhat);C1[r]=fsub_s(C1[r],mhat);} \
    CMASKX(C0,C1,t); MHOOK(C0,C1,t); \
    { float a=MX3(C0[0],C0[1],C1[0]),b=MX3(C0[2],C0[3],C1[1]); a=MX3(a,C1[2],C1[3]); \
      _Pragma("unroll") for(int r=4;r<16;r+=4){a=MX3(a,C0[r],C0[r+1]);b=MX3(b,C0[r+2],C0[r+3]);a=MX3(a,C1[r],C1[r+1]);b=MX3(b,C1[r+2],C1[r+3]);} \
      float rm=__builtin_fmaxf(a,b); { auto rr=__builtin_amdgcn_permlane32_swap(__float_as_uint(rm),__float_as_uint(rm),false,false); rm=__builtin_fmaxf(__uint_as_float(rr[0]),__uint_as_float(rr[1])); } \
      resc=false; \
      if(__builtin_expect(__any(rm>(float)THRL),0)){ const float dl=__builtin_fmaxf(rm,0.f); mhat+=dl; \
        _Pragma("unroll") for(int r=0;r<16;++r){C0[r]-=dl;C1[r]-=dl;} \
        const float f=__builtin_amdgcn_exp2f(-dl); l_reg*=f; if(hi==0)wsf[r32]=f; resc=true; } } \
    } else { resc=false; } \
    SBAR(); \
    GAPB(o[0]=__builtin_amdgcn_mfma_f32_32x32x16_bf16(PAF(0),VFR(0),o[0],0,0,0), C0,0); \
    GAPB(o[1]=__builtin_amdgcn_mfma_f32_32x32x16_bf16(PAF(0),VFR(4),o[1],0,0,0), C0,4); \
    KRD(GL,0); GAPB(o[0]=__builtin_amdgcn_mfma_f32_32x32x16_bf16(PAF(1),VFR(1),o[0],0,0,0), C0,8); \
    KRD(GL,1); GAPB(o[1]=__builtin_amdgcn_mfma_f32_32x32x16_bf16(PAF(1),VFR(5),o[1],0,0,0), C0,12); \
    KRD(GL,2); GAPB(o[0]=__builtin_amdgcn_mfma_f32_32x32x16_bf16(PAF(2),VFR(2),o[0],0,0,0), C1,0); \
    KRD(GL,3); GAPB(o[1]=__builtin_amdgcn_mfma_f32_32x32x16_bf16(PAF(2),VFR(6),o[1],0,0,0), C1,4); \
    GAPB(o[0]=__builtin_amdgcn_mfma_f32_32x32x16_bf16(PAF(3),VFR(3),o[0],0,0,0), C1,8); \
    GAPB(o[1]=__builtin_amdgcn_mfma_f32_32x32x16_bf16(PAF(3),VFR(7),o[1],0,0,0), C1,12); \
    }while(0)
  int t=1;
  #define CMASKX(P0,P1,t) do{}while(0)
  #define STEP_DMA(t) DMA_K((t)+3,sl_cur); DMA_V((t)+1,sl_next)
  for(;t+5<NT;t+=2){
    STEP(pB0,pB1,pA0,pA1,t,true);     CLOSE_BAR(); RESC(); ROT();
    STEP(pA0,pA1,pB0,pB1,t+1,true);   CLOSE_BAR(); RESC(); ROT();
  }
  #undef STEP_DMA
  #define STEP_DMA(t) DMA_KX((t)+3,sl_cur); DMA_VX((t)+1,sl_next)
  #undef CMASKX
  #define CMASKX(P0,P1,t) CMASK(P0,P1,t)
  for(;t+1<NT;t+=2){
    STEP(pB0,pB1,pA0,pA1,t,(t+1<NT));       CLOSE_BAR(); RESC(); ROT();
    STEP(pA0,pA1,pB0,pB1,t+1,(t+2<NT));     CLOSE_BAR(); RESC(); ROT();
  }
  STEP(pB0,pB1,pA0,pA1,NT-1,false); CLOSE_BAR(); RESC();
  ring=sl_next;
  #undef STEP_DMA
  { float sacc=pB0[0]+pB0[1]; _Pragma("unroll") for(int r=2;r<16;++r)sacc+=pB0[r]; _Pragma("unroll") for(int r=0;r<16;++r)sacc+=pB1[r]; l_reg+=sacc;
    pw0=(u32x4){PKW(pB0,0),PKW(pB0,2),PKW(pB0,4),PKW(pB0,6)};pw1=(u32x4){PKW(pB0,8),PKW(pB0,10),PKW(pB0,12),PKW(pB0,14)};pw2=(u32x4){PKW(pB1,0),PKW(pB1,2),PKW(pB1,4),PKW(pB1,6)};pw3=(u32x4){PKW(pB1,8),PKW(pB1,10),PKW(pB1,12),PKW(pB1,14)};
    SBAR(); pv(o,vb0+sl_cur,PAF(0),PAF(1),PAF(2),PAF(3)); }
  #undef PKW
  #undef PAF
  #undef VFR
  #undef PIN
  #undef MX3
  #undef GAPA
  #undef GAPB
  #undef EX
  #undef VRD
  #undef KRD
  #undef STEP
  #undef CMASKX
  { const bf16*Qnw=Qn+(long)(qbn*QB+wid*QBLK)*LDQ;
    qp0=*reinterpret_cast<const bf16x8*>(&Qnw[(long)r32*LDQ+0*16+hi*8]); qp1=*reinterpret_cast<const bf16x8*>(&Qnw[(long)r32*LDQ+1*16+hi*8]);
    qp2=*reinterpret_cast<const bf16x8*>(&Qnw[(long)r32*LDQ+2*16+hi*8]); qp3=*reinterpret_cast<const bf16x8*>(&Qnw[(long)r32*LDQ+3*16+hi*8]); }
  {auto rr=__builtin_amdgcn_permlane32_swap(__float_as_uint(l_reg),__float_as_uint(l_reg),false,false);l_reg=__uint_as_float(rr[0])+__uint_as_float(rr[1]);}
  if(hi==0)wsf[32+r32]=l_reg;asm volatile("s_waitcnt lgkmcnt(0)":::"memory");
  float rli[16];
  #pragma unroll
  for(int r=0;r<16;++r)rli[r]=__builtin_amdgcn_rcpf(wsf[32+crow(r,hi)]);
  bf16*Ow=Og+(long)(q0+wid*QBLK)*ldo;
  if(est==0){ bf16*stg=(bf16*)(shm+LDS_OST)+wid*2048;
    #pragma unroll
    for(int r=0;r<16;++r){const int orow=crow(r,hi);
      #pragma unroll
      for(int d0=0;d0<2;++d0)stg[orow*64+d0*32+r32]=__float2bfloat16(o[d0][r]*rli[r]);}
    asm volatile("s_waitcnt lgkmcnt(0)":::"memory");
    #pragma unroll
    for(int i=0;i<4;++i){const int row=i*8+(lane>>3),ch=lane&7; const u32x4 v=*(const u32x4*)(stg+row*64+ch*8); ATTN_STORE16(Ow+(long)row*ldo+ch*8,v);} }
  else if(est==1){ bf16*s1=(bf16*)(shm+LDS_S1)+wid*2048;
    #pragma unroll
    for(int r=0;r<16;++r){const int orow=crow(r,hi);
      #pragma unroll
      for(int d0=0;d0<2;++d0)s1[orow*64+d0*32+r32]=__float2bfloat16(o[d0][r]*rli[r]);} }
  else{ bf16*s1=(bf16*)(shm+LDS_S1)+wid*2048; bf16*stg=(bf16*)(shm+LDS_OST)+wid*2048; bf16*dst=(est==2)?stg:s1;
    const float*dc=(const float*)(shm+LDS_DC); float*ssb=(float*)(shm+LDS_SSB)+wid*32; const float lam=dc[128];
    #pragma unroll
    for(int r=0;r<16;++r){const int orow=crow(r,hi);
      #pragma unroll
      for(int d0=0;d0<2;++d0){const int idx=orow*64+d0*32+r32; const float o1=__bfloat162float(s1[idx]); dst[idx]=__float2bfloat16(o1-lam*(o[d0][r]*rli[r]));}}
    asm volatile("s_waitcnt lgkmcnt(0)":::"memory");
    const int ch=lane&7;
    #pragma unroll
    for(int i=0;i<4;++i){const int row=i*8+(lane>>3); const u32x4 v=*(const u32x4*)(dst+row*64+ch*8);
      float dv[8];
      #pragma unroll
      for(int e=0;e<4;++e){dv[2*e]=__uint_as_float(v[e]<<16);dv[2*e+1]=__uint_as_float(v[e]&0xffff0000u);}
      float ss=0.f;
      #pragma unroll
      for(int e=0;e<8;++e)ss+=dv[e]*dv[e];
      ss+=__shfl_xor(ss,1);ss+=__shfl_xor(ss,2);ss+=__shfl_xor(ss,4);
      if(est==2){ if(ch==0)ssb[row]=ss; }
      else{ const float rs=1.0f/sqrtf((ss+ssb[row])*(1.0f/128.0f)+1e-5f);
        const u32x4 v0=*(const u32x4*)(stg+row*64+ch*8);
        const f32x4 g0a=*(const f32x4*)(dc+ch*8),g0b=*(const f32x4*)(dc+ch*8+4),g1a=*(const f32x4*)(dc+64+ch*8),g1b=*(const f32x4*)(dc+64+ch*8+4);
        u32x4 w0,w1;
        #pragma unroll
        for(int e=0;e<4;++e){ const float ga=(e<2)?g0a[2*e]:g0b[2*e-4], gb=(e<2)?g0a[2*e+1]:g0b[2*e-3], ha=(e<2)?g1a[2*e]:g1b[2*e-4], hb=(e<2)?g1a[2*e+1]:g1b[2*e-3];
          w0[e]=cvtpk_s(__uint_as_float(v0[e]<<16)*rs*ga,__uint_as_float(v0[e]&0xffff0000u)*rs*gb);
          w1[e]=cvtpk_s(dv[2*e]*rs*ha,dv[2*e+1]*rs*hb); }
        ATTN_STORE16(Ow+(long)row*ldo+ch*8,w0); ATTN_STORE16(Ow+(long)row*ldo+64+ch*8,w1); } } }
  asm volatile("s_waitcnt lgkmcnt(0)\n\ts_barrier":::"memory");
  #undef DMA_K
  #undef DMA_V
  #undef DMA_KX
  #undef DMA_VX
  #undef CMASK
  #undef MHOOK
  #undef START
  #undef RESC
  #undef ROT
  #undef WBX
  #undef CLOSE_BAR
}
constexpr int V_SLOTB=16384;
constexpr int X_K=0, X_V=NSLOT*SLOTB, X_WS=X_V+NSLOT*V_SLOTB, X_ST=X_WS+NW*256, X_DC=X_ST+NW*8192, X_BYTES=X_DC+544;
__device__ __forceinline__ void pv128(f32x16*o,int vb,bf16x8 pa0,bf16x8 pa1,bf16x8 pa2,bf16x8 pa3){
  #pragma unroll
  for(int d0=0;d0<4;++d0){s16x4 lo[4],hi[4];
    #pragma unroll
    for(int ks=0;ks<4;++ks){
      asm volatile("ds_read_b64_tr_b16 %0,%1 offset:%c2":"=&v"(lo[ks]):"v"(vb),"i"(d0*4096+ks*1024):"memory");
      asm volatile("ds_read_b64_tr_b16 %0,%1 offset:%c2":"=&v"(hi[ks]):"v"(vb),"i"(d0*4096+ks*1024+512):"memory");}
    asm volatile("s_waitcnt lgkmcnt(0)":::"memory");SBAR();
    #define PK(k) (bf16x8){lo[k][0],lo[k][1],lo[k][2],lo[k][3],hi[k][0],hi[k][1],hi[k][2],hi[k][3]}
    o[d0]=__builtin_amdgcn_mfma_f32_32x32x16_bf16(pa0,PK(0),o[d0],0,0,0);
    o[d0]=__builtin_amdgcn_mfma_f32_32x32x16_bf16(pa1,PK(1),o[d0],0,0,0);
    o[d0]=__builtin_amdgcn_mfma_f32_32x32x16_bf16(pa2,PK(2),o[d0],0,0,0);
    o[d0]=__builtin_amdgcn_mfma_f32_32x32x16_bf16(pa3,PK(3),o[d0],0,0,0);
    #undef PK
  }
}
template<int THRL> __device__ __forceinline__ void attn_unit_dv128(int qb,const bf16*__restrict__ QKVb,int qcol,int kcol,int vcol,bf16*Og,int ldo,char*shm,int est,int kncol,int first,int&ring,int qncol,int qbn,bf16x8&qp0,bf16x8&qp1,bf16x8&qp2,bf16x8&qp3){
  const bf16*Qg=QKVb+qcol,*Kg=QKVb+kcol,*Vg=QKVb+vcol,*Kn=QKVb+kncol,*Qn=QKVb+qncol;
  int tid_=threadIdx.x; asm volatile("":"+v"(tid_));
  const int tid=tid_,lane=tid&63,r32=lane&31,hi=lane>>5; const int wid=__builtin_amdgcn_readfirstlane(tid>>6);
  const int q0=qb*QB;
  const bf16*Qw=Qg+(long)(q0+wid*QBLK)*LDQ;
  const unsigned lds0=(unsigned)(uintptr_t)shm;
  float*wsf=(float*)(shm+X_WS)+wid*64;
  const bf16*ksrc=Kg+wid*8, *knsrc=Kn+wid*8;
  const bf16*vsrc=Vg+(long)(16*(wid&3))*LDQ+(wid>>2)*32;
  const unsigned koff=(unsigned)lane*(LDQ*2u), voff=(unsigned)(lane>>2)*(LDQ*2u)+(unsigned)(lane&3)*16u;
  const unsigned kdst=lds0+X_K+wid*1024, vdst=lds0+X_V+wid*1024;
  const int NT=(q0+QB)/KVBLK;
  #define DMA_K(t,slot) glds16(ksrc+(long)(t)*KVBLK*LDQ,koff,(unsigned)__builtin_amdgcn_readfirstlane(kdst+(slot)))
  #define DMA_V(t,vslot) do{ const bf16*s_=vsrc+(long)(t)*KVBLK*LDQ; glds16(s_,voff,(unsigned)__builtin_amdgcn_readfirstlane(vdst+(vslot))); glds16(s_+64,voff,(unsigned)__builtin_amdgcn_readfirstlane(vdst+(vslot)+8192)); }while(0)
  #define DMA_KX(t,slot) do{ const int t_=(t); const bf16*s_=(t_<NT)?(ksrc+(long)t_*KVBLK*LDQ):(knsrc+(long)(t_-NT)*KVBLK*LDQ); glds16(s_,koff,(unsigned)__builtin_amdgcn_readfirstlane(kdst+(slot))); }while(0)
  #define DMA_VX(t,vslot) do{ const int t_=(t); DMA_V((t_<NT)?t_:(t_-NT),vslot); }while(0)
  const int vb0=(int)(lds0+X_V)+((lane>>4)&1)*32+(lane&3)*8+(4*hi+((lane&15)>>2))*64;
  const int s0=ring, s1=(s0==(NSLOT-1)*SLOTB)?0:s0+SLOTB, s2=(s1==(NSLOT-1)*SLOTB)?0:s1+SLOTB;
  const char*Kbase=shm+X_K+s0; bf16x8 kf[8];
  const lds_cptr shm3=(lds_cptr)shm; const lds_cptr kp0=shm3+X_K+hi*1024+r32*16; const lds_cptr vp0=shm3+X_V+((lane>>4)&1)*32+(lane&3)*8+(4*hi+((lane&15)>>2))*64;
  if(first){DMA_K(0,s0);DMA_V(0,2*s0);DMA_K(1,s1);}
  bf16x8 qr[4];
  if(first){
    #pragma unroll
    for(int d0=0;d0<4;++d0)qr[d0]=*reinterpret_cast<const bf16x8*>(&Qw[(long)r32*LDQ+d0*16+hi*8]); }
  else{ qr[0]=qp0;qr[1]=qp1;qr[2]=qp2;qr[3]=qp3; }
  float mhat=0.f,l_reg=0.f;f32x16 o[4];o[0]=f32x16{};o[1]=f32x16{};o[2]=f32x16{};o[3]=f32x16{};const f32x16 zero16=f32x16{};
  const int qrel=wid*QBLK+r32;
  #define CMASK(P0,P1,t) do{ int jb_=(t)-(NT-4); if(jb_>=0)cmask(P0,P1,jb_,qrel,hi); }while(0)
  bool resc=false;
  #define RESC() do{ if(resc){ asm volatile("s_waitcnt lgkmcnt(0)":::"memory"); \
      _Pragma("unroll") for(int d_=0;d_<4;++d_) _Pragma("unroll") for(int r=0;r<16;++r)o[d_][r]*=wsf[crow(r,hi)]; } }while(0)
  f32x16 c0,c1; u32x4 pw0,pw1,pw2,pw3;
  int sl_prev=s0,sl_cur=s0,sl_next=s1;
  #define ROT() do{sl_prev=sl_cur;sl_cur=sl_next;sl_next=(sl_next==(NSLOT-1)*SLOTB)?0:sl_next+SLOTB;}while(0)
  if(first){DMA_K(2,s2);}
  WAIT_BAR(4);
  #define PKW(P,B) cvtpk_s(P[B],P[B+1])
  qkt(c0,c1,Kbase,qr,r32,hi);asm volatile("s_nop 15\n\ts_nop 7":"+v"(c0),"+v"(c1));CMASK(c0,c1,0);
  { float dl=0.f; if constexpr(!NOREF){ const float rm=rowmax(c0,c1); dl=(rm>-1e30f)?rm:0.f; } mhat=dl;
    #pragma unroll
    for(int r=0;r<16;++r){c0[r]=__builtin_amdgcn_exp2f(c0[r]-dl);c1[r]=__builtin_amdgcn_exp2f(c1[r]-dl);}
    float sa=0.f,sb=0.f;
    #pragma unroll
    for(int r=0;r<16;++r){sa+=c0[r];sb+=c1[r];}
    l_reg=sa+sb;
    pw0=(u32x4){PKW(c0,0),PKW(c0,2),PKW(c0,4),PKW(c0,6)};pw1=(u32x4){PKW(c0,8),PKW(c0,10),PKW(c0,12),PKW(c0,14)};pw2=(u32x4){PKW(c1,0),PKW(c1,2),PKW(c1,4),PKW(c1,6)};pw3=(u32x4){PKW(c1,8),PKW(c1,10),PKW(c1,12),PKW(c1,14)}; }
  WAIT_BAR(0);
  DMA_K(3,s0);DMA_V(1,2*s1);
  ROT();
  kload8(kf,kp0+sl_cur);
  WAIT_BAR(3);
  s16x4 vlo[4],vhi[4];
  #define PAF(k) __builtin_bit_cast(bf16x8,pw##k)
  #define VFR(i) (bf16x8){vlo[i][0],vlo[i][1],vlo[i][2],vlo[i][3],vhi[i][0],vhi[i][1],vhi[i][2],vhi[i][3]}
  #define PIN(x) asm volatile("":"+v"(x))
  #define MX3(a,b,c) __builtin_fmaxf(__builtin_fmaxf((a),(b)),(c))
  #define EX(v) __builtin_amdgcn_exp2f(v)
  #define VRDX(s,KS) do{ vlo[s]=vtr(vp_+((s)*4096+(KS)*1024)); vhi[s]=vtr(vp_+((s)*4096+(KS)*1024+512)); }while(0)
  #define QKA(MF) do{ MF; SBAR(); }while(0)
  #define GAPX(MF,X,B,RF) do{ MF; RF; X[B]=EX(X[B]); X[B+1]=EX(X[B+1]); sacc+=X[B]; sacc+=X[B+1]; PIN(sacc); PIN(X); SBAR(); }while(0)
  #define PACKW(PW,W,X,B) do{ PW[W]=PKW(X,B); PIN(PW); }while(0)
  #define KRD(G,j) do{ if(G){ kload2(kf,kp0+sl_next,j); SBAR(); } }while(0)
  #define STEP(t,GL) do{ SBAR(); \
    const lds_cptr vp_=vp0+2*sl_prev; \
    VRDX(0,0); SBAR(); QKA(c0=__builtin_amdgcn_mfma_f32_32x32x16_bf16(kf[0],qr[0],zero16,0,0,0)); \
    QKA(c1=__builtin_amdgcn_mfma_f32_32x32x16_bf16(kf[1],qr[0],zero16,0,0,0)); \
    VRDX(1,0); SBAR(); QKA(c0=__builtin_amdgcn_mfma_f32_32x32x16_bf16(kf[2],qr[1],c0,0,0,0)); \
    QKA(c1=__builtin_amdgcn_mfma_f32_32x32x16_bf16(kf[3],qr[1],c1,0,0,0)); \
    VRDX(2,0); SBAR(); QKA(c0=__builtin_amdgcn_mfma_f32_32x32x16_bf16(kf[4],qr[2],c0,0,0,0)); \
    QKA(c1=__builtin_amdgcn_mfma_f32_32x32x16_bf16(kf[5],qr[2],c1,0,0,0)); \
    VRDX(3,0); SBAR(); QKA(c0=__builtin_amdgcn_mfma_f32_32x32x16_bf16(kf[6],qr[3],c0,0,0,0)); \
    QKA(c1=__builtin_amdgcn_mfma_f32_32x32x16_bf16(kf[7],qr[3],c1,0,0,0)); \
    STEP_DMA(t); \
    if constexpr(NOREF){ CMASKX(c0,c1,t); resc=false; } else { \
    asm volatile("s_nop 7\n\ts_nop 7":"+v"(c0),"+v"(c1)); \
    _Pragma("unroll") for(int r=0;r<16;++r){c0[r]=fsub_s(c0[r],mhat);c1[r]=fsub_s(c1[r],mhat);} \
    CMASKX(c0,c1,t); \
    { float a=MX3(c0[0],c0[1],c1[0]),b=MX3(c0[2],c0[3],c1[1]); a=MX3(a,c1[2],c1[3]); \
      _Pragma("unroll") for(int r=4;r<16;r+=4){a=MX3(a,c0[r],c0[r+1]);b=MX3(b,c0[r+2],c0[r+3]);a=MX3(a,c1[r],c1[r+1]);b=MX3(b,c1[r+2],c1[r+3]);} \
      float rm=__builtin_fmaxf(a,b); { auto rr=__builtin_amdgcn_permlane32_swap(__float_as_uint(rm),__float_as_uint(rm),false,false); rm=__builtin_fmaxf(__uint_as_float(rr[0]),__uint_as_float(rr[1])); } \
      resc=false; \
      if(__builtin_expect(__any(rm>(float)THRL),0)){ const float dl=__builtin_fmaxf(rm,0.f); mhat+=dl; \
        _Pragma("unroll") for(int r=0;r<16;++r){c0[r]-=dl;c1[r]-=dl;} \
        const float f=__builtin_amdgcn_exp2f(-dl); l_reg*=f; if(hi==0)wsf[r32]=f; resc=true; } } \
    } \
    SBAR(); float sacc=0.f; \
    GAPX(o[0]=__builtin_amdgcn_mfma_f32_32x32x16_bf16(PAF(0),VFR(0),o[0],0,0,0), c0,0,  VRDX(0,1)); \
    GAPX(o[1]=__builtin_amdgcn_mfma_f32_32x32x16_bf16(PAF(0),VFR(1),o[1],0,0,0), c0,2,  VRDX(1,1)); \
    GAPX(o[2]=__builtin_amdgcn_mfma_f32_32x32x16_bf16(PAF(0),VFR(2),o[2],0,0,0), c0,4,  VRDX(2,1)); \
    GAPX(o[3]=__builtin_amdgcn_mfma_f32_32x32x16_bf16(PAF(0),VFR(3),o[3],0,0,0), c0,6,  VRDX(3,1)); \
    GAPX(o[0]=__builtin_amdgcn_mfma_f32_32x32x16_bf16(PAF(1),VFR(0),o[0],0,0,0), c0,8,  VRDX(0,2)); PACKW(pw0,0,c0,0); SBAR(); \
    GAPX(o[1]=__builtin_amdgcn_mfma_f32_32x32x16_bf16(PAF(1),VFR(1),o[1],0,0,0), c0,10, VRDX(1,2)); PACKW(pw0,1,c0,2); SBAR(); \
    GAPX(o[2]=__builtin_amdgcn_mfma_f32_32x32x16_bf16(PAF(1),VFR(2),o[2],0,0,0), c0,12, VRDX(2,2)); PACKW(pw0,2,c0,4); SBAR(); \
    GAPX(o[3]=__builtin_amdgcn_mfma_f32_32x32x16_bf16(PAF(1),VFR(3),o[3],0,0,0), c0,14, VRDX(3,2)); PACKW(pw0,3,c0,6); SBAR(); \
    KRD(GL,0); GAPX(o[0]=__builtin_amdgcn_mfma_f32_32x32x16_bf16(PAF(2),VFR(0),o[0],0,0,0), c1,0,  VRDX(0,3)); PACKW(pw1,0,c0,8);  SBAR(); \
    KRD(GL,1); GAPX(o[1]=__builtin_amdgcn_mfma_f32_32x32x16_bf16(PAF(2),VFR(1),o[1],0,0,0), c1,2,  VRDX(1,3)); PACKW(pw1,1,c0,10); SBAR(); \
    KRD(GL,2); GAPX(o[2]=__builtin_amdgcn_mfma_f32_32x32x16_bf16(PAF(2),VFR(2),o[2],0,0,0), c1,4,  VRDX(2,3)); PACKW(pw1,2,c0,12); SBAR(); \
    KRD(GL,3); GAPX(o[3]=__builtin_amdgcn_mfma_f32_32x32x16_bf16(PAF(2),VFR(3),o[3],0,0,0), c1,6,  VRDX(3,3)); PACKW(pw1,3,c0,14); SBAR(); \
    GAPX(o[0]=__builtin_amdgcn_mfma_f32_32x32x16_bf16(PAF(3),VFR(0),o[0],0,0,0), c1,8,  (void)0); PACKW(pw2,0,c1,0); SBAR(); \
    GAPX(o[1]=__builtin_amdgcn_mfma_f32_32x32x16_bf16(PAF(3),VFR(1),o[1],0,0,0), c1,10, (void)0); PACKW(pw2,1,c1,2); SBAR(); \
    GAPX(o[2]=__builtin_amdgcn_mfma_f32_32x32x16_bf16(PAF(3),VFR(2),o[2],0,0,0), c1,12, (void)0); PACKW(pw2,2,c1,4); SBAR(); \
    GAPX(o[3]=__builtin_amdgcn_mfma_f32_32x32x16_bf16(PAF(3),VFR(3),o[3],0,0,0), c1,14, (void)0); PACKW(pw2,3,c1,6); SBAR(); \
    PACKW(pw3,0,c1,8); PACKW(pw3,1,c1,10); PACKW(pw3,2,c1,12); PACKW(pw3,3,c1,14); \
    l_reg+=sacc; \
    }while(0)
  int t=1;
  #define CMASKX(P0,P1,t) do{}while(0)
  #define STEP_DMA(t) DMA_K((t)+3,sl_cur); DMA_V((t)+1,2*sl_next)
  for(;t+5<NT;t+=2){
    STEP(t,true);     WAIT_BAR(3); RESC(); ROT();
    STEP(t+1,true);   WAIT_BAR(3); RESC(); ROT();
  }
  #undef CMASKX
  #undef STEP_DMA
  #define CMASKX(P0,P1,t) CMASK(P0,P1,t)
  #define STEP_DMA(t) DMA_KX((t)+3,sl_cur); DMA_VX((t)+1,2*sl_next)
  for(;t+1<NT;t+=2){
    STEP(t,(t+1<NT));       WAIT_BAR(3); RESC(); ROT();
    STEP(t+1,(t+2<NT));     WAIT_BAR(3); RESC(); ROT();
  }
  STEP(NT-1,false); WAIT_BAR(3); RESC();
  ring=sl_next;
  #undef STEP_DMA
  #undef CMASKX
  SBAR(); pv128(o,vb0+2*sl_cur,PAF(0),PAF(1),PAF(2),PAF(3));
  #undef PKW
  #undef PAF
  #undef PACKW
  #undef VFR
  #undef PIN
  #undef MX3
  #undef EX
  #undef VRDX
  #undef QKA
  #undef GAPX
  #undef KRD
  #undef STEP
  { const bf16*Qnw=Qn+(long)(qbn*QB+wid*QBLK)*LDQ;
    qp0=*reinterpret_cast<const bf16x8*>(&Qnw[(long)r32*LDQ+0*16+hi*8]); qp1=*reinterpret_cast<const bf16x8*>(&Qnw[(long)r32*LDQ+1*16+hi*8]);
    qp2=*reinterpret_cast<const bf16x8*>(&Qnw[(long)r32*LDQ+2*16+hi*8]); qp3=*reinterpret_cast<const bf16x8*>(&Qnw[(long)r32*LDQ+3*16+hi*8]); }
  {auto rr=__builtin_amdgcn_permlane32_swap(__float_as_uint(l_reg),__float_as_uint(l_reg),false,false);l_reg=__uint_as_float(rr[0])+__uint_as_float(rr[1]);}
  if(hi==0)wsf[32+r32]=l_reg;asm volatile("s_waitcnt lgkmcnt(0)":::"memory");
  float rli[16];
  #pragma unroll
  for(int r=0;r<16;++r)rli[r]=__builtin_amdgcn_rcpf(wsf[32+crow(r,hi)]);
  bf16*st=(bf16*)(shm+X_ST)+wid*4096;
  if(est==1){
    #pragma unroll
    for(int r=0;r<16;++r){const int orow=crow(r,hi);
      #pragma unroll
      for(int d0=0;d0<4;++d0)st[orow*128+d0*32+r32]=__float2bfloat16(o[d0][r]*rli[r]);} }
  else{ const float*dc=(const float*)(shm+X_DC); const float lam=dc[128];
    #pragma unroll
    for(int r=0;r<16;++r){const int orow=crow(r,hi);
      #pragma unroll
      for(int d0=0;d0<4;++d0){const int idx=orow*128+d0*32+r32; const float o1=__bfloat162float(st[idx]); st[idx]=__float2bfloat16(o1-lam*(o[d0][r]*rli[r]));}}
    asm volatile("s_waitcnt lgkmcnt(0)":::"memory");
    bf16*Ow=Og+(long)(q0+wid*QBLK)*ldo; const int ch=lane&15;
    const f32x4 ga=*(const f32x4*)(dc+ch*8),gb=*(const f32x4*)(dc+ch*8+4);
    #pragma unroll
    for(int i=0;i<8;++i){const int row=i*4+(lane>>4); const u32x4 v=*(const u32x4*)(st+row*128+ch*8);
      float dv[8];
      #pragma unroll
      for(int e=0;e<4;++e){dv[2*e]=__uint_as_float(v[e]<<16);dv[2*e+1]=__uint_as_float(v[e]&0xffff0000u);}
      float ss=0.f;
      #pragma unroll
      for(int e=0;e<8;++e)ss+=dv[e]*dv[e];
      ss+=__shfl_xor(ss,1);ss+=__shfl_xor(ss,2);ss+=__shfl_xor(ss,4);ss+=__shfl_xor(ss,8);
      const float rs=1.0f/sqrtf(ss*(1.0f/128.0f)+1e-5f);
      u32x4 w; w[0]=cvtpk_s(dv[0]*rs*ga[0],dv[1]*rs*ga[1]); w[1]=cvtpk_s(dv[2]*rs*ga[2],dv[3]*rs*ga[3]); w[2]=cvtpk_s(dv[4]*rs*gb[0],dv[5]*rs*gb[1]); w[3]=cvtpk_s(dv[6]*rs*gb[2],dv[7]*rs*gb[3]);
      ATTN_STORE16(Ow+(long)row*ldo+ch*8,w); } }
  asm volatile("s_waitcnt lgkmcnt(0)\n\ts_barrier":::"memory");
  #undef DMA_K
  #undef DMA_V
  #undef DMA_KX
  #undef DMA_VX
  #undef CMASK
  #undef RESC
  #undef ROT
}
constexpr int ATTN_LDS_BYTES=LDS_BYTES;
#undef SBAR
#undef WAIT_BAR
}
#ifndef ATT_A_MODE
#define ATT_A_MODE 1
#endif
#ifndef ATT_B_MODE
#define ATT_B_MODE 2
#endif
#ifndef ATT_THRL
#define ATT_THRL 8
#endif

constexpr int NWAVES = 8;
constexpr int BATCH = 16, T = 2048, D = 1024, HD = 64, FF = 2816, NQKV = 3072;
constexpr int M = BATCH * T;
constexpr float NORM_EPS = 1e-5f;
constexpr float LAMBDA_INIT = 0.35550906759096934f;
static_assert(M == pg8::TOK, "row count");

constexpr size_t MiB = 1u << 20;
constexpr size_t WS_CTL = 0, CTL_ZERO_BYTES = 1 * MiB;
constexpr size_t WS_ROPE = 1 * MiB;
constexpr size_t WS_SSP = 3 * MiB;
constexpr size_t WS_KMP = 5 * MiB;
constexpr size_t WS_W = 6 * MiB, W_LAYER = 25 * MiB;
constexpr size_t W_IN = 0, W_OUT = 6 * MiB, W_GU = 8 * MiB, W_DN = 19 * MiB;
constexpr size_t WS_HB = 56 * MiB;
constexpr size_t WS_OB = 120 * MiB;
constexpr size_t WS_QKV = 184 * MiB;
constexpr size_t WS_OS = 376 * MiB;
constexpr size_t WS_END = 504 * MiB;
static_assert(WS_ROPE == pg8::XWS_ROPE && WS_SSP == pg8::XWS_SSP && WS_KMP == pg8::XWS_KMP && WS_HB == pg8::XWS_HB && WS_QKV == pg8::XWS_QKV, "d_ws map vs epilogues");
constexpr int CW_BAR = 4096;
constexpr int RING_OFF = 0, RING_BYTES = 131072;
constexpr int LDSCTL_OFF = 143360, MISC_OFF = LDSCTL_OFF + 320;
constexpr int PTAB_OFF = LDSCTL_OFF + 512;
constexpr int RTAB_OFF = LDSCTL_OFF + 1024;
constexpr int LDS_BYTES = 163840;
static_assert(attn_body::X_BYTES <= LDSCTL_OFF && attn_body::DIL_LUT_OFF == RTAB_OFF && attn_body::DIL_LUT_OFF + 4 * attn_body::DIL_LUT_N <= LDS_BYTES && attn_body::ATTN_LDS_BYTES_DIFF <= RING_BYTES && RTAB_OFF + 11 * 1024 <= LDS_BYTES && MISC_OFF + 128 <= PTAB_OFF && PTAB_OFF + 160 <= RTAB_OFF, "LDS map");

#define GAS __attribute__((address_space(1)))
#define LAS __attribute__((address_space(3)))
typedef unsigned short bf16;
typedef unsigned v4u __attribute__((ext_vector_type(4)));
typedef unsigned v2u __attribute__((ext_vector_type(2)));
typedef float f32x4 __attribute__((ext_vector_type(4)));
typedef GAS unsigned gu32;
#define RLX_AGENT __ATOMIC_RELAXED, __HIP_MEMORY_SCOPE_AGENT
#define LDS_WAIT() asm volatile("s_waitcnt lgkmcnt(0)" ::: "memory")
#define VM_WAIT() asm volatile("s_waitcnt vmcnt(0)" ::: "memory")
__device__ __forceinline__ unsigned f2bf(float f) { unsigned u = __builtin_bit_cast(unsigned, f); return (u + 0x7fffu + ((u >> 16) & 1u)) >> 16; }
__device__ __forceinline__ unsigned pk2(float lo, float hi) { return f2bf(lo) | (f2bf(hi) << 16); }
__device__ __forceinline__ float bf_lo(unsigned w) { return __uint_as_float(w << 16); }
__device__ __forceinline__ float bf_hi(unsigned w) { return __uint_as_float(w & 0xffff0000u); }

#define XB_TMO      128
#define XB_XCNT(j)  (256  + 64 * (j))
#define XB_XSUB(j)  (1280 + 64 * (j))
#define XB_XGEN(j)  (2304 + 64 * (j))
#define XB_TOP      3328
#define XB_TOPGEN   3392
#define XCD_BAR_WORDS 3456
#define XB_SPIN_CAP (1u << 18)

__device__ __forceinline__ unsigned xb_ld(unsigned* p)              { return __hip_atomic_load(p, __ATOMIC_RELAXED, __HIP_MEMORY_SCOPE_AGENT); }
__device__ __forceinline__ unsigned xb_add(unsigned* p, unsigned v) { return __hip_atomic_fetch_add(p, v, __ATOMIC_RELAXED, __HIP_MEMORY_SCOPE_AGENT); }
__device__ __forceinline__ unsigned xb_xcc_id() { return (unsigned)__builtin_amdgcn_s_getreg((3 << 11) | 20) & 0xFu; }
#define XB_SPIN(cond, bar) do { unsigned _sp = 0; while (cond) { __builtin_amdgcn_s_sleep(1); \
    if ((++_sp & 255u) == 0u) { if (xb_ld(&(bar)[XB_TMO])) break; if (_sp > XB_SPIN_CAP) { atomicAdd(&(bar)[XB_TMO], 1u); break; } } } } while (0)

struct XcdBarrier {
    unsigned* bar; unsigned x;
    volatile LAS unsigned* st;
};

__device__ __forceinline__ XcdBarrier xcd_barrier_post(unsigned* bar, volatile LAS unsigned* st) {
    XcdBarrier b; b.bar = bar; b.x = xb_xcc_id(); b.st = st;
    if (threadIdx.x == 0) (void)xb_add(&bar[XB_XCNT(b.x)], 1u);
    return b;
}
__device__ __forceinline__ void xcd_barrier_complete(unsigned* bar, unsigned x, unsigned& nloc, unsigned& nx) {
    const unsigned G = gridDim.x * gridDim.y * gridDim.z;
    unsigned sum, cnt, mine, sp = 0u;
    for (;;) {
        sum = 0u; cnt = 0u; mine = 0u;
#pragma unroll
        for (unsigned j = 0; j < 16; ++j) { const unsigned c = xb_ld(&bar[XB_XCNT(j)]); sum += c; cnt += (c > 0u) ? 1u : 0u; mine = (j == x) ? c : mine; }
        if (sum == G) break;
        __builtin_amdgcn_s_sleep(1);
        if ((++sp & 255u) == 0u) { if (xb_ld(&bar[XB_TMO])) break; if (sp > XB_SPIN_CAP) { atomicAdd(&bar[XB_TMO], 1u); break; } }
    }
    nloc = mine > 0u ? mine : 1u; nx = cnt > 0u ? cnt : 1u;
}

__device__ __forceinline__ void xcd_barrier(const XcdBarrier& b) {
    asm volatile("s_waitcnt vmcnt(0)" ::: "memory");
    __syncthreads();
    if (threadIdx.x == 0) {
        unsigned* bar = b.bar;
        __builtin_amdgcn_s_waitcnt(0);
        unsigned nloc = b.st[0], nx = b.st[1];
        if (nloc == 0u) { xcd_barrier_complete(bar, b.x, nloc, nx); b.st[0] = nloc; b.st[1] = nx; }
        const unsigned old = xb_add(&bar[XB_XSUB(b.x)], 1u);
        const unsigned gen = old / nloc;
        if (old + 1u == (gen + 1u) * nloc) {
            __builtin_amdgcn_fence(__ATOMIC_RELEASE, "agent");
            asm volatile("s_waitcnt vmcnt(0)" ::: "memory");
            const unsigned og = xb_add(&bar[XB_TOP], 1u);
            const unsigned tg = og / nx;
            if (og + 1u == (tg + 1u) * nx) xb_add(&bar[XB_TOPGEN], 1u);
            else XB_SPIN(xb_ld(&bar[XB_TOPGEN]) == tg, bar);
            __builtin_amdgcn_fence(__ATOMIC_ACQUIRE, "agent");
            xb_add(&bar[XB_XGEN(b.x)], 1u);
            asm volatile("s_waitcnt vmcnt(0)" ::: "memory");
        } else {
            XB_SPIN(xb_ld(&bar[XB_XGEN(b.x)]) == gen, bar);
            __builtin_amdgcn_fence(__ATOMIC_ACQUIRE, "agent");
            asm volatile("s_waitcnt vmcnt(0)" ::: "memory");
        }
    }
    __syncthreads();
}


struct Frame {
    LAS unsigned char* lds;
    volatile LAS unsigned* MISC;
    gu32* ctl;
    int tid, lane, wave;
    int vcu, G, bx;
};
#ifndef FIN_ST
#define FIN_ST 1
#endif
#ifndef P0_ST
#define P0_ST 0
#endif
__device__ __forceinline__ float wave_sum(float v) {
#pragma unroll
    for (int o = 1; o < 64; o <<= 1) v += __shfl_xor(v, o);
    return v;
}
__device__ __forceinline__ void p0_transpose_item(const float* W, const float* g, int K, int N, bf16* WT, int mode, LAS float* scr, int item, int lane) {
    const int nblk = N / 32, kb = item / nblk, nb = item % nblk, k0 = 64 * kb, n0 = 32 * nb;
    const int orow = (mode == 0) ? n0 : (256 * (n0 >> 7) + (n0 & 127) + (mode == 2 ? 128 : 0));
    f32x4 w[8];
#pragma unroll
    for (int i = 0; i < 8; ++i) w[i] = MEM_NT ? __builtin_nontemporal_load((const GAS f32x4*)(W + (size_t)(k0 + 8 * i + (lane >> 3)) * N + n0 + 4 * (lane & 7))) : *(const GAS f32x4*)(W + (size_t)(k0 + 8 * i + (lane >> 3)) * N + n0 + 4 * (lane & 7));
    if (g) {
#pragma unroll
        for (int i = 0; i < 8; ++i) w[i] = w[i] * g[k0 + 8 * i + (lane >> 3)];
    }
#pragma unroll
    for (int i = 0; i < 8; ++i) { LAS float* d = scr + (8 * i + (lane >> 3)) * 33 + 4 * (lane & 7); d[0] = w[i].x; d[1] = w[i].y; d[2] = w[i].z; d[3] = w[i].w; }
    LDS_WAIT(); asm volatile("" ::: "memory");
    const int c = lane & 7;
#pragma unroll
    for (int j = 0; j < 4; ++j) { const int n = (lane >> 3) + 8 * j; const LAS float* s = scr + (8 * c) * 33 + n;
        v4u o; o.x = pk2(s[0 * 33], s[1 * 33]); o.y = pk2(s[2 * 33], s[3 * 33]); o.z = pk2(s[4 * 33], s[5 * 33]); o.w = pk2(s[6 * 33], s[7 * 33]);
        if (P0_ST == 2) ST16_SC1((GAS v4u*)(WT + (size_t)(orow + n) * K + k0 + 8 * c), o); else *(GAS v4u*)(WT + (size_t)(orow + n) * K + k0 + 8 * c) = o; }
    LDS_WAIT(); asm volatile("" ::: "memory");
}

struct Args { const void* in[18]; float* out; unsigned char* ws; };

template <class Sched> __device__ __forceinline__ void prep_rtab(Frame& F, const Sched& S, const float* ssp, int nparts) {
    LAS float* rt = (LAS float*)(F.lds + RTAB_OFF);
    pg8::Unit u;
    for (int i = 0; S.next(i, u); ++i) {
        if ((i & 1) == (F.tid >> 8)) {
            const int rl = F.tid & 255; const int row = u.pm * 256 + rl; float s = 0.f;
            for (int j = 0; j < nparts; ++j) s += ssp[(size_t)j * M + row];
            rt[i * 256 + rl] = 1.0f / sqrtf(s * (1.0f / D) + NORM_EPS);
        }
    }
    LDS_WAIT(); __syncthreads();
}


__device__ __forceinline__ unsigned char* get_ptr(volatile LAS unsigned* t, int k) {
    { unsigned a_ = (unsigned)(uintptr_t)t; asm volatile("" : "+v"(a_)); t = (volatile LAS unsigned*)a_; }
    const unsigned lo = (unsigned)__builtin_amdgcn_readfirstlane((int)t[2 * k]), hi = (unsigned)__builtin_amdgcn_readfirstlane((int)t[2 * k + 1]);
    unsigned long long v = (unsigned long long)lo | ((unsigned long long)hi << 32); asm volatile("" : "+s"(v)); return (unsigned char*)(GAS unsigned char*)v; }
#define PTAB ((volatile LAS unsigned*)((LAS unsigned char*)lds + PTAB_OFF))
#define IN_PTR(T, k) ((T*)get_ptr(PTAB, (k)))
#define OUT_PTR() ((float*)get_ptr(PTAB, 18))
#define WS_BASE() (get_ptr(PTAB, 19))
#define WS_PTR(T, off) ((T*)(WS_BASE() + (off)))
__device__ __forceinline__ int vcu_of(int bx, int G) { return (G % 8 == 0) ? (bx % 8) * (G / 8) + bx / 8 : bx; }
#define GRID_BAR() do { XcdBarrier b_; b_.bar = WS_PTR(unsigned, WS_CTL) + CW_BAR; b_.x = xb_xcc_id(); b_.st = (volatile LAS unsigned*)((LAS unsigned char*)lds + MISC_OFF) + 8; xcd_barrier(b_); } while (0)
constexpr int CW_GRP = 8192;
__device__ __forceinline__ void group_barrier(unsigned* cnt, unsigned nmemb, unsigned* tmo) {
    asm volatile("s_waitcnt vmcnt(0)" ::: "memory");
    __syncthreads();
    if (threadIdx.x == 0) {
        __builtin_amdgcn_fence(__ATOMIC_RELEASE, "agent");
        asm volatile("s_waitcnt vmcnt(0)" ::: "memory");
        const unsigned old = __hip_atomic_fetch_add(cnt, 1u, __ATOMIC_RELAXED, __HIP_MEMORY_SCOPE_AGENT);
        const unsigned target = (old / nmemb + 1u) * nmemb;
        unsigned sp = 0u;
        while (__hip_atomic_load(cnt, __ATOMIC_RELAXED, __HIP_MEMORY_SCOPE_AGENT) < target) {
            __builtin_amdgcn_s_sleep(1);
            if ((++sp & 255u) == 0u) { if (__hip_atomic_load(tmo, __ATOMIC_RELAXED, __HIP_MEMORY_SCOPE_AGENT)) break; if (sp > (1u << 20)) { atomicAdd(tmo, 1u); break; } }
        }
        __builtin_amdgcn_fence(__ATOMIC_ACQUIRE, "agent");
        asm volatile("s_waitcnt vmcnt(0)" ::: "memory");
    }
    __syncthreads();
}
__device__ __forceinline__ int opq_s(int v) { asm volatile("" : "+s"(v)); return v; }
__device__ __forceinline__ int opq_v(int v) { asm volatile("" : "+v"(v)); return v; }
#define GROUP_ID() (2 * (opq_s(blockIdx.x) & 7) + ((opq_s(blockIdx.x) >> 3) >> 4))
#define GROUP_BAR() do { unsigned* c_ = WS_PTR(unsigned, WS_CTL); group_barrier(c_ + CW_GRP + 64 * GROUP_ID(), 16u, c_ + CW_BAR + XB_TMO); } while (0)
#ifndef GRP_BAR
#define GRP_BAR 1
#endif
#if GRP && GRP_BAR
#define PHASE_BAR() GROUP_BAR()
#else
#define PHASE_BAR() GRID_BAR()
#endif
#define MK_FRAME() Frame F; F.lds = (LAS unsigned char*)lds; F.MISC = (volatile LAS unsigned*)(F.lds + MISC_OFF); F.ctl = nullptr; F.tid = opq_v(threadIdx.x); F.lane = F.tid & 63; \
    F.wave = __builtin_amdgcn_readfirstlane(F.tid >> 6); F.G = opq_s(gridDim.x); F.bx = opq_s(blockIdx.x); F.vcu = vcu_of(F.bx, F.G)


#ifndef REP_P0
#define REP_P0 1
#endif
#ifndef REP_QKV
#define REP_QKV 1
#endif
#ifndef REP_ATTN0
#define REP_ATTN0 1
#endif
#ifndef REP_ATTN1
#define REP_ATTN1 1
#endif
#ifndef REP_COMB
#define REP_COMB 1
#endif
#ifndef REP_OUT0
#define REP_OUT0 1
#endif
#ifndef REP_UP
#define REP_UP 1
#endif
#define REPEAT(n) for (int rep_ = 0; rep_ < opq_s(n); ++rep_)
__global__ void __launch_bounds__(NWAVES * 64, 2) mk_fwd(Args args) {
    extern __shared__ __attribute__((aligned(16))) unsigned char lds[];
    for (int u = threadIdx.x; u < (LDS_BYTES - LDSCTL_OFF) / 4; u += NWAVES * 64) ((LAS unsigned*)((LAS unsigned char*)lds + LDSCTL_OFF))[u] = 0u;
    __syncthreads();
    if (threadIdx.x < 20) { const unsigned long long v = threadIdx.x < 18 ? (unsigned long long)args.in[threadIdx.x < 18 ? threadIdx.x : 0] : (threadIdx.x == 18 ? (unsigned long long)args.out : (unsigned long long)args.ws);
        PTAB[2 * threadIdx.x] = (unsigned)v; PTAB[2 * threadIdx.x + 1] = (unsigned)(v >> 32); }
    LDS_WAIT(); __syncthreads();
    (void)xcd_barrier_post(WS_PTR(unsigned, WS_CTL) + CW_BAR, (volatile LAS unsigned*)((LAS unsigned char*)lds + MISC_OFF) + 8);

#ifndef SKIP_P0
    REPEAT(REP_P0) {
        MK_FRAME();
        unsigned char* ws = WS_BASE();
        const int gw = F.vcu * NWAVES + F.wave, NGW = F.G * NWAVES;
        LAS float* scr = (LAS float*)(F.lds + RING_OFF + F.wave * 16384);
        constexpr int I_IN = (D / 64) * (NQKV / 32), I_OUT = (D / 64) * (D / 32), I_G = (D / 64) * (FF / 32), I_D = (FF / 64) * (D / 32);
        constexpr int I_LAYER = I_IN + I_OUT + 2 * I_G + I_D, NITEMS = 2 * I_LAYER;
        for (int it = gw; it < NITEMS; it += NGW) {
            const int L = it / I_LAYER; int r = it % I_LAYER;
            unsigned char* wl = ws + WS_W + (size_t)L * W_LAYER;
            const float* ffn_g = IN_PTR(const float, 13) + (size_t)L * D;
            if (r < I_IN) { p0_transpose_item(IN_PTR(const float, L ? 6 : 3), IN_PTR(const float, L ? 5 : 2), D, NQKV, (bf16*)(wl + W_IN), 0, scr, r, F.lane); continue; } r -= I_IN;
            if (r < I_OUT) { p0_transpose_item(IN_PTR(const float, L ? 7 : 4), nullptr, D, D, (bf16*)(wl + W_OUT), 0, scr, r, F.lane); continue; } r -= I_OUT;
            if (r < I_G) { p0_transpose_item(IN_PTR(const float, 14) + (size_t)L * D * FF, ffn_g, D, FF, (bf16*)(wl + W_GU), 1, scr, r, F.lane); continue; } r -= I_G;
            if (r < I_G) { p0_transpose_item(IN_PTR(const float, 15) + (size_t)L * D * FF, ffn_g, D, FF, (bf16*)(wl + W_GU), 2, scr, r, F.lane); continue; } r -= I_G;
            p0_transpose_item(IN_PTR(const float, 16) + (size_t)L * FF * D, nullptr, FF, D, (bf16*)(wl + W_DN), 0, scr, r, F.lane);
        }
        const float* x = IN_PTR(const float, 0);
        bf16* HB = (bf16*)(ws + WS_HB); float* ssp = (float*)(ws + WS_SSP);
        for (int m0 = gw; m0 < M; m0 += 2 * NGW) {
            f32x4 v[2][4];
#pragma unroll
            for (int q = 0; q < 2; ++q) { const int mq = (m0 + q * NGW < M) ? m0 + q * NGW : m0; const GAS f32x4* xr = (const GAS f32x4*)(x + (size_t)mq * D) + F.lane;
#pragma unroll
                for (int j = 0; j < 4; ++j) v[q][j] = MEM_NT ? __builtin_nontemporal_load(xr + 64 * j) : xr[64 * j]; }
#pragma unroll
            for (int q = 0; q < 2; ++q) { const int m = (m0 + q * NGW < M) ? m0 + q * NGW : m0; float s = 0.f;
#pragma unroll
                for (int j = 0; j < 4; ++j) s += (v[q][j].x * v[q][j].x + v[q][j].y * v[q][j].y) + (v[q][j].z * v[q][j].z + v[q][j].w * v[q][j].w);
                s = wave_sum(s);
                GAS unsigned long long* o8 = (GAS unsigned long long*)(HB + (size_t)m * D) + F.lane;
#pragma unroll
                for (int j = 0; j < 4; ++j) { const unsigned long long pv = (unsigned long long)pk2(v[q][j].x, v[q][j].y) | ((unsigned long long)pk2(v[q][j].z, v[q][j].w) << 32); if (P0_ST == 2) ST8_SC1(o8 + 64 * j, pv); else if (P0_ST == 1) __builtin_nontemporal_store(pv, o8 + 64 * j); else o8[64 * j] = pv; }
                if (F.lane == 0) ssp[m] = s; }
        }
        const int* pos = IN_PTR(const int, 1); float* rope = (float*)(ws + WS_ROPE);
        for (int idx = gw * 64 + F.lane; idx < M * 8; idx += NGW * 64) {
            const int row = idx >> 3, i = idx & 7;
            const float invf = i == 0 ? 1.0f : i == 1 ? 0.1939227432012558f : i == 2 ? 0.03760603070259094f : i == 3 ? 0.007292664609849453f :
                               i == 4 ? 0.0014142135623842478f : i == 5 ? 0.00027424818836152554f : i == 6 ? 5.3182957344688475e-05f : 1.0313385246263351e-05f;
            const float ang = (float)pos[row] * invf;
            float sn, cs; sincosf(ang, &sn, &cs);
            rope[(size_t)row * 16 + i] = cs; rope[(size_t)row * 16 + 8 + i] = sn;
        }
    }
#endif
    GRID_BAR();
#if GRP
#ifndef STAGGER_SLEEPS
#define STAGGER_SLEEPS 4
#endif
    for (int i_ = 0; i_ < ((opq_s(blockIdx.x) >> 3) >> 4) * STAGGER_SLEEPS; ++i_) __builtin_amdgcn_s_sleep(127);
#endif

#pragma unroll 1
    for (int L = 0; L < 2; ++L) {
#ifndef SKIP_QKV
        REPEAT(REP_QKV) {
            MK_FRAME();
            unsigned char* ws = WS_BASE();
            pg8::Gemm g{(const bf16*)(ws + WS_HB), (const bf16*)(ws + WS_W + (size_t)L * W_LAYER + W_IN), M, NQKV, D}; pg8::QkvOrder S; S.init(M, NQKV, F.G, F.bx);
            prep_rtab(F, S, (const float*)(ws + WS_SSP), L == 0 ? 1 : 16);
            pg8::EpiQKV E{PTAB, (const LAS float*)(F.lds + RTAB_OFF), L == 0 ? 0x3CFu : 0xFFu, L == 0 ? 0xC3u : 0x0Fu, L == 0 ? 0x300u : 0u, attn_body::C2};
            pg8::gemm_phase<pg8::EpiQKV, pg8::QkvOrder, PG8_ALIGN, PG8_SP2>(F.lds + RING_OFF, g, S, E);
        }
#endif
        PHASE_BAR();
        if (L == 0) {
#ifndef SKIP_ATTN0
            const int G = opq_s(gridDim.x);
            {
                LAS float* lut = (LAS float*)((LAS unsigned char*)lds + RING_OFF + attn_body::DIL_LUT_OFF);
#pragma clang loop vectorize(disable) unroll(disable)
                for (int i = opq_v(threadIdx.x); i < attn_body::DIL_LUT_N; i += NWAVES * 64) ((volatile LAS float*)lut)[i] = attn_body::dil_bias(opq_v(i) - 256);
                LDS_WAIT(); __syncthreads();
            }
            REPEAT(REP_ATTN0) for (int it = vcu_of(opq_s(blockIdx.x), G); it < 256; it += G) {
                const int p = it >> 1, par = it & 1, b = p >> 3, hh = p & 7;
                int ring = 0, first = 1;
                attn_body::bf16x8 qp0 = {}, qp1 = {}, qp2 = {}, qp3 = {};
#pragma unroll 1
                for (int k = 0; k < 4; ++k) {
                    const int qb = par == 0 ? (k == 0 ? 7 : k == 1 ? 4 : k == 2 ? 3 : 0) : (k == 0 ? 6 : k == 1 ? 5 : k == 2 ? 2 : 1);
                    const int k1 = k < 3 ? k + 1 : 3, qb1 = par == 0 ? (k1 == 0 ? 7 : k1 == 1 ? 4 : k1 == 2 ? 3 : 0) : (k1 == 0 ? 6 : k1 == 1 ? 5 : k1 == 2 ? 2 : 1);
                    {
                        const attn_body::bf16* qkvb = WS_PTR(const attn_body::bf16, WS_QKV) + (size_t)b * T * NQKV + 64 * hh;
                        attn_body::bf16* ob = WS_PTR(attn_body::bf16, WS_OB) + (size_t)b * T * D + 64 * hh;
                        attn_body::attn_unit<ATT_A_MODE, ATT_THRL>(qb, qkvb, 0, 512, 1024, ob, D, nullptr, (char*)lds + RING_OFF, 0, 2048, 2560, first, ring, 1536, qb, qp0, qp1, qp2, qp3);
                        first = 0;
                    }
                    {
                        const attn_body::bf16* qkvb = WS_PTR(const attn_body::bf16, WS_QKV) + (size_t)b * T * NQKV + 64 * hh;
                        attn_body::bf16* ob = WS_PTR(attn_body::bf16, WS_OB) + (size_t)b * T * D + 64 * hh;
                        const float* km0 = WS_PTR(const float, WS_KMP) + (size_t)(b * 8) * 512 + 64 * hh;
                        attn_body::attn_unit<ATT_B_MODE, ATT_THRL>(qb, qkvb, 1536, 2048, 2560, ob + 512, D, km0, (char*)lds + RING_OFF, 0, 512, 1024, 0, ring, 0, qb1, qp0, qp1, qp2, qp3);
                    }
                }
                VM_WAIT(); __syncthreads();
            }
#ifdef XABL
            for (int it = vcu_of(opq_s(blockIdx.x), G); it < 256; it += G) {
                const int p = it >> 1, b = p >> 3, hh = p & 7;
                int ring = 0; attn_body::bf16x8 qp0 = {}, qp1 = {}, qp2 = {}, qp3 = {};
#pragma unroll 1
                for (int k = 0; k < 8; ++k) {
                    const attn_body::bf16* qkvb = WS_PTR(const attn_body::bf16, WS_QKV) + (size_t)b * T * NQKV + 64 * hh;
                    attn_body::bf16* osb = WS_PTR(attn_body::bf16, WS_OS) + (size_t)b * T * 2048 + 64 * hh;
                    attn_body::attn_unit<0, 8, XABL>(7, qkvb, 0, 512, 1024, osb, 2048, nullptr, (char*)lds + RING_OFF, 0, 512, 1024, k == 0 ? 1 : 0, ring, 0, 7, qp0, qp1, qp2, qp3);
                }
                VM_WAIT(); __syncthreads();
            }
#endif
#endif
        } else {
#ifndef SKIP_ATTN1
            const int G = opq_s(gridDim.x);
            {
                LAS float* dc = (LAS float*)((LAS unsigned char*)lds + RING_OFF + attn_body::X_DC);
                const int tid = opq_v(threadIdx.x);
                if (tid < 128) dc[tid] = IN_PTR(const float, 12)[tid] * (1.0f - LAMBDA_INIT);
                if (tid < 64) {
                    const float s1 = wave_sum(IN_PTR(const float, 8)[tid] * IN_PTR(const float, 9)[tid]), s2 = wave_sum(IN_PTR(const float, 10)[tid] * IN_PTR(const float, 11)[tid]);
                    if (tid == 0) dc[128] = expf(s1) - expf(s2) + LAMBDA_INIT;
                }
                LDS_WAIT(); __syncthreads();
            }
            REPEAT(REP_ATTN1) for (int it = vcu_of(opq_s(blockIdx.x), G); it < 256; it += G) {
                const int p = it >> 1, par = it & 1, b = p >> 3, h = p & 7;
                int ring = 0; attn_body::bf16x8 qp0 = {}, qp1 = {}, qp2 = {}, qp3 = {};
#pragma unroll 1
                for (int k = 0; k < 8; ++k) {
                    const int kq = k >> 1, i = k & 1, in_ = (k + 1) & 1;
                    const int qb = par == 0 ? (kq == 0 ? 7 : kq == 1 ? 4 : kq == 2 ? 3 : 0) : (kq == 0 ? 6 : kq == 1 ? 5 : kq == 2 ? 2 : 1);
                    const int kqn = (k < 7 ? k + 1 : 7) >> 1, qbn = par == 0 ? (kqn == 0 ? 7 : kqn == 1 ? 4 : kqn == 2 ? 3 : 0) : (kqn == 0 ? 6 : kqn == 1 ? 5 : kqn == 2 ? 2 : 1);
                    const attn_body::bf16* qkvb = WS_PTR(const attn_body::bf16, WS_QKV) + (size_t)b * T * NQKV;
                    attn_body::bf16* ob = WS_PTR(attn_body::bf16, WS_OB) + (size_t)b * T * D + 128 * h;
                    attn_body::attn_unit_dv128<ATT_THRL>(qb, qkvb, 64 * (2 * h + i), 1024 + 64 * (2 * h + i), 2048 + 128 * h, ob, D, (char*)lds + RING_OFF, i == 0 ? 1 : 3,
                                                  1024 + 64 * (2 * h + in_), k == 0 ? 1 : 0, ring, 64 * (2 * h + in_), qbn, qp0, qp1, qp2, qp3);
                }
                VM_WAIT(); __syncthreads();
            }
#endif
        }
        PHASE_BAR();
#ifndef SKIP_OUT
        {
            MK_FRAME();
            unsigned char* ws = WS_BASE();
            pg8::Gemm g{(const bf16*)(ws + WS_OB), (const bf16*)(ws + WS_W + (size_t)L * W_LAYER + W_OUT), M, D, D}; pg8::PhaseOrder S; S.init(M, D, F.G, F.bx);
            pg8::EpiResid E{PTAB};
            pg8::gemm_phase<pg8::EpiResid, pg8::PhaseOrder, PG8_ALIGN, PG8_SP2>(F.lds + RING_OFF, g, S, E);
        }
#endif
#ifndef XEPI
#define XEPI 1
#endif
#ifdef XOUT
        for (int xr = 0; xr < opq_s(XOUT); ++xr) {
            GRID_BAR();
            MK_FRAME();
            unsigned char* ws = WS_BASE();
            pg8::Gemm g{(const bf16*)(ws + WS_OB), (const bf16*)(ws + WS_W + (size_t)L * W_LAYER + W_OUT), M, D, D}; pg8::StaticOrder S; S.init(M, D, F.G, F.bx);
            pg8::EpiResidT<XEPI> E{PTAB};
            pg8::gemm_phase<pg8::EpiResidT<XEPI>, pg8::StaticOrder, PG8_ALIGN, PG8_SP2>(F.lds + RING_OFF, g, S, E);
        }
#endif
#ifndef XCLK_SRC
#define XCLK_SRC WS_HB
#endif
#ifdef XCLK
        {
            MK_FRAME();
            unsigned char* ws = WS_BASE();
            attn_body::bf16x8 xa = *(const GAS attn_body::bf16x8*)(ws + XCLK_SRC + (size_t)F.tid * 16), xb = *(const GAS attn_body::bf16x8*)(ws + XCLK_SRC + 65536 + (size_t)F.tid * 16);
            attn_body::f32x16 c0 = {}, c1 = {}, c2 = {}, c3 = {};
            for (int i = 0; i < opq_s(XCLK); ++i) {
                c0 = __builtin_amdgcn_mfma_f32_32x32x16_bf16(xa, xb, c0, 0, 0, 0); c1 = __builtin_amdgcn_mfma_f32_32x32x16_bf16(xb, xa, c1, 0, 0, 0);
                c2 = __builtin_amdgcn_mfma_f32_32x32x16_bf16(xa, xa, c2, 0, 0, 0); c3 = __builtin_amdgcn_mfma_f32_32x32x16_bf16(xb, xb, c3, 0, 0, 0);
            }
            asm volatile("" :: "v"(c0), "v"(c1), "v"(c2), "v"(c3));
        }
#endif
#ifdef XDOWN
        for (int xr = 0; xr < opq_s(XDOWN); ++xr) {
            GRID_BAR();
            MK_FRAME();
            unsigned char* ws = WS_BASE();
            pg8::Gemm g{(const bf16*)(ws + WS_QKV), (const bf16*)(ws + WS_W + (size_t)L * W_LAYER + W_DN), M, D, FF}; pg8::StaticOrder S; S.init(M, D, F.G, F.bx);
            pg8::EpiResidT<XEPI> E{PTAB};
            pg8::gemm_phase<pg8::EpiResidT<XEPI>, pg8::StaticOrder, PG8_ALIGN, PG8_SP2>(F.lds + RING_OFF, g, S, E);
        }
#endif
        PHASE_BAR();
#ifndef SKIP_UP
        REPEAT(REP_UP) {
            MK_FRAME();
            unsigned char* ws = WS_BASE();
            pg8::Gemm g{(const bf16*)(ws + WS_HB), (const bf16*)(ws + WS_W + (size_t)L * W_LAYER + W_GU), M, 2 * FF, D}; pg8::PhaseOrder S; S.init(M, 2 * FF, F.G, F.bx);
            prep_rtab(F, S, (const float*)(ws + WS_SSP), 16);
            pg8::EpiSwiGLU E{PTAB, (const LAS float*)(F.lds + RTAB_OFF)};
            pg8::gemm_phase<pg8::EpiSwiGLU, pg8::PhaseOrder, PG8_ALIGN, PG8_SP2>(F.lds + RING_OFF, g, S, E);
        }
#endif
        PHASE_BAR();
#ifndef SKIP_DOWN
        {
            MK_FRAME();
            unsigned char* ws = WS_BASE();
            pg8::Gemm g{(const bf16*)(ws + WS_QKV + (GRP ? (size_t)GROUP_ID() * MiB : (size_t)0)), (const bf16*)(ws + WS_W + (size_t)L * W_LAYER + W_DN), M, D, FF}; pg8::PhaseOrder S; S.init(M, D, F.G, F.bx);
            pg8::EpiResid E{PTAB};
            pg8::gemm_phase<pg8::EpiResid, pg8::PhaseOrder, PG8_ALIGN, PG8_SP2>(F.lds + RING_OFF, g, S, E);
        }
#endif
        PHASE_BAR();
    }
#ifndef SKIP_FINAL
    {
        MK_FRAME();
        unsigned char* ws = WS_BASE();
#if GRP
        const int gw = ((F.bx >> 3) & 15) * NWAVES + F.wave, NGW = 16 * NWAVES, row0 = GROUP_ID() * T, nrow = T;
#else
        const int gw = F.vcu * NWAVES + F.wave, NGW = F.G * NWAVES, row0 = 0, nrow = M;
#endif
        float* out = OUT_PTR();
        const bf16* HB = (const bf16*)(ws + WS_HB); const float* ssp = (const float*)(ws + WS_SSP);
        const float* gf = IN_PTR(const float, 17);
        f32x4 gv[2][2];
#pragma unroll
        for (int j = 0; j < 2; ++j) { gv[j][0] = *(const GAS f32x4*)(gf + 512 * j + 8 * F.lane); gv[j][1] = *(const GAS f32x4*)(gf + 512 * j + 8 * F.lane + 4); }
        for (int mm = gw; mm < nrow; mm += NGW) {
            const int m = row0 + mm; float s = 0.f;
#pragma unroll
            for (int j = 0; j < 16; ++j) s += ssp[(size_t)j * M + m];
            const float rs = 1.0f / sqrtf(s * (1.0f / D) + NORM_EPS);
#pragma unroll
            for (int j = 0; j < 2; ++j) {
                const v4u w = MEM_NT ? __builtin_nontemporal_load((const GAS v4u*)(HB + (size_t)m * D + 512 * j + 8 * F.lane)) : *(const GAS v4u*)(HB + (size_t)m * D + 512 * j + 8 * F.lane);
                const f32x4 a = (f32x4){bf_lo(w.x), bf_hi(w.x), bf_lo(w.y), bf_hi(w.y)}, b = (f32x4){bf_lo(w.z), bf_hi(w.z), bf_lo(w.w), bf_hi(w.w)};
                GAS f32x4* po = (GAS f32x4*)(out + (size_t)m * D + 512 * j + 8 * F.lane);
                if (FIN_ST == 2) { const f32x4 o0 = a * rs * gv[j][0], o1 = b * rs * gv[j][1]; ST16_SC1(po, o0); ST16_SC1(po + 1, o1); } else if (FIN_ST) { __builtin_nontemporal_store(a * rs * gv[j][0], po); __builtin_nontemporal_store(b * rs * gv[j][1], po + 1); } else { po[0] = a * rs * gv[j][0]; po[1] = b * rs * gv[j][1]; }
            }
        }
    }
#endif
}

extern "C" void kernel_launch(void* const* d_in, const int* in_sizes, int n_in, void* d_out, int out_size, void* d_ws, size_t ws_size, hipStream_t stream) {
    static int grid = 0;
    if (grid == 0) {
        if (n_in != 18 || in_sizes[0] != M * D || out_size != M * D || ws_size < WS_END) { fprintf(stderr, "kernel_launch: unexpected problem shape / workspace (n_in %d, in0 %d, out %d, ws %zu)\n", n_in, n_in > 0 ? in_sizes[0] : -1, out_size, ws_size); grid = -1; return; }
        int dev = 0, cus = 0, per_cu = 0;
        if (hipGetDevice(&dev) != hipSuccess || hipDeviceGetAttribute(&cus, hipDeviceAttributeMultiprocessorCount, dev) != hipSuccess) { grid = -1; return; }
        if (hipFuncSetAttribute((const void*)mk_fwd, hipFuncAttributeMaxDynamicSharedMemorySize, LDS_BYTES) != hipSuccess) { fprintf(stderr, "kernel_launch: hipFuncSetAttribute failed\n"); grid = -1; return; }
        if (hipOccupancyMaxActiveBlocksPerMultiprocessor(&per_cu, (const void*)mk_fwd, NWAVES * 64, LDS_BYTES) != hipSuccess || per_cu < 1) { fprintf(stderr, "kernel_launch: occupancy query says %d blocks per CU\n", per_cu); per_cu = 1; }
        (void)hipGetLastError();
        if (GRP && cus != 256) { fprintf(stderr, "kernel_launch: the batch-group schedule needs 256 CUs (have %d)\n", cus); grid = -1; return; }
        grid = cus;
    }
    if (grid < 0) return;
    if (hipMemsetAsync((char*)d_ws + WS_CTL, 0, CTL_ZERO_BYTES, stream) != hipSuccess) { fprintf(stderr, "kernel_launch: hipMemsetAsync failed\n"); return; }
    Args a{};
    for (int i = 0; i < 18; ++i) a.in[i] = d_in[i];
    a.out = (float*)d_out; a.ws = (unsigned char*)d_ws;
    hipLaunchKernelGGL(mk_fwd, dim3(grid), dim3(NWAVES * 64), LDS_BYTES, stream, a);
}
```

```cpp
#define STAGGER_SLEEPS 0
#include <hip/hip_runtime.h>
#include <hip/hip_bf16.h>
#include <cstdio>
#include <cstdint>
#include <cmath>
namespace pg8 {
#define PG8_LAS __attribute__((address_space(3)))
typedef unsigned short bf16_t;
typedef short bf16x8 __attribute__((ext_vector_type(8)));
typedef float f32x4 __attribute__((ext_vector_type(4)));
typedef unsigned u32x4 __attribute__((ext_vector_type(4)));
typedef unsigned u32x2 __attribute__((ext_vector_type(2)));
constexpr int BM = 256, BK = 64, HALF = 128, HTB = HALF * BK * 2  , STAGE_BYTES = 8 * HTB, NXCD = 8, WGM = 8;

__host__ __device__ __forceinline__ int lds_byte(int r, int c) { const int st = (r >> 4) * 2 + (c >> 5), rr = r & 15, cc = c & 31, ob = rr * 64 + cc * 2; return st * 1024 + (ob ^ (((ob >> 9) & 1) << 5)); }
__host__ __device__ __forceinline__ void stage_rc(int b, int& R, int& C) { const int st = b / 1024, sb = b % 1024, swz = sb ^ (((sb >> 9) & 1) << 5); R = (st >> 1) * 16 + swz / 64; C = (st & 1) * 32 + (swz % 64) / 2; }
__host__ __device__ __forceinline__ int perm32(int rho) { const int n = rho >> 4, i = rho & 15; return 8 * (i >> 2) + 4 * n + (i & 3); }

struct Unit { int pm, pn, idx; };
struct Gemm { const bf16_t* A; const bf16_t* Bt; int M, N, K; };

struct StaticOrder {
    int nM, nN, nwg, G, c;
    __host__ __device__ void init(int M, int N, int G_, int c_) { nM = M / BM; nN = N / BM; nwg = nM * nN; G = G_; c = c_; }
    __host__ __device__ bool next(int i, Unit& u) const {
        const long L = (long)i * G + c; if (L >= nwg) return false;
        int wgid = (int)L; { const int q = nwg / NXCD, r = nwg % NXCD, xcd = wgid % NXCD, off = wgid / NXCD; wgid = (xcd < r ? xcd * (q + 1) : r * (q + 1) + (xcd - r) * q) + off; }
        const int nig = WGM * nN, gid = wgid / nig, fm = gid * WGM, gsz = (nM - fm) < WGM ? (nM - fm) : WGM;
        u.pm = fm + ((wgid % nig) % gsz); u.pn = (wgid % nig) / gsz; u.idx = i; return true;
    }
    __device__ __forceinline__ void a_ready(const Unit&) const {}
    __device__ __forceinline__ void done(const Unit&) const {}
};
struct GroupOrder {
    int nN, gb, mb, per;
    __host__ __device__ void init(int, int N, int, int c_) { nN = N / BM; gb = 2 * (c_ & 7) + ((c_ >> 3) >> 4); mb = (c_ >> 3) & 15; per = nN >> 1; }
    __host__ __device__ bool next(int i, Unit& u) const {
        if (i >= per) return false;
        const int L = i * 16 + mb, nig = 4 * nN, gid = L / nig, r = L % nig;
        u.pm = 8 * gb + 4 * gid + (r & 3); u.pn = r >> 2; u.idx = i; return true;
    }
    __device__ __forceinline__ void a_ready(const Unit&) const {}
    __device__ __forceinline__ void done(const Unit&) const {}
};
#ifndef GRP
#define GRP 1
#endif
#ifdef DBG_QKV_GROUP
typedef GroupOrder QkvOrder;
#define QKV_ORDER_DEFINED 1
#endif
#ifndef GRP_ORDER
#define GRP_ORDER 1
#endif
#if GRP && GRP_ORDER
typedef GroupOrder PhaseOrder;
#else
typedef StaticOrder PhaseOrder;
#endif
#ifndef QKV_ORDER_DEFINED
typedef PhaseOrder QkvOrder;
#endif

__device__ __forceinline__ unsigned cvt_pk_bf16(float lo, float hi) { unsigned r; asm volatile("v_cvt_pk_bf16_f32 %0, %1, %2" : "=v"(r) : "v"(lo), "v"(hi)); return r; }

constexpr int TOK = 32768;
__device__ __forceinline__ unsigned char* tab_ptr(volatile PG8_LAS unsigned* t, int k) {
    { unsigned a_ = (unsigned)(uintptr_t)t; asm volatile("" : "+v"(a_)); t = (volatile PG8_LAS unsigned*)a_; }
    const unsigned lo = (unsigned)__builtin_amdgcn_readfirstlane((int)t[2 * k]), hi = (unsigned)__builtin_amdgcn_readfirstlane((int)t[2 * k + 1]);
    unsigned long long v = (unsigned long long)lo | ((unsigned long long)hi << 32); asm volatile("" : "+s"(v)); return (unsigned char*)(__attribute__((address_space(1))) unsigned char*)v; }
constexpr size_t XWS_ROPE = (size_t)1 << 20, XWS_SSP = (size_t)3 << 20, XWS_KMP = (size_t)5 << 20, XWS_HB = (size_t)56 << 20, XWS_QKV = (size_t)184 << 20;

#ifndef EPI_NT
#define EPI_NT 2
#endif

#ifndef MEM_NT
#define MEM_NT 1
#endif
#define ST16_SC1(p, v) asm volatile("global_store_dwordx4 %0, %1, off sc1\n\ts_nop 1" :: "v"(p), "v"(v) : "memory")
#define ST8_SC1(p, v) asm volatile("global_store_dwordx2 %0, %1, off sc1\n\ts_nop 1" :: "v"(p), "v"(v) : "memory")
#ifndef PG8_AUX_A
#define PG8_AUX_A 0
#endif
#ifndef PG8_AUX_B
#define PG8_AUX_B 0
#endif
#ifndef RES_PF
#define RES_PF 1
#endif
#ifndef RES_LD
#define RES_LD 0
#endif
#ifndef EPI_QKV
#define EPI_QKV EPI_NT
#endif
#ifndef EPI_UP
#define EPI_UP EPI_NT
#endif
#ifndef EPI_RES
#define EPI_RES EPI_NT
#endif
template <int MODE> __device__ __forceinline__ void epi_st(void* p, const u32x4& v) {
    if constexpr (MODE == 2) asm volatile("global_store_dwordx4 %0, %1, off sc1\n\ts_nop 1" :: "v"((u32x4*)p), "v"(v) : "memory");
    else if constexpr (MODE == 3) asm volatile("global_store_dwordx4 %0, %1, off sc1 nt\n\ts_nop 1" :: "v"((u32x4*)p), "v"(v) : "memory");
    else if constexpr (MODE == 4) asm volatile("global_store_dwordx4 %0, %1, off sc0 sc1\n\ts_nop 1" :: "v"((u32x4*)p), "v"(v) : "memory");
    else if constexpr (MODE == 1) __builtin_nontemporal_store(v, (u32x4*)p);
    else *(u32x4*)p = v;
}
struct EpiQKV {
    static constexpr bool PERM = true, AFTER_DRAIN = false, PREFETCH = false;
    volatile PG8_LAS unsigned* pt; const PG8_LAS float* rt; unsigned ropemask, qmask, kmmask; float qscale;
    __device__ __forceinline__ void operator()(const f32x4 (&acc)[2][2][4][2], const Unit& u, int wr, int wc, int fr, int fq) const {
        unsigned char* ws = tab_ptr(pt, 19); bf16_t* O = (bf16_t*)(ws + XWS_QKV); const float* rope = (const float*)(ws + XWS_ROPE); float* kmp = (float*)(ws + XWS_KMP);
        const bool do_rope = (((ropemask >> u.pn) & 1u) != 0u) && ((wc & 1) == 0);
        const bool do_km = ((kmmask >> u.pn) & 1u) != 0u;
        const float sc = ((qmask >> u.pn) & 1u) ? qscale : 1.f;
        const int col0 = u.pn * BM + wc * 32 + 8 * fq;
        const float sgn = (fq == 0) ? -1.f : 1.f;
        f32x4 cs[2][2];
#pragma unroll
        for (int bj = 0; bj < 2; ++bj)
#pragma unroll
            for (int n = 0; n < 2; ++n) cs[bj][n] = (f32x4){0.f, 0.f, 0.f, 0.f};
#pragma unroll
        for (int ai = 0; ai < 2; ++ai) {
            f32x4 cc[4][2], sn[4][2];
            if (do_rope) {
#pragma unroll
                for (int m = 0; m < 4; ++m) { const f32x4* rp = (const f32x4*)(rope + (size_t)(u.pm * BM + ai * HALF + wr * 64 + m * 16 + fr) * 16);
                    cc[m][0] = rp[0]; cc[m][1] = rp[1]; sn[m][0] = rp[2]; sn[m][1] = rp[3]; }
            }
#pragma unroll
            for (int m = 0; m < 4; ++m) {
                const int rl = ai * HALF + wr * 64 + m * 16 + fr; const int row = u.pm * BM + rl;
                const float r = rt[u.idx * BM + rl];
                f32x4 v[2][2];
#pragma unroll
                for (int bj = 0; bj < 2; ++bj)
#pragma unroll
                    for (int n = 0; n < 2; ++n) v[bj][n] = acc[ai][bj][m][n] * r;
                if (do_rope) {
#pragma unroll
                    for (int bj = 0; bj < 2; ++bj)
#pragma unroll
                        for (int n = 0; n < 2; ++n)
#pragma unroll
                            for (int e = 0; e < 4; ++e) {
                                const float p = __shfl_xor(v[bj][n][e], 16);
                                const float rot = v[bj][n][e] * cc[m][n][e] + sgn * p * sn[m][n][e];
                                if (fq < 2) v[bj][n][e] = rot;
                            }
                }
                if (do_km) {
#pragma unroll
                    for (int bj = 0; bj < 2; ++bj)
#pragma unroll
                        for (int n = 0; n < 2; ++n) cs[bj][n] += v[bj][n];
                }
                bf16_t* rowp = O + (size_t)row * 3072 + col0;
#pragma unroll
                for (int bj = 0; bj < 2; ++bj) { const f32x4 v0 = v[bj][0] * sc, v1 = v[bj][1] * sc;
                    u32x4 w; w.x = cvt_pk_bf16(v0[0], v0[1]); w.y = cvt_pk_bf16(v0[2], v0[3]); w.z = cvt_pk_bf16(v1[0], v1[1]); w.w = cvt_pk_bf16(v1[2], v1[3]);
                    epi_st<EPI_QKV>(rowp + bj * HALF, w); }
            }
        }
        if (do_km) {
#pragma unroll
            for (int bj = 0; bj < 2; ++bj)
#pragma unroll
                for (int n = 0; n < 2; ++n)
#pragma unroll
                    for (int e = 0; e < 4; ++e) { float s = cs[bj][n][e]; s += __shfl_xor(s, 1); s += __shfl_xor(s, 2); s += __shfl_xor(s, 4); s += __shfl_xor(s, 8); cs[bj][n][e] = s; }
            if (fr == 0) {
                float* kp = kmp + ((size_t)wr * 128 + u.pm) * 512 + (u.pn - 8) * BM + wc * 32 + 8 * fq;
#pragma unroll
                for (int bj = 0; bj < 2; ++bj)
#pragma unroll
                    for (int n = 0; n < 2; ++n) *(f32x4*)(kp + bj * HALF + 4 * n) = cs[bj][n];
            }
        }
    }
};

template <int SCR>
struct EpiResidT {
    static constexpr bool PERM = true, AFTER_DRAIN = false, PREFETCH = (RES_PF != 0);
    volatile PG8_LAS unsigned* pt;
    __device__ __forceinline__ void prefetch(const Unit& u, int tid, int r, PG8_LAS unsigned char* junk) const {
        const unsigned char* ws = tab_ptr(pt, 19); const int li = r * 512 + tid, row = li >> 2, seg = li & 3;
        const unsigned char* p = ws + (SCR ? ((size_t)376 << 20) : XWS_HB) + ((size_t)(u.pm * BM + row) * 1024 + u.pn * BM + seg * 64) * 2;
        __builtin_amdgcn_global_load_lds((const unsigned*)p, (PG8_LAS unsigned*)junk, 4, 0, 0);
    }
    __device__ __forceinline__ void operator()(const f32x4 (&acc)[2][2][4][2], const Unit& u, int wr, int wc, int fr, int fq) const {
        unsigned char* ws = tab_ptr(pt, 19);
        bf16_t* hb = (bf16_t*)(ws + (SCR ? ((size_t)376 << 20) : XWS_HB)); float* ssp = (float*)(ws + (SCR ? ((size_t)440 << 20) : XWS_SSP));
        const int col0 = u.pn * BM + wc * 32 + 8 * fq;
        u32x4 bw[2][4][2];
#pragma unroll
        for (int ai = 0; ai < 2; ++ai)
#pragma unroll
            for (int m = 0; m < 4; ++m) {
                const size_t off = (size_t)(u.pm * BM + ai * HALF + wr * 64 + m * 16 + fr) * 1024 + col0;
#pragma unroll
                for (int bj = 0; bj < 2; ++bj) { if constexpr (SCR == 2 || SCR == 4) bw[ai][m][bj] = (u32x4){0u, 0u, 0u, 0u}; else bw[ai][m][bj] = RES_LD ? __builtin_nontemporal_load((const u32x4*)(hb + off + bj * HALF)) : *(const u32x4*)(hb + off + bj * HALF); }
            }
#pragma unroll
        for (int ai = 0; ai < 2; ++ai)
#pragma unroll
            for (int m = 0; m < 4; ++m) {
                const int row = u.pm * BM + ai * HALF + wr * 64 + m * 16 + fr; const size_t off = (size_t)row * 1024 + col0; float ss = 0.f;
#pragma unroll
                for (int bj = 0; bj < 2; ++bj) {
                    const u32x4 w0 = bw[ai][m][bj];
                    const f32x4 b0 = (f32x4){__uint_as_float(w0.x << 16), __uint_as_float(w0.x & 0xffff0000u), __uint_as_float(w0.y << 16), __uint_as_float(w0.y & 0xffff0000u)};
                    const f32x4 b1 = (f32x4){__uint_as_float(w0.z << 16), __uint_as_float(w0.z & 0xffff0000u), __uint_as_float(w0.w << 16), __uint_as_float(w0.w & 0xffff0000u)};
                    const f32x4 o0 = b0 + acc[ai][bj][m][0], o1 = b1 + acc[ai][bj][m][1];
                    ss += ((o0[0] * o0[0] + o0[1] * o0[1]) + (o0[2] * o0[2] + o0[3] * o0[3])) + ((o1[0] * o1[0] + o1[1] * o1[1]) + (o1[2] * o1[2] + o1[3] * o1[3]));
                    u32x4 w; w.x = cvt_pk_bf16(o0[0], o0[1]); w.y = cvt_pk_bf16(o0[2], o0[3]); w.z = cvt_pk_bf16(o1[0], o1[1]); w.w = cvt_pk_bf16(o1[2], o1[3]);
                    if constexpr (SCR == 3 || SCR == 4) { ss += __uint_as_float(w.x ^ w.y ^ w.z ^ w.w) * 1e-30f; } else epi_st<EPI_RES>(hb + off + bj * HALF, w);
                }
                ss += __shfl_xor(ss, 16); ss += __shfl_xor(ss, 32);
                if (fq == 0) ssp[(size_t)(u.pn * 4 + wc) * TOK + row] = ss;
            }
    }
};
typedef EpiResidT<0> EpiResid;

struct EpiSwiGLU {
    static constexpr bool PERM = true, AFTER_DRAIN = false, PREFETCH = false;
    volatile PG8_LAS unsigned* pt; const PG8_LAS float* rt;
    __device__ __forceinline__ void operator()(const f32x4 (&acc)[2][2][4][2], const Unit& u, int wr, int wc, int fr, int fq) const {
        bf16_t* O = (bf16_t*)(tab_ptr(pt, 19) + XWS_QKV + (GRP ? (size_t)(u.pm >> 3) * ((size_t)1 << 20) : (size_t)0));
        const int col0 = u.pn * HALF + wc * 32 + 8 * fq;
#pragma unroll
        for (int ai = 0; ai < 2; ++ai)
#pragma unroll
            for (int m = 0; m < 4; ++m) {
                const int rl = ai * HALF + wr * 64 + m * 16 + fr; const int row = u.pm * BM + rl;
                const float r = rt[u.idx * BM + rl];
                float a[8];
                typedef float f32x2_e __attribute__((ext_vector_type(2)));
                const float r2 = r * r, ncr = -1.4426950408889634f * r;
#pragma unroll
                for (int n = 0; n < 2; ++n)
#pragma unroll
                    for (int e = 0; e < 4; e += 2) { const f32x2_e g2 = {acc[ai][0][m][n][e], acc[ai][0][m][n][e + 1]}, u2 = {acc[ai][1][m][n][e], acc[ai][1][m][n][e + 1]};
                        f32x2_e p = g2 * u2; p = p * r2; const f32x2_e x = g2 * ncr;
                        f32x2_e d = {__builtin_amdgcn_exp2f(x.x), __builtin_amdgcn_exp2f(x.y)}; d = d + 1.0f;
                        const f32x2_e rc = {__builtin_amdgcn_rcpf(d.x), __builtin_amdgcn_rcpf(d.y)}; p = p * rc; a[4 * n + e] = p.x; a[4 * n + e + 1] = p.y; }
                u32x4 w; w.x = cvt_pk_bf16(a[0], a[1]); w.y = cvt_pk_bf16(a[2], a[3]); w.z = cvt_pk_bf16(a[4], a[5]); w.w = cvt_pk_bf16(a[6], a[7]);
                epi_st<EPI_UP>(O + (size_t)row * 2816 + col0, w);
            }
    }
};

template <class Epi, class Sched, bool ALIGN_EPI = false, bool SP2 = false>
__device__ __forceinline__ void gemm_phase(PG8_LAS unsigned char* lds, const Gemm g, const Sched& S, const Epi& E) {
    int tid_ = threadIdx.x; asm volatile("" : "+v"(tid_));
    const int tid = tid_, wid = __builtin_amdgcn_readfirstlane(tid >> 6), lane = tid & 63, wr = wid >> 2, wc = wid & 3, fr = lane & 15, fq = lane >> 4;
    const int K = g.K, nt = K / BK;
    unsigned voffA[2], voffB[2];
#pragma unroll
    for (int i = 0; i < 2; ++i) { int R, C; stage_rc(tid * 16 + i * 8192, R, C); const int Rb = Epi::PERM ? ((R & ~31) + perm32(R & 31)) : R;
        voffA[i] = (unsigned)(R * K + C) * 2u; voffB[i] = (unsigned)(Rb * K + C) * 2u; }
    const size_t kstep = (size_t)(BK * 2);
    const size_t hstep = (size_t)HALF * K * 2;
    const size_t tstep = 2 * hstep;
    const unsigned ldsw = (unsigned)wid * 1024u;
    const int aoff = lds_byte(wr * 64 + fr, fq * 8), boff = lds_byte(wc * 32 + fr, fq * 8);
#define PG8_SA(b, h) (((b) * 2 + (h)) * HTB)
#define PG8_SB(b, h) ((4 + (b) * 2 + (h)) * HTB)
#define PG8_STAGE(bufoff, gbase, voff) do { _Pragma("unroll") for (int _i = 0; _i < 2; ++_i) \
        __builtin_amdgcn_global_load_lds((const unsigned*)((const char*)(gbase) + (voff)[_i]), (PG8_LAS unsigned*)(lds + (bufoff) + ldsw + _i * 8192), 16, 0, ((bufoff) < 4 * HTB) ? PG8_AUX_A : PG8_AUX_B); } while (0)
#define PG8_LDA(dst, b, h) do { _Pragma("unroll") for (int m = 0; m < 4; ++m) _Pragma("unroll") for (int k = 0; k < 2; ++k) dst[m][k] = *(const PG8_LAS bf16x8*)(lds + PG8_SA(b, h) + aoff + m * 2048 + k * 1024); } while (0)
#define PG8_LDB(dst, b, h) do { _Pragma("unroll") for (int n = 0; n < 2; ++n) _Pragma("unroll") for (int k = 0; k < 2; ++k) dst[n][k] = *(const PG8_LAS bf16x8*)(lds + PG8_SB(b, h) + boff + n * 2048 + k * 1024); } while (0)
#define PG8_MMA(ai, bj, At, Bt) do { __builtin_amdgcn_s_setprio(1); _Pragma("unroll") for (int m = 0; m < 4; ++m) _Pragma("unroll") for (int n = 0; n < 2; ++n) _Pragma("unroll") for (int k = 0; k < 2; ++k) \
        acc[ai][bj][m][n] = __builtin_amdgcn_mfma_f32_16x16x32_bf16(Bt[n][k], At[m][k], acc[ai][bj][m][n], 0, 0, 0); __builtin_amdgcn_s_setprio(0); } while (0)
#define PG8_WAIT_V(n) asm volatile("s_waitcnt vmcnt(" #n ")" ::: "memory")
#define PG8_WAIT_L(n) asm volatile("s_waitcnt lgkmcnt(" #n ")" ::: "memory")
#define PG8_BAR __builtin_amdgcn_s_barrier()
#define PG8_SCHED __builtin_amdgcn_sched_barrier(0)
    Unit cur, nxt; int ui = 0;
    if (!S.next(0, cur)) return;
    f32x4 acc[2][2][4][2];
#pragma unroll
    for (int a = 0; a < 2; ++a)
#pragma unroll
        for (int b = 0; b < 2; ++b)
#pragma unroll
            for (int m = 0; m < 4; ++m)
#pragma unroll
                for (int n = 0; n < 2; ++n) acc[a][b][m][n] = (f32x4){0.f, 0.f, 0.f, 0.f};
    bf16x8 At[4][2], B0[2][2], B1[2][2];
    const char* cA = (const char*)g.A + (size_t)cur.pm * tstep; const char* cB = (const char*)g.Bt + (size_t)cur.pn * tstep;
    S.a_ready(cur);
    if constexpr (SP2) {
        PG8_STAGE(PG8_SB(0, 0), cB, voffB); PG8_STAGE(PG8_SB(0, 1), cB + hstep, voffB); PG8_STAGE(PG8_SA(0, 0), cA, voffA); PG8_STAGE(PG8_SA(0, 1), cA + hstep, voffA);
        if (wr == 1) PG8_BAR;
        PG8_WAIT_V(2); PG8_BAR;
        PG8_STAGE(PG8_SB(1, 0), cB + kstep, voffB); PG8_STAGE(PG8_SA(1, 0), cA + kstep, voffA); PG8_STAGE(PG8_SB(1, 1), cB + hstep + kstep, voffB);
        PG8_WAIT_V(6); PG8_BAR;
    } else {
        PG8_STAGE(PG8_SB(0, 0), cB, voffB); PG8_STAGE(PG8_SA(0, 0), cA, voffA); PG8_STAGE(PG8_SB(0, 1), cB + hstep, voffB); PG8_STAGE(PG8_SA(0, 1), cA + hstep, voffA);
        if (wr == 1) PG8_BAR;
        PG8_WAIT_V(4); PG8_BAR;
        PG8_STAGE(PG8_SB(1, 0), cB + kstep, voffB); PG8_STAGE(PG8_SA(1, 0), cA + kstep, voffA); PG8_STAGE(PG8_SB(1, 1), cB + hstep + kstep, voffB);
        PG8_WAIT_V(6); PG8_BAR;
    }
    for (;;) {
        const bool has_next = S.next(ui + 1, nxt);
        const char* nA = has_next ? (const char*)g.A + (size_t)nxt.pm * tstep : cA; const char* nB = has_next ? (const char*)g.Bt + (size_t)nxt.pn * tstep : cB;
        for (int t = 0; t < nt; t += 2) {
            const bool last = (t == nt - 2);
            const char* a1 = cA + (size_t)(t + 1) * kstep;
            const char* a2 = last ? nA : cA + (size_t)(t + 2) * kstep; const char* b2 = last ? nB : cB + (size_t)(t + 2) * kstep;
            const char* a3 = a2 + kstep; const char* b3 = b2 + kstep;
            if (last && has_next) S.a_ready(nxt);
            if constexpr (Epi::PREFETCH) { if (t == nt - 6 || t == nt - 4) E.prefetch(cur, tid, t == nt - 6 ? 0 : 1, lds + 131072 + wid * 256); }
            if constexpr (SP2) {
            PG8_LDB(B0, 0, 0); PG8_LDB(B1, 0, 1); PG8_SCHED; PG8_LDA(At, 0, 0); PG8_STAGE(PG8_SA(1, 1), a1 + hstep, voffA);
            PG8_WAIT_V(8); PG8_WAIT_L(0); PG8_BAR; PG8_MMA(0, 0, At, B0); PG8_MMA(0, 1, At, B1); PG8_BAR; PG8_SCHED;
            PG8_LDA(At, 0, 1); PG8_STAGE(PG8_SB(0, 0), b2, voffB); PG8_STAGE(PG8_SB(0, 1), b2 + hstep, voffB); PG8_STAGE(PG8_SA(0, 0), a2, voffA);
            PG8_WAIT_V(8); PG8_WAIT_L(0); PG8_BAR; PG8_MMA(1, 0, At, B0); PG8_MMA(1, 1, At, B1); PG8_BAR; PG8_SCHED;
            PG8_LDB(B0, 1, 0); PG8_LDB(B1, 1, 1); PG8_SCHED; PG8_LDA(At, 1, 0); PG8_STAGE(PG8_SA(0, 1), a2 + hstep, voffA);
            PG8_WAIT_V(8); PG8_WAIT_L(0); PG8_BAR; PG8_MMA(0, 0, At, B0); PG8_MMA(0, 1, At, B1); PG8_BAR; PG8_SCHED;
            PG8_LDA(At, 1, 1); PG8_STAGE(PG8_SB(1, 0), b3, voffB); PG8_STAGE(PG8_SB(1, 1), b3 + hstep, voffB); PG8_STAGE(PG8_SA(1, 0), a3, voffA);
            PG8_WAIT_V(8); PG8_WAIT_L(0); PG8_BAR; PG8_MMA(1, 0, At, B0); PG8_MMA(1, 1, At, B1); PG8_BAR; PG8_SCHED;
            } else {
            PG8_LDB(B0, 0, 0); PG8_SCHED; PG8_LDA(At, 0, 0); PG8_STAGE(PG8_SA(1, 1), a1 + hstep, voffA);
            PG8_WAIT_L(8); PG8_BAR; PG8_WAIT_L(0); PG8_MMA(0, 0, At, B0); PG8_BAR; PG8_SCHED;
            PG8_LDB(B1, 0, 1); PG8_STAGE(PG8_SB(0, 0), b2, voffB);
            PG8_BAR; PG8_WAIT_L(0); PG8_MMA(0, 1, At, B1); PG8_BAR;
            PG8_LDA(At, 0, 1); PG8_STAGE(PG8_SA(0, 0), a2, voffA);
            PG8_BAR; PG8_WAIT_L(0); PG8_MMA(1, 0, At, B0); PG8_BAR; PG8_SCHED;
            PG8_STAGE(PG8_SB(0, 1), b2 + hstep, voffB);
            PG8_WAIT_V(6); PG8_BAR; PG8_MMA(1, 1, At, B1); PG8_BAR;
            PG8_LDB(B0, 1, 0); PG8_SCHED; PG8_LDA(At, 1, 0); PG8_STAGE(PG8_SA(0, 1), a2 + hstep, voffA);
            PG8_WAIT_L(8); PG8_BAR; PG8_WAIT_L(0); PG8_MMA(0, 0, At, B0); PG8_BAR; PG8_SCHED;
            PG8_LDB(B1, 1, 1); PG8_STAGE(PG8_SB(1, 0), b3, voffB);
            PG8_BAR; PG8_WAIT_L(0); PG8_MMA(0, 1, At, B1); PG8_BAR;
            PG8_LDA(At, 1, 1); PG8_STAGE(PG8_SA(1, 0), a3, voffA);
            PG8_BAR; PG8_WAIT_L(0); PG8_MMA(1, 0, At, B0); PG8_BAR; PG8_SCHED;
            PG8_STAGE(PG8_SB(1, 1), b3 + hstep, voffB);
            PG8_WAIT_V(6); PG8_BAR; PG8_MMA(1, 1, At, B1); PG8_BAR;
            }
        }
        if constexpr (ALIGN_EPI) { if (wr == 0) PG8_BAR; }
        if constexpr (!Epi::AFTER_DRAIN) { E(acc, cur, wr, wc, fr, fq); S.done(cur); }
        if (!has_next) break;
#pragma unroll
        for (int a = 0; a < 2; ++a)
#pragma unroll
            for (int b = 0; b < 2; ++b)
#pragma unroll
                for (int m = 0; m < 4; ++m)
#pragma unroll
                    for (int n = 0; n < 2; ++n) acc[a][b][m][n] = (f32x4){0.f, 0.f, 0.f, 0.f};
        cur = nxt; cA = nA; cB = nB; ++ui;
        if constexpr (ALIGN_EPI) { if (wr == 1) PG8_BAR; }
    }
    PG8_WAIT_V(0);
    if constexpr (!ALIGN_EPI) { if (wr == 0) PG8_BAR; }
    PG8_BAR;
    if constexpr (Epi::AFTER_DRAIN) { E.fused(acc, cur, wr, wc, fr, fq, lds, wid, lane); S.done(cur); }
#undef PG8_SA
#undef PG8_SB
#undef PG8_STAGE
#undef PG8_LDA
#undef PG8_LDB
#undef PG8_MMA
#undef PG8_WAIT_V
#undef PG8_WAIT_L
#undef PG8_BAR
#undef PG8_SCHED
}
}

#ifndef PG8_SP2
#define PG8_SP2 true
#endif
#ifndef PG8_ALIGN
#define PG8_ALIGN true
#endif
#ifndef ATT_NOREF
#define ATT_NOREF 1
#endif
namespace attn_body {
constexpr bool NOREF = ATT_NOREF != 0;
using bf16=__hip_bfloat16;
using bf16x8=__attribute__((ext_vector_type(8)))short;
using s16x4=__attribute__((ext_vector_type(4)))short;
using f32x16=__attribute__((ext_vector_type(16)))float;
using f32x4=__attribute__((ext_vector_type(4)))float;
using u32x4=__attribute__((ext_vector_type(4)))unsigned;
constexpr int SEQ=2048,D=64,LDQ=3072;
constexpr int NW=8,QBLK=32,QB=QBLK*NW,KVBLK=64,NQB=SEQ/QB;
__device__ __forceinline__ int crow(int r,int hi){return (r&3)+8*(r>>2)+4*hi;}
#define SBAR() __builtin_amdgcn_sched_barrier(0)
__device__ __forceinline__ void cmask(f32x16&p0,f32x16&p1,int jb,int qrel,int hi){
  const float NEG=-INFINITY; int kb=64*jb+4*hi;
  #pragma unroll
  for(int r=0;r<16;++r){int kv=kb+(r&3)+8*(r>>2); if(kv>qrel)p0[r]=NEG; if(kv+32>qrel)p1[r]=NEG;}
}
__device__ __forceinline__ float dil_bias(int d){
  const unsigned u=(unsigned)d;
  const int c=(int)(u<=128u)+(int)((u<=512u)&&((u&3u)==0u))+(int)((d>=0)&&((u&15u)==0u));
  return c==0?-INFINITY:(c==1?0.f:(c==2?1.0f:1.5849625007211562f));
}
constexpr int DIL_LUT_OFF=144384, DIL_LUT_N=2336;
__device__ __forceinline__ void dil_hook(f32x16&p0,f32x16&p1,int dt,const char*shm){
#ifdef DIL_NO_LUT
  #pragma unroll
  for(int r=0;r<16;++r){const int d=dt-((r&3)+8*(r>>2)); p0[r]+=dil_bias(d); p1[r]+=dil_bias(d-32);}
#else
  const __attribute__((address_space(3))) float*Tl=(const __attribute__((address_space(3))) float*)(shm+DIL_LUT_OFF)+(dt+197);
  #pragma unroll
  for(int r=0;r<16;++r){const int off=(r&3)+8*(r>>2); float a0=Tl[59-off],a1=Tl[27-off],x0=p0[r],x1=p1[r],y0,y1;
    asm volatile("v_add_f32_e32 %0, %1, %2":"=v"(y0):"v"(x0),"v"(a0)); asm volatile("v_add_f32_e32 %0, %1, %2":"=v"(y1):"v"(x1),"v"(a1)); p0[r]=y0; p1[r]=y1;}
#endif
}
__device__ __forceinline__ void all_neg(f32x16&p0,f32x16&p1){
  #pragma unroll
  for(int r=0;r<16;++r){p0[r]=-INFINITY;p1[r]=-INFINITY;}
}

constexpr int NSLOT=3, SLOTB=8192;
constexpr int LDS_K=0, LDS_V=NSLOT*SLOTB, LDS_WS=2*NSLOT*SLOTB, LDS_OST=LDS_WS+NW*64*4, LDS_BYTES=LDS_OST+NW*4096;
constexpr float C2=0.125f*1.4426950408889634f;
__device__ __forceinline__ void glds16(const void*sbase,unsigned voff,unsigned lds_dst){unsigned keep;
  asm volatile("s_nop 4\n\ts_mov_b32 %0, m0\n\ts_mov_b32 m0, %3\n\ts_nop 0\n\tglobal_load_lds_dwordx4 %1, %2\n\ts_mov_b32 m0, %0":"=&s"(keep):"v"(voff),"s"(sbase),"s"(lds_dst):"memory");}
__device__ __forceinline__ float max3f(float a,float b,float c){float r;asm("v_max3_f32 %0, %1, %2, %3":"=v"(r):"v"(a),"v"(b),"v"(c));return r;}
__device__ __forceinline__ float max2f(float a,float b){float r;asm("v_max_f32_e32 %0, %1, %2":"=v"(r):"v"(a),"v"(b));return r;}
__device__ __forceinline__ float fadd_s(float a,float b){float r;asm("v_add_f32_e32 %0, %1, %2":"=v"(r):"v"(a),"v"(b));return r;}
__device__ __forceinline__ float fsub_s(float a,float b){float r;asm("v_sub_f32_e32 %0, %1, %2":"=v"(r):"v"(a),"v"(b));return r;}
typedef float f32x2_t __attribute__((ext_vector_type(2))); typedef __bf16 bf16x2_t __attribute__((ext_vector_type(2)));
__device__ __forceinline__ unsigned cvtpk_s(float lo,float hi){f32x2_t v={lo,hi};bf16x2_t b=__builtin_convertvector(v,bf16x2_t);return __builtin_bit_cast(unsigned,b);}
#define WAIT_BAR(N) asm volatile("s_waitcnt vmcnt(" #N ") lgkmcnt(0)\n\ts_barrier":::"memory")

__device__ __forceinline__ void qkt(f32x16&p0,f32x16&p1,const char*Kslot,const bf16x8*qr,int r32,int hi){
  const f32x16 negm=f32x16{};
  const char*kb=Kslot+hi*1024+r32*16;
  #pragma unroll
  for(int d0=0;d0<4;++d0){
    const bf16x8 b0=*reinterpret_cast<const bf16x8*>(kb+d0*2048);
    const bf16x8 b1=*reinterpret_cast<const bf16x8*>(kb+d0*2048+512);
    if(d0==0){p0=__builtin_amdgcn_mfma_f32_32x32x16_bf16(b0,qr[0],negm,0,0,0);p1=__builtin_amdgcn_mfma_f32_32x32x16_bf16(b1,qr[0],negm,0,0,0);}
    else{p0=__builtin_amdgcn_mfma_f32_32x32x16_bf16(b0,qr[d0],p0,0,0,0);p1=__builtin_amdgcn_mfma_f32_32x32x16_bf16(b1,qr[d0],p1,0,0,0);}}
}
typedef __attribute__((address_space(3))) const char* lds_cptr;
typedef short v4i16_t __attribute__((ext_vector_type(4)));
__device__ __forceinline__ void kload8(bf16x8*kf,lds_cptr kp){
  kf[0]=*(const __attribute__((address_space(3))) bf16x8*)(kp);      kf[1]=*(const __attribute__((address_space(3))) bf16x8*)(kp+512);
  kf[2]=*(const __attribute__((address_space(3))) bf16x8*)(kp+2048); kf[3]=*(const __attribute__((address_space(3))) bf16x8*)(kp+2560);
  kf[4]=*(const __attribute__((address_space(3))) bf16x8*)(kp+4096); kf[5]=*(const __attribute__((address_space(3))) bf16x8*)(kp+4608);
  kf[6]=*(const __attribute__((address_space(3))) bf16x8*)(kp+6144); kf[7]=*(const __attribute__((address_space(3))) bf16x8*)(kp+6656);
}
__device__ __forceinline__ void kload2(bf16x8*kf,lds_cptr kp,int j){ kf[2*j]=*(const __attribute__((address_space(3))) bf16x8*)(kp+j*2048); kf[2*j+1]=*(const __attribute__((address_space(3))) bf16x8*)(kp+j*2048+512); }
__device__ __forceinline__ s16x4 vtr(lds_cptr p){ return __builtin_bit_cast(s16x4,__builtin_amdgcn_ds_read_tr16_b64_v4i16((__attribute__((address_space(3))) v4i16_t*)p)); }
__device__ __forceinline__ float rowmax(const f32x16&p0,const f32x16&p1){
  float a=max3f(p0[0],p0[1],p1[0]),b=max3f(p0[2],p0[3],p1[1]);a=max3f(a,p1[2],p1[3]);
  #pragma unroll
  for(int r=4;r<16;r+=4){a=max3f(a,p0[r],p0[r+1]);b=max3f(b,p0[r+2],p0[r+3]);a=max3f(a,p1[r],p1[r+1]);b=max3f(b,p1[r+2],p1[r+3]);}
  const float m=max2f(a,b);
  auto rr=__builtin_amdgcn_permlane32_swap(__float_as_uint(m),__float_as_uint(m),false,false);
  return max2f(__uint_as_float(rr[0]),__uint_as_float(rr[1]));
}
__device__ __forceinline__ void pv(f32x16*o,int vb,bf16x8 pa0,bf16x8 pa1,bf16x8 pa2,bf16x8 pa3){
  #pragma unroll
  for(int d0=0;d0<2;++d0){s16x4 lo[4],hi[4];
    #pragma unroll
    for(int ks=0;ks<4;++ks){
      asm volatile("ds_read_b64_tr_b16 %0,%1 offset:%c2":"=&v"(lo[ks]):"v"(vb),"i"(d0*4096+ks*1024):"memory");
      asm volatile("ds_read_b64_tr_b16 %0,%1 offset:%c2":"=&v"(hi[ks]):"v"(vb),"i"(d0*4096+ks*1024+512):"memory");}
    asm volatile("s_waitcnt lgkmcnt(0)":::"memory");SBAR();
    #define PK(k) (bf16x8){lo[k][0],lo[k][1],lo[k][2],lo[k][3],hi[k][0],hi[k][1],hi[k][2],hi[k][3]}
    o[d0]=__builtin_amdgcn_mfma_f32_32x32x16_bf16(pa0,PK(0),o[d0],0,0,0);
    o[d0]=__builtin_amdgcn_mfma_f32_32x32x16_bf16(pa1,PK(1),o[d0],0,0,0);
    o[d0]=__builtin_amdgcn_mfma_f32_32x32x16_bf16(pa2,PK(2),o[d0],0,0,0);
    o[d0]=__builtin_amdgcn_mfma_f32_32x32x16_bf16(pa3,PK(3),o[d0],0,0,0);
    #undef PK
  }
}

#ifndef ATTN_STORE16
#ifndef ATT_ST
#define ATT_ST 1
#endif
#define ATTN_STORE16(p,v) do{ if(ATT_ST==2){ const u32x4 v__=(v); ST16_SC1((u32x4*)(p),v__); } else if(ATT_ST) __builtin_nontemporal_store((v),(u32x4*)(p)); else *(u32x4*)(p)=(v); }while(0)
#endif
constexpr int LDS_S1=83968, LDS_SSB=LDS_S1+NW*4096, LDS_DC=LDS_SSB+NW*128, ATTN_LDS_BYTES_DIFF=LDS_DC+544;
template<int MODE,int THRL,int ABL=0>
__device__ __forceinline__ void attn_unit(int qb,const bf16*__restrict__ QKVb,int qcol,int kcol,int vcol,bf16*Og,int ldo,const float*km0,char*shm,int est,int kncol,int vncol,int first,int&ring,int qncol,int qbn,bf16x8&qp0,bf16x8&qp1,bf16x8&qp2,bf16x8&qp3){
  const bf16*Qg=QKVb+qcol,*Kg=QKVb+kcol,*Vg=QKVb+vcol,*Kn=QKVb+kncol,*Vn=QKVb+vncol,*Qn=QKVb+qncol; const float*km1=km0+128*512;
  int tid_=threadIdx.x; asm volatile("":"+v"(tid_));
  #define CLOSE_BAR() do{ if constexpr((ABL&2048)!=0){ asm volatile("s_waitcnt lgkmcnt(0)\n\ts_barrier":::"memory"); } else if constexpr((ABL&32)!=0){ if(wid<4){ WBX(2); } } else { WBX(2); } }while(0)
  #define WBX(N) do{ if constexpr((ABL&8)!=0){ asm volatile("s_waitcnt vmcnt(" #N ") lgkmcnt(0)":::"memory"); } else { WAIT_BAR(N); } }while(0)
  const int tid=tid_,lane=tid&63,r32=lane&31,hi=lane>>5; const int wid=__builtin_amdgcn_readfirstlane(tid>>6);
  const int q0=qb*QB;
  const bf16*Qw=Qg+(long)(q0+wid*QBLK)*LDQ;
  const bf16*Kh=Kg,*Vh=Vg;
  const unsigned lds0=(unsigned)(uintptr_t)shm;
  float*wsf=(float*)(shm+LDS_WS)+wid*64;
  const bf16*ksrc=Kh+wid*8;
  const bf16*vsrc=Vh+(long)(16*(wid&3))*LDQ+(wid>>2)*32;
  const bf16*knsrc=Kn+wid*8; const bf16*vnsrc=Vn+(long)(16*(wid&3))*LDQ+(wid>>2)*32;
  const unsigned koff=(unsigned)lane*(LDQ*2u), voff=(unsigned)(lane>>2)*(LDQ*2u)+(unsigned)(lane&3)*16u;
  const unsigned kdst=lds0+LDS_K+wid*1024, vdst=lds0+LDS_V+wid*1024;
  #define DMA_K(t,slot) glds16(ksrc+(long)(t)*KVBLK*LDQ,koff,(unsigned)__builtin_amdgcn_readfirstlane(kdst+(slot)))
  #define DMA_V(t,slot) glds16(vsrc+(long)(t)*KVBLK*LDQ,voff,(unsigned)__builtin_amdgcn_readfirstlane(vdst+(slot)))
  #define DMA_KX(t,slot) do{ const int t_=(t); const bf16*s_=(t_<NT)?(ksrc+(long)t_*KVBLK*LDQ):(knsrc+(long)(t_-NT)*KVBLK*LDQ); glds16(s_,koff,(unsigned)__builtin_amdgcn_readfirstlane(kdst+(slot))); }while(0)
  #define DMA_VX(t,slot) do{ const int t_=(t); const bf16*s_=(t_<NT)?(vsrc+(long)t_*KVBLK*LDQ):(vnsrc+(long)(t_-NT)*KVBLK*LDQ); glds16(s_,voff,(unsigned)__builtin_amdgcn_readfirstlane(vdst+(slot))); }while(0)
  const int vb0=(int)(lds0+LDS_V)+((lane>>4)&1)*32+(lane&3)*8+(4*hi+((lane&15)>>2))*64;
  const int s0=ring, s1=(s0==(NSLOT-1)*SLOTB)?0:s0+SLOTB, s2=(s1==(NSLOT-1)*SLOTB)?0:s1+SLOTB;
  const char*Kbase=shm+LDS_K+s0; bf16x8 kf[8];
  const lds_cptr shm3=(lds_cptr)shm; const lds_cptr kp0=shm3+LDS_K+hi*1024+r32*16; const lds_cptr vp0=shm3+LDS_V+((lane>>4)&1)*32+(lane&3)*8+(4*hi+((lane&15)>>2))*64;
  const int NT=(q0+QB)/KVBLK;
  if(first){DMA_K(0,s0);DMA_V(0,s0);DMA_K(1,s1);}
  bf16x8 qr[4];
  if(first){
    #pragma unroll
    for(int d0=0;d0<4;++d0)qr[d0]=*reinterpret_cast<const bf16x8*>(&Qw[(long)r32*LDQ+d0*16+hi*8]); }
  else{
    qr[0]=qp0;qr[1]=qp1;qr[2]=qp2;qr[3]=qp3; }
  float mhat=0.f,l_reg=0.f;f32x16 o[2];o[0]=f32x16{};o[1]=f32x16{};const f32x16 zero16=f32x16{};
  const int qrel=wid*QBLK+r32;
  unsigned selmask=0u;
  if constexpr(MODE==2){
    if(qb<=3)selmask=(1u<<qb)-1u;
    else{
      float g[8];
      #pragma unroll
      for(int n=0;n<8;++n){
        if(n<qb){ float s=0.f;
          #pragma unroll
          for(int d0=0;d0<4;++d0){
            const f32x4 a0=*(const f32x4*)(km0+(long)n*512+d0*16+hi*8),a1=*(const f32x4*)(km0+(long)n*512+d0*16+hi*8+4);
            const f32x4 b0=*(const f32x4*)(km1+(long)n*512+d0*16+hi*8),b1=*(const f32x4*)(km1+(long)n*512+d0*16+hi*8+4);
            const f32x4 k0=a0+b0,k1=a1+b1;
            #pragma unroll
            for(int e=0;e<4;++e){
              const unsigned w=(unsigned)(unsigned short)qr[d0][e],w2=(unsigned)(unsigned short)qr[d0][4+e];
              s+=__uint_as_float(w<<16)*k0[e]; s+=__uint_as_float(w2<<16)*k1[e]; } }
          s+=__shfl_xor(s,32); g[n]=s; }
        else g[n]=-INFINITY; }
      #pragma unroll
      for(int n=0;n<8;++n){ int rank=0;
        #pragma unroll
        for(int m=0;m<8;++m){ if(m!=n){ rank+=(g[m]>g[n]||(g[m]==g[n]&&m<n))?1:0; } }
        if(n<qb&&rank<3)selmask|=(1u<<n); }
    }
    ((unsigned*)(shm+LDS_OST))[wid*1024+lane]=selmask;
  }
  const int dq=q0+qrel-4*hi;
  #define MHOOK(P0,P1,t) do{ if constexpr(MODE==1){ dil_hook(P0,P1,dq-64*(t),shm); } \
      else if constexpr(MODE==2){ if((t)<NT-4){ const unsigned sm_=((const unsigned*)(shm+LDS_OST))[wid*1024+lane]; if(!((sm_>>((t)>>2))&1u)) all_neg(P0,P1); } } }while(0)
  #define CMASK(P0,P1,t) do{ if constexpr(MODE!=1){ int jb_=(t)-(NT-4); if(jb_>=0)cmask(P0,P1,jb_,qrel,hi);} }while(0)
  bool resc=false;
  #define START(P0,P1) do{ resc=false; \
    if constexpr(!NOREF){ const float rm=rowmax(P0,P1); const float dl=(rm>-1e30f)?rm:0.f; mhat=fadd_s(mhat,dl); \
      _Pragma("unroll") for(int r=0;r<16;++r){P0[r]=fsub_s(P0[r],dl);P1[r]=fsub_s(P1[r],dl);} \
      } \
    _Pragma("unroll") for(int r=0;r<16;++r)P0[r]=__builtin_amdgcn_exp2f(P0[r]); }while(0)
  #define RESC() do{ if(resc){ asm volatile("s_waitcnt lgkmcnt(0)":::"memory"); \
      _Pragma("unroll") for(int d_=0;d_<2;++d_) _Pragma("unroll") for(int r=0;r<16;++r)o[d_][r]*=wsf[crow(r,hi)]; } }while(0)
  f32x16 pA0,pA1,pB0,pB1;
  int sl_prev=s0,sl_cur=s0,sl_next=s1;
  #define ROT() do{sl_prev=sl_cur;sl_cur=sl_next;sl_next=(sl_next==(NSLOT-1)*SLOTB)?0:sl_next+SLOTB;}while(0)
  if(first){DMA_K(2,s2);}
  WBX(3);
  qkt(pA0,pA1,Kbase,qr,r32,hi);asm volatile("s_nop 15\n\ts_nop 7":"+v"(pA0),"+v"(pA1));CMASK(pA0,pA1,0);MHOOK(pA0,pA1,0);
  START(pA0,pA1);
  _Pragma("unroll") for(int r=0;r<16;++r)pA1[r]=__builtin_amdgcn_exp2f(pA1[r]);
  WBX(0);
  DMA_K(3,s0);DMA_V(1,s1);
  ROT();
  kload8(kf,kp0+sl_cur);
  WBX(2);
  s16x4 vlo[8],vhi[8]; u32x4 pw0,pw1,pw2,pw3;
  if constexpr((ABL&16)!=0){ _Pragma("unroll") for(int i_=0;i_<8;++i_){vlo[i_]=s16x4{};vhi[i_]=s16x4{};} }
  if constexpr((ABL&4)!=0){ pA0=f32x16{};pA1=f32x16{};pB0=f32x16{};pB1=f32x16{}; }
  if constexpr((ABL&512)!=0){ pw0=u32x4{};pw1=u32x4{};pw2=u32x4{};pw3=u32x4{}; }
  #define PKW(P,B) cvtpk_s(P[B],P[B+1])
  #define PAF(k) __builtin_bit_cast(bf16x8,pw##k)
  #define VFR(i) (bf16x8){vlo[i][0],vlo[i][1],vlo[i][2],vlo[i][3],vhi[i][0],vhi[i][1],vhi[i][2],vhi[i][3]}
  #define PIN(x) asm volatile("":"+v"(x))
  #define MX3(a,b,c) __builtin_fmaxf(__builtin_fmaxf((a),(b)),(c))
  #define GAPA(MF,A0,A1,A2,A3,W0,W1,PW) do{ if constexpr((ABL&4)==0){ MF; } if constexpr((ABL&512)==0){ sacc+=A0; sacc+=A1; sacc+=A2; sacc+=A3; PIN(sacc); W0; W1; PIN(PW); } if constexpr((ABL&1024)!=0){ rmx_=MX3(rmx_,A0,A1); rmx_=MX3(rmx_,A2,A3); PIN(rmx_); } SBAR(); }while(0)
  #define EX(v) (((ABL&1)!=0)?(v):__builtin_amdgcn_exp2f(v))
  #define GAPB(MF,X,B) do{ if constexpr((ABL&2)==0){ MF; } if constexpr((ABL&1024)!=0){ X[B]=fsub_s(X[B],mhat);X[B+1]=fsub_s(X[B+1],mhat);X[B+2]=fsub_s(X[B+2],mhat);X[B+3]=fsub_s(X[B+3],mhat); } X[B]=EX(X[B]); X[B+1]=EX(X[B+1]); X[B+2]=EX(X[B+2]); X[B+3]=EX(X[B+3]); PIN(X); SBAR(); }while(0)
  #define VRD(i) do{ if constexpr((ABL&16)!=0) break; vlo[i]=vtr(vp_+(((i)>>2)*4096+((i)&3)*1024)); vhi[i]=vtr(vp_+(((i)>>2)*4096+((i)&3)*1024+512)); }while(0)
  #define KRD(G,j) do{ if constexpr((ABL&128)==0){ if(G){ kload2(kf,kp0+sl_next,j); SBAR(); } } }while(0)
  #define STEP(C0,C1,P0,P1,t,GL) do{ SBAR(); \
    const lds_cptr vp_=vp0+sl_prev; \
    VRD(0); SBAR(); float sacc=(P0[0]+P0[1]); float rmx_=0.f; \
    GAPA(C0=__builtin_amdgcn_mfma_f32_32x32x16_bf16(kf[0],qr[0],zero16,0,0,0), P0[2],P0[3],P0[4],P0[5],     pw0[0]=PKW(P0,0), pw0[1]=PKW(P0,2), pw0); \
    VRD(4); SBAR(); GAPA(C1=__builtin_amdgcn_mfma_f32_32x32x16_bf16(kf[1],qr[0],zero16,0,0,0), P0[6],P0[7],P0[8],P0[9],     pw0[2]=PKW(P0,4), pw0[3]=PKW(P0,6), pw0); \
    VRD(1); SBAR(); GAPA(C0=__builtin_amdgcn_mfma_f32_32x32x16_bf16(kf[2],qr[1],C0,0,0,0),   P0[10],P0[11],P0[12],P0[13], pw1[0]=PKW(P0,8), pw1[1]=PKW(P0,10), pw1); \
    VRD(5); SBAR(); GAPA(C1=__builtin_amdgcn_mfma_f32_32x32x16_bf16(kf[3],qr[1],C1,0,0,0),   P0[14],P0[15],P1[0],P1[1],   pw1[2]=PKW(P0,12),pw1[3]=PKW(P0,14), pw1); \
    VRD(2); SBAR(); GAPA(C0=__builtin_amdgcn_mfma_f32_32x32x16_bf16(kf[4],qr[2],C0,0,0,0),   P1[2],P1[3],P1[4],P1[5],     pw2[0]=PKW(P1,0), pw2[1]=PKW(P1,2), pw2); \
    VRD(6); SBAR(); GAPA(C1=__builtin_amdgcn_mfma_f32_32x32x16_bf16(kf[5],qr[2],C1,0,0,0),   P1[6],P1[7],P1[8],P1[9],     pw2[2]=PKW(P1,4), pw2[3]=PKW(P1,6), pw2); \
    VRD(3); SBAR(); GAPA(C0=__builtin_amdgcn_mfma_f32_32x32x16_bf16(kf[6],qr[3],C0,0,0,0),   P1[10],P1[11],P1[12],P1[13], pw3[0]=PKW(P1,8), pw3[1]=PKW(P1,10), pw3); \
    VRD(7); SBAR(); GAPA(C1=__builtin_amdgcn_mfma_f32_32x32x16_bf16(kf[7],qr[3],C1,0,0,0),   P1[14],P1[15],0.f,0.f,       pw3[2]=PKW(P1,12),pw3[3]=PKW(P1,14), pw3); \
    l_reg+=sacc; if constexpr((ABL&1024)!=0){ asm volatile(""::"v"(rmx_)); } \
    if constexpr((ABL&64)==0){ STEP_DMA(t); } \
    if constexpr((ABL&32)!=0){ if(wid>=4){ WAIT_BAR(2); } } \
    if constexpr(NOREF){ if constexpr(MODE==1){ asm volatile("s_nop 7\n\ts_nop 7":"+v"(C0),"+v"(C1)); } CMASKX(C0,C1,t); MHOOK(C0,C1,t); resc=false; } else \
    if constexpr((ABL&256)==0){ \
    asm volatile("s_nop 7\n\ts_nop 7":"+v"(C0),"+v"(C1)); \
    _Pragma("unroll") for(int r=0;r<16;++r){C0[r]=fsub_s(C0[r],mhat);C1[r]=fsub_s(C1[r],mhat);} \
    CMASKX(C0,C1,t); MHOOK(C0,C1,t); \
    { float a=MX3(C0[0],C0[1],C1[0]),b=MX3(C0[2],C0[3],C1[1]); a=MX3(a,C1[2],C1[3]); \
      _Pragma("unroll") for(int r=4;r<16;r+=4){a=MX3(a,C0[r],C0[r+1]);b=MX3(b,C0[r+2],C0[r+3]);a=MX3(a,C1[r],C1[r+1]);b=MX3(b,C1[r+2],C1[r+3]);} \
      float rm=__builtin_fmaxf(a,b); { auto rr=__builtin_amdgcn_permlane32_swap(__float_as_uint(rm),__float_as_uint(rm),false,false); rm=__builtin_fmaxf(__uint_as_float(rr[0]),__uint_as_float(rr[1])); } \
      resc=false; \
      if(__builtin_expect(__any(rm>(float)THRL),0)){ const float dl=__builtin_fmaxf(rm,0.f); mhat+=dl; \
        _Pragma("unroll") for(int r=0;r<16;++r){C0[r]-=dl;C1[r]-=dl;} \
        const float f=__builtin_amdgcn_exp2f(-dl); l_reg*=f; if(hi==0)wsf[r32]=f; resc=true; } } \
    } else { resc=false; } \
    SBAR(); \
    GAPB(o[0]=__builtin_amdgcn_mfma_f32_32x32x16_bf16(PAF(0),VFR(0),o[0],0,0,0), C0,0); \
    GAPB(o[1]=__builtin_amdgcn_mfma_f32_32x32x16_bf16(PAF(0),VFR(4),o[1],0,0,0), C0,4); \
    KRD(GL,0); GAPB(o[0]=__builtin_amdgcn_mfma_f32_32x32x16_bf16(PAF(1),VFR(1),o[0],0,0,0), C0,8); \
    KRD(GL,1); GAPB(o[1]=__builtin_amdgcn_mfma_f32_32x32x16_bf16(PAF(1),VFR(5),o[1],0,0,0), C0,12); \
    KRD(GL,2); GAPB(o[0]=__builtin_amdgcn_mfma_f32_32x32x16_bf16(PAF(2),VFR(2),o[0],0,0,0), C1,0); \
    KRD(GL,3); GAPB(o[1]=__builtin_amdgcn_mfma_f32_32x32x16_bf16(PAF(2),VFR(6),o[1],0,0,0), C1,4); \
    GAPB(o[0]=__builtin_amdgcn_mfma_f32_32x32x16_bf16(PAF(3),VFR(3),o[0],0,0,0), C1,8); \
    GAPB(o[1]=__builtin_amdgcn_mfma_f32_32x32x16_bf16(PAF(3),VFR(7),o[1],0,0,0), C1,12); \
    }while(0)
  int t=1;
  #define CMASKX(P0,P1,t) do{}while(0)
  #define STEP_DMA(t) DMA_K((t)+3,sl_cur); DMA_V((t)+1,sl_next)
  for(;t+5<NT;t+=2){
    STEP(pB0,pB1,pA0,pA1,t,true);     CLOSE_BAR(); RESC(); ROT();
    STEP(pA0,pA1,pB0,pB1,t+1,true);   CLOSE_BAR(); RESC(); ROT();
  }
  #undef STEP_DMA
  #define STEP_DMA(t) DMA_KX((t)+3,sl_cur); DMA_VX((t)+1,sl_next)
  #undef CMASKX
  #define CMASKX(P0,P1,t) CMASK(P0,P1,t)
  for(;t+1<NT;t+=2){
    STEP(pB0,pB1,pA0,pA1,t,(t+1<NT));       CLOSE_BAR(); RESC(); ROT();
    STEP(pA0,pA1,pB0,pB1,t+1,(t+2<NT));     CLOSE_BAR(); RESC(); ROT();
  }
  STEP(pB0,pB1,pA0,pA1,NT-1,false); CLOSE_BAR(); RESC();
  ring=sl_next;
  #undef STEP_DMA
  { float sacc=pB0[0]+pB0[1]; _Pragma("unroll") for(int r=2;r<16;++r)sacc+=pB0[r]; _Pragma("unroll") for(int r=0;r<16;++r)sacc+=pB1[r]; l_reg+=sacc;
    pw0=(u32x4){PKW(pB0,0),PKW(pB0,2),PKW(pB0,4),PKW(pB0,6)};pw1=(u32x4){PKW(pB0,8),PKW(pB0,10),PKW(pB0,12),PKW(pB0,14)};pw2=(u32x4){PKW(pB1,0),PKW(pB1,2),PKW(pB1,4),PKW(pB1,6)};pw3=(u32x4){PKW(pB1,8),PKW(pB1,10),PKW(pB1,12),PKW(pB1,14)};
    SBAR(); pv(o,vb0+sl_cur,PAF(0),PAF(1),PAF(2),PAF(3)); }
  #undef PKW
  #undef PAF
  #undef VFR
  #undef PIN
  #undef MX3
  #undef GAPA
  #undef GAPB
  #undef EX
  #undef VRD
  #undef KRD
  #undef STEP
  #undef CMASKX
  { const bf16*Qnw=Qn+(long)(qbn*QB+wid*QBLK)*LDQ;
    qp0=*reinterpret_cast<const bf16x8*>(&Qnw[(long)r32*LDQ+0*16+hi*8]); qp1=*reinterpret_cast<const bf16x8*>(&Qnw[(long)r32*LDQ+1*16+hi*8]);
    qp2=*reinterpret_cast<const bf16x8*>(&Qnw[(long)r32*LDQ+2*16+hi*8]); qp3=*reinterpret_cast<const bf16x8*>(&Qnw[(long)r32*LDQ+3*16+hi*8]); }
  {auto rr=__builtin_amdgcn_permlane32_swap(__float_as_uint(l_reg),__float_as_uint(l_reg),false,false);l_reg=__uint_as_float(rr[0])+__uint_as_float(rr[1]);}
  if(hi==0)wsf[32+r32]=l_reg;asm volatile("s_waitcnt lgkmcnt(0)":::"memory");
  float rli[16];
  #pragma unroll
  for(int r=0;r<16;++r)rli[r]=__builtin_amdgcn_rcpf(wsf[32+crow(r,hi)]);
  bf16*Ow=Og+(long)(q0+wid*QBLK)*ldo;
  if(est==0){ bf16*stg=(bf16*)(shm+LDS_OST)+wid*2048;
    #pragma unroll
    for(int r=0;r<16;++r){const int orow=crow(r,hi);
      #pragma unroll
      for(int d0=0;d0<2;++d0)stg[orow*64+d0*32+r32]=__float2bfloat16(o[d0][r]*rli[r]);}
    asm volatile("s_waitcnt lgkmcnt(0)":::"memory");
    #pragma unroll
    for(int i=0;i<4;++i){const int row=i*8+(lane>>3),ch=lane&7; const u32x4 v=*(const u32x4*)(stg+row*64+ch*8); ATTN_STORE16(Ow+(long)row*ldo+ch*8,v);} }
  else if(est==1){ bf16*s1=(bf16*)(shm+LDS_S1)+wid*2048;
    #pragma unroll
    for(int r=0;r<16;++r){const int orow=crow(r,hi);
      #pragma unroll
      for(int d0=0;d0<2;++d0)s1[orow*64+d0*32+r32]=__float2bfloat16(o[d0][r]*rli[r]);} }
  else{ bf16*s1=(bf16*)(shm+LDS_S1)+wid*2048; bf16*stg=(bf16*)(shm+LDS_OST)+wid*2048; bf16*dst=(est==2)?stg:s1;
    const float*dc=(const float*)(shm+LDS_DC); float*ssb=(float*)(shm+LDS_SSB)+wid*32; const float lam=dc[128];
    #pragma unroll
    for(int r=0;r<16;++r){const int orow=crow(r,hi);
      #pragma unroll
      for(int d0=0;d0<2;++d0){const int idx=orow*64+d0*32+r32; const float o1=__bfloat162float(s1[idx]); dst[idx]=__float2bfloat16(o1-lam*(o[d0][r]*rli[r]));}}
    asm volatile("s_waitcnt lgkmcnt(0)":::"memory");
    const int ch=lane&7;
    #pragma unroll
    for(int i=0;i<4;++i){const int row=i*8+(lane>>3); const u32x4 v=*(const u32x4*)(dst+row*64+ch*8);
      float dv[8];
      #pragma unroll
      for(int e=0;e<4;++e){dv[2*e]=__uint_as_float(v[e]<<16);dv[2*e+1]=__uint_as_float(v[e]&0xffff0000u);}
      float ss=0.f;
      #pragma unroll
      for(int e=0;e<8;++e)ss+=dv[e]*dv[e];
      ss+=__shfl_xor(ss,1);ss+=__shfl_xor(ss,2);ss+=__shfl_xor(ss,4);
      if(est==2){ if(ch==0)ssb[row]=ss; }
      else{ const float rs=1.0f/sqrtf((ss+ssb[row])*(1.0f/128.0f)+1e-5f);
        const u32x4 v0=*(const u32x4*)(stg+row*64+ch*8);
        const f32x4 g0a=*(const f32x4*)(dc+ch*8),g0b=*(const f32x4*)(dc+ch*8+4),g1a=*(const f32x4*)(dc+64+ch*8),g1b=*(const f32x4*)(dc+64+ch*8+4);
        u32x4 w0,w1;
        #pragma unroll
        for(int e=0;e<4;++e){ const float ga=(e<2)?g0a[2*e]:g0b[2*e-4], gb=(e<2)?g0a[2*e+1]:g0b[2*e-3], ha=(e<2)?g1a[2*e]:g1b[2*e-4], hb=(e<2)?g1a[2*e+1]:g1b[2*e-3];
          w0[e]=cvtpk_s(__uint_as_float(v0[e]<<16)*rs*ga,__uint_as_float(v0[e]&0xffff0000u)*rs*gb);
          w1[e]=cvtpk_s(dv[2*e]*rs*ha,dv[2*e+1]*rs*hb); }
        ATTN_STORE16(Ow+(long)row*ldo+ch*8,w0); ATTN_STORE16(Ow+(long)row*ldo+64+ch*8,w1); } } }
  asm volatile("s_waitcnt lgkmcnt(0)\n\ts_barrier":::"memory");
  #undef DMA_K
  #undef DMA_V
  #undef DMA_KX
  #undef DMA_VX
  #undef CMASK
  #undef MHOOK
  #undef START
  #undef RESC
  #undef ROT
  #undef WBX
  #undef CLOSE_BAR
}
constexpr int V_SLOTB=16384;
constexpr int X_K=0, X_V=NSLOT*SLOTB, X_WS=X_V+NSLOT*V_SLOTB, X_ST=X_WS+NW*256, X_DC=X_ST+NW*8192, X_BYTES=X_DC+544;
__device__ __forceinline__ void pv128(f32x16*o,int vb,bf16x8 pa0,bf16x8 pa1,bf16x8 pa2,bf16x8 pa3){
  #pragma unroll
  for(int d0=0;d0<4;++d0){s16x4 lo[4],hi[4];
    #pragma unroll
    for(int ks=0;ks<4;++ks){
      asm volatile("ds_read_b64_tr_b16 %0,%1 offset:%c2":"=&v"(lo[ks]):"v"(vb),"i"(d0*4096+ks*1024):"memory");
      asm volatile("ds_read_b64_tr_b16 %0,%1 offset:%c2":"=&v"(hi[ks]):"v"(vb),"i"(d0*4096+ks*1024+512):"memory");}
    asm volatile("s_waitcnt lgkmcnt(0)":::"memory");SBAR();
    #define PK(k) (bf16x8){lo[k][0],lo[k][1],lo[k][2],lo[k][3],hi[k][0],hi[k][1],hi[k][2],hi[k][3]}
    o[d0]=__builtin_amdgcn_mfma_f32_32x32x16_bf16(pa0,PK(0),o[d0],0,0,0);
    o[d0]=__builtin_amdgcn_mfma_f32_32x32x16_bf16(pa1,PK(1),o[d0],0,0,0);
    o[d0]=__builtin_amdgcn_mfma_f32_32x32x16_bf16(pa2,PK(2),o[d0],0,0,0);
    o[d0]=__builtin_amdgcn_mfma_f32_32x32x16_bf16(pa3,PK(3),o[d0],0,0,0);
    #undef PK
  }
}
template<int THRL> __device__ __forceinline__ void attn_unit_dv128(int qb,const bf16*__restrict__ QKVb,int qcol,int kcol,int vcol,bf16*Og,int ldo,char*shm,int est,int kncol,int first,int&ring,int qncol,int qbn,bf16x8&qp0,bf16x8&qp1,bf16x8&qp2,bf16x8&qp3){
  const bf16*Qg=QKVb+qcol,*Kg=QKVb+kcol,*Vg=QKVb+vcol,*Kn=QKVb+kncol,*Qn=QKVb+qncol;
  int tid_=threadIdx.x; asm volatile("":"+v"(tid_));
  const int tid=tid_,lane=tid&63,r32=lane&31,hi=lane>>5; const int wid=__builtin_amdgcn_readfirstlane(tid>>6);
  const int q0=qb*QB;
  const bf16*Qw=Qg+(long)(q0+wid*QBLK)*LDQ;
  const unsigned lds0=(unsigned)(uintptr_t)shm;
  float*wsf=(float*)(shm+X_WS)+wid*64;
  const bf16*ksrc=Kg+wid*8, *knsrc=Kn+wid*8;
  const bf16*vsrc=Vg+(long)(16*(wid&3))*LDQ+(wid>>2)*32;
  const unsigned koff=(unsigned)lane*(LDQ*2u), voff=(unsigned)(lane>>2)*(LDQ*2u)+(unsigned)(lane&3)*16u;
  const unsigned kdst=lds0+X_K+wid*1024, vdst=lds0+X_V+wid*1024;
  const int NT=(q0+QB)/KVBLK;
  #define DMA_K(t,slot) glds16(ksrc+(long)(t)*KVBLK*LDQ,koff,(unsigned)__builtin_amdgcn_readfirstlane(kdst+(slot)))
  #define DMA_V(t,vslot) do{ const bf16*s_=vsrc+(long)(t)*KVBLK*LDQ; glds16(s_,voff,(unsigned)__builtin_amdgcn_readfirstlane(vdst+(vslot))); glds16(s_+64,voff,(unsigned)__builtin_amdgcn_readfirstlane(vdst+(vslot)+8192)); }while(0)
  #define DMA_KX(t,slot) do{ const int t_=(t); const bf16*s_=(t_<NT)?(ksrc+(long)t_*KVBLK*LDQ):(knsrc+(long)(t_-NT)*KVBLK*LDQ); glds16(s_,koff,(unsigned)__builtin_amdgcn_readfirstlane(kdst+(slot))); }while(0)
  #define DMA_VX(t,vslot) do{ const int t_=(t); DMA_V((t_<NT)?t_:(t_-NT),vslot); }while(0)
  const int vb0=(int)(lds0+X_V)+((lane>>4)&1)*32+(lane&3)*8+(4*hi+((lane&15)>>2))*64;
  const int s0=ring, s1=(s0==(NSLOT-1)*SLOTB)?0:s0+SLOTB, s2=(s1==(NSLOT-1)*SLOTB)?0:s1+SLOTB;
  const char*Kbase=shm+X_K+s0; bf16x8 kf[8];
  const lds_cptr shm3=(lds_cptr)shm; const lds_cptr kp0=shm3+X_K+hi*1024+r32*16; const lds_cptr vp0=shm3+X_V+((lane>>4)&1)*32+(lane&3)*8+(4*hi+((lane&15)>>2))*64;
  if(first){DMA_K(0,s0);DMA_V(0,2*s0);DMA_K(1,s1);}
  bf16x8 qr[4];
  if(first){
    #pragma unroll
    for(int d0=0;d0<4;++d0)qr[d0]=*reinterpret_cast<const bf16x8*>(&Qw[(long)r32*LDQ+d0*16+hi*8]); }
  else{ qr[0]=qp0;qr[1]=qp1;qr[2]=qp2;qr[3]=qp3; }
  float mhat=0.f,l_reg=0.f;f32x16 o[4];o[0]=f32x16{};o[1]=f32x16{};o[2]=f32x16{};o[3]=f32x16{};const f32x16 zero16=f32x16{};
  const int qrel=wid*QBLK+r32;
  #define CMASK(P0,P1,t) do{ int jb_=(t)-(NT-4); if(jb_>=0)cmask(P0,P1,jb_,qrel,hi); }while(0)
  bool resc=false;
  #define RESC() do{ if(resc){ asm volatile("s_waitcnt lgkmcnt(0)":::"memory"); \
      _Pragma("unroll") for(int d_=0;d_<4;++d_) _Pragma("unroll") for(int r=0;r<16;++r)o[d_][r]*=wsf[crow(r,hi)]; } }while(0)
  f32x16 c0,c1; u32x4 pw0,pw1,pw2,pw3;
  int sl_prev=s0,sl_cur=s0,sl_next=s1;
  #define ROT() do{sl_prev=sl_cur;sl_cur=sl_next;sl_next=(sl_next==(NSLOT-1)*SLOTB)?0:sl_next+SLOTB;}while(0)
  if(first){DMA_K(2,s2);}
  WAIT_BAR(4);
  #define PKW(P,B) cvtpk_s(P[B],P[B+1])
  qkt(c0,c1,Kbase,qr,r32,hi);asm volatile("s_nop 15\n\ts_nop 7":"+v"(c0),"+v"(c1));CMASK(c0,c1,0);
  { float dl=0.f; if constexpr(!NOREF){ const float rm=rowmax(c0,c1); dl=(rm>-1e30f)?rm:0.f; } mhat=dl;
    #pragma unroll
    for(int r=0;r<16;++r){c0[r]=__builtin_amdgcn_exp2f(c0[r]-dl);c1[r]=__builtin_amdgcn_exp2f(c1[r]-dl);}
    float sa=0.f,sb=0.f;
    #pragma unroll
    for(int r=0;r<16;++r){sa+=c0[r];sb+=c1[r];}
    l_reg=sa+sb;
    pw0=(u32x4){PKW(c0,0),PKW(c0,2),PKW(c0,4),PKW(c0,6)};pw1=(u32x4){PKW(c0,8),PKW(c0,10),PKW(c0,12),PKW(c0,14)};pw2=(u32x4){PKW(c1,0),PKW(c1,2),PKW(c1,4),PKW(c1,6)};pw3=(u32x4){PKW(c1,8),PKW(c1,10),PKW(c1,12),PKW(c1,14)}; }
  WAIT_BAR(0);
  DMA_K(3,s0);DMA_V(1,2*s1);
  ROT();
  kload8(kf,kp0+sl_cur);
  WAIT_BAR(3);
  s16x4 vlo[4],vhi[4];
  #define PAF(k) __builtin_bit_cast(bf16x8,pw##k)
  #define VFR(i) (bf16x8){vlo[i][0],vlo[i][1],vlo[i][2],vlo[i][3],vhi[i][0],vhi[i][1],vhi[i][2],vhi[i][3]}
  #define PIN(x) asm volatile("":"+v"(x))
  #define MX3(a,b,c) __builtin_fmaxf(__builtin_fmaxf((a),(b)),(c))
  #define EX(v) __builtin_amdgcn_exp2f(v)
  #define VRDX(s,KS) do{ vlo[s]=vtr(vp_+((s)*4096+(KS)*1024)); vhi[s]=vtr(vp_+((s)*4096+(KS)*1024+512)); }while(0)
  #define QKA(MF) do{ MF; SBAR(); }while(0)
  #define GAPX(MF,X,B,RF) do{ MF; RF; X[B]=EX(X[B]); X[B+1]=EX(X[B+1]); sacc+=X[B]; sacc+=X[B+1]; PIN(sacc); PIN(X); SBAR(); }while(0)
  #define PACKW(PW,W,X,B) do{ PW[W]=PKW(X,B); PIN(PW); }while(0)
  #define KRD(G,j) do{ if(G){ kload2(kf,kp0+sl_next,j); SBAR(); } }while(0)
  #define STEP(t,GL) do{ SBAR(); \
    const lds_cptr vp_=vp0+2*sl_prev; \
    VRDX(0,0); SBAR(); QKA(c0=__builtin_amdgcn_mfma_f32_32x32x16_bf16(kf[0],qr[0],zero16,0,0,0)); \
    QKA(c1=__builtin_amdgcn_mfma_f32_32x32x16_bf16(kf[1],qr[0],zero16,0,0,0)); \
    VRDX(1,0); SBAR(); QKA(c0=__builtin_amdgcn_mfma_f32_32x32x16_bf16(kf[2],qr[1],c0,0,0,0)); \
    QKA(c1=__builtin_amdgcn_mfma_f32_32x32x16_bf16(kf[3],qr[1],c1,0,0,0)); \
    VRDX(2,0); SBAR(); QKA(c0=__builtin_amdgcn_mfma_f32_32x32x16_bf16(kf[4],qr[2],c0,0,0,0)); \
    QKA(c1=__builtin_amdgcn_mfma_f32_32x32x16_bf16(kf[5],qr[2],c1,0,0,0)); \
    VRDX(3,0); SBAR(); QKA(c0=__builtin_amdgcn_mfma_f32_32x32x16_bf16(kf[6],qr[3],c0,0,0,0)); \
    QKA(c1=__builtin_amdgcn_mfma_f32_32x32x16_bf16(kf[7],qr[3],c1,0,0,0)); \
    STEP_DMA(t); \
    if constexpr(NOREF){ CMASKX(c0,c1,t); resc=false; } else { \
    asm volatile("s_nop 7\n\ts_nop 7":"+v"(c0),"+v"(c1)); \
    _Pragma("unroll") for(int r=0;r<16;++r){c0[r]=fsub_s(c0[r],mhat);c1[r]=fsub_s(c1[r],mhat);} \
    CMASKX(c0,c1,t); \
    { float a=MX3(c0[0],c0[1],c1[0]),b=MX3(c0[2],c0[3],c1[1]); a=MX3(a,c1[2],c1[3]); \
      _Pragma("unroll") for(int r=4;r<16;r+=4){a=MX3(a,c0[r],c0[r+1]);b=MX3(b,c0[r+2],c0[r+3]);a=MX3(a,c1[r],c1[r+1]);b=MX3(b,c1[r+2],c1[r+3]);} \
      float rm=__builtin_fmaxf(a,b); { auto rr=__builtin_amdgcn_permlane32_swap(__float_as_uint(rm),__float_as_uint(rm),false,false); rm=__builtin_fmaxf(__uint_as_float(rr[0]),__uint_as_float(rr[1])); } \
      resc=false; \
      if(__builtin_expect(__any(rm>(float)THRL),0)){ const float dl=__builtin_fmaxf(rm,0.f); mhat+=dl; \
        _Pragma("unroll") for(int r=0;r<16;++r){c0[r]-=dl;c1[r]-=dl;} \
        const float f=__builtin_amdgcn_exp2f(-dl); l_reg*=f; if(hi==0)wsf[r32]=f; resc=true; } } \
    } \
    SBAR(); float sacc=0.f; \
    GAPX(o[0]=__builtin_amdgcn_mfma_f32_32x32x16_bf16(PAF(0),VFR(0),o[0],0,0,0), c0,0,  VRDX(0,1)); \
    GAPX(o[1]=__builtin_amdgcn_mfma_f32_32x32x16_bf16(PAF(0),VFR(1),o[1],0,0,0), c0,2,  VRDX(1,1)); \
    GAPX(o[2]=__builtin_amdgcn_mfma_f32_32x32x16_bf16(PAF(0),VFR(2),o[2],0,0,0), c0,4,  VRDX(2,1)); \
    GAPX(o[3]=__builtin_amdgcn_mfma_f32_32x32x16_bf16(PAF(0),VFR(3),o[3],0,0,0), c0,6,  VRDX(3,1)); \
    GAPX(o[0]=__builtin_amdgcn_mfma_f32_32x32x16_bf16(PAF(1),VFR(0),o[0],0,0,0), c0,8,  VRDX(0,2)); PACKW(pw0,0,c0,0); SBAR(); \
    GAPX(o[1]=__builtin_amdgcn_mfma_f32_32x32x16_bf16(PAF(1),VFR(1),o[1],0,0,0), c0,10, VRDX(1,2)); PACKW(pw0,1,c0,2); SBAR(); \
    GAPX(o[2]=__builtin_amdgcn_mfma_f32_32x32x16_bf16(PAF(1),VFR(2),o[2],0,0,0), c0,12, VRDX(2,2)); PACKW(pw0,2,c0,4); SBAR(); \
    GAPX(o[3]=__builtin_amdgcn_mfma_f32_32x32x16_bf16(PAF(1),VFR(3),o[3],0,0,0), c0,14, VRDX(3,2)); PACKW(pw0,3,c0,6); SBAR(); \
    KRD(GL,0); GAPX(o[0]=__builtin_amdgcn_mfma_f32_32x32x16_bf16(PAF(2),VFR(0),o[0],0,0,0), c1,0,  VRDX(0,3)); PACKW(pw1,0,c0,8);  SBAR(); \
    KRD(GL,1); GAPX(o[1]=__builtin_amdgcn_mfma_f32_32x32x16_bf16(PAF(2),VFR(1),o[1],0,0,0), c1,2,  VRDX(1,3)); PACKW(pw1,1,c0,10); SBAR(); \
    KRD(GL,2); GAPX(o[2]=__builtin_amdgcn_mfma_f32_32x32x16_bf16(PAF(2),VFR(2),o[2],0,0,0), c1,4,  VRDX(2,3)); PACKW(pw1,2,c0,12); SBAR(); \
    KRD(GL,3); GAPX(o[3]=__builtin_amdgcn_mfma_f32_32x32x16_bf16(PAF(2),VFR(3),o[3],0,0,0), c1,6,  VRDX(3,3)); PACKW(pw1,3,c0,14); SBAR(); \
    GAPX(o[0]=__builtin_amdgcn_mfma_f32_32x32x16_bf16(PAF(3),VFR(0),o[0],0,0,0), c1,8,  (void)0); PACKW(pw2,0,c1,0); SBAR(); \
    GAPX(o[1]=__builtin_amdgcn_mfma_f32_32x32x16_bf16(PAF(3),VFR(1),o[1],0,0,0), c1,10, (void)0); PACKW(pw2,1,c1,2); SBAR(); \
    GAPX(o[2]=__builtin_amdgcn_mfma_f32_32x32x16_bf16(PAF(3),VFR(2),o[2],0,0,0), c1,12, (void)0); PACKW(pw2,2,c1,4); SBAR(); \
    GAPX(o[3]=__builtin_amdgcn_mfma_f32_32x32x16_bf16(PAF(3),VFR(3),o[3],0,0,0), c1,14, (void)0); PACKW(pw2,3,c1,6); SBAR(); \
    PACKW(pw3,0,c1,8); PACKW(pw3,1,c1,10); PACKW(pw3,2,c1,12); PACKW(pw3,3,c1,14); \
    l_reg+=sacc; \
    }while(0)
  int t=1;
  #define CMASKX(P0,P1,t) do{}while(0)
  #define STEP_DMA(t) DMA_K((t)+3,sl_cur); DMA_V((t)+1,2*sl_next)
  for(;t+5<NT;t+=2){
    STEP(t,true);     WAIT_BAR(3); RESC(); ROT();
    STEP(t+1,true);   WAIT_BAR(3); RESC(); ROT();
  }
  #undef CMASKX
  #undef STEP_DMA
  #define CMASKX(P0,P1,t) CMASK(P0,P1,t)
  #define STEP_DMA(t) DMA_KX((t)+3,sl_cur); DMA_VX((t)+1,2*sl_next)
  for(;t+1<NT;t+=2){
    STEP(t,(t+1<NT));       WAIT_BAR(3); RESC(); ROT();
    STEP(t+1,(t+2<NT));     WAIT_BAR(3); RESC(); ROT();
  }
  STEP(NT-1,false); WAIT_BAR(3); RESC();
  ring=sl_next;
  #undef STEP_DMA
  #undef CMASKX
  SBAR(); pv128(o,vb0+2*sl_cur,PAF(0),PAF(1),PAF(2),PAF(3));
  #undef PKW
  #undef PAF
  #undef PACKW
  #undef VFR
  #undef PIN
  #undef MX3
  #undef EX
  #undef VRDX
  #undef QKA
  #undef GAPX
  #undef KRD
  #undef STEP
  { const bf16*Qnw=Qn+(long)(qbn*QB+wid*QBLK)*LDQ;
    qp0=*reinterpret_cast<const bf16x8*>(&Qnw[(long)r32*LDQ+0*16+hi*8]); qp1=*reinterpret_cast<const bf16x8*>(&Qnw[(long)r32*LDQ+1*16+hi*8]);
    qp2=*reinterpret_cast<const bf16x8*>(&Qnw[(long)r32*LDQ+2*16+hi*8]); qp3=*reinterpret_cast<const bf16x8*>(&Qnw[(long)r32*LDQ+3*16+hi*8]); }
  {auto rr=__builtin_amdgcn_permlane32_swap(__float_as_uint(l_reg),__float_as_uint(l_reg),false,false);l_reg=__uint_as_float(rr[0])+__uint_as_float(rr[1]);}
  if(hi==0)wsf[32+r32]=l_reg;asm volatile("s_waitcnt lgkmcnt(0)":::"memory");
  float rli[16];
  #pragma unroll
  for(int r=0;r<16;++r)rli[r]=__builtin_amdgcn_rcpf(wsf[32+crow(r,hi)]);
  bf16*st=(bf16*)(shm+X_ST)+wid*4096;
  if(est==1){
    #pragma unroll
    for(int r=0;r<16;++r){const int orow=crow(r,hi);
      #pragma unroll
      for(int d0=0;d0<4;++d0)st[orow*128+d0*32+r32]=__float2bfloat16(o[d0][r]*rli[r]);} }
  else{ const float*dc=(const float*)(shm+X_DC); const float lam=dc[128];
    #pragma unroll
    for(int r=0;r<16;++r){const int orow=crow(r,hi);
      #pragma unroll
      for(int d0=0;d0<4;++d0){const int idx=orow*128+d0*32+r32; const float o1=__bfloat162float(st[idx]); st[idx]=__float2bfloat16(o1-lam*(o[d0][r]*rli[r]));}}
    asm volatile("s_waitcnt lgkmcnt(0)":::"memory");
    bf16*Ow=Og+(long)(q0+wid*QBLK)*ldo; const int ch=lane&15;
    const f32x4 ga=*(const f32x4*)(dc+ch*8),gb=*(const f32x4*)(dc+ch*8+4);
    #pragma unroll
    for(int i=0;i<8;++i){const int row=i*4+(lane>>4); const u32x4 v=*(const u32x4*)(st+row*128+ch*8);
      float dv[8];
      #pragma unroll
      for(int e=0;e<4;++e){dv[2*e]=__uint_as_float(v[e]<<16);dv[2*e+1]=__uint_as_float(v[e]&0xffff0000u);}
      float ss=0.f;
      #pragma unroll
      for(int e=0;e<8;++e)ss+=dv[e]*dv[e];
      ss+=__shfl_xor(ss,1);ss+=__shfl_xor(ss,2);ss+=__shfl_xor(ss,4);ss+=__shfl_xor(ss,8);
      const float rs=1.0f/sqrtf(ss*(1.0f/128.0f)+1e-5f);
      u32x4 w; w[0]=cvtpk_s(dv[0]*rs*ga[0],dv[1]*rs*ga[1]); w[1]=cvtpk_s(dv[2]*rs*ga[2],dv[3]*rs*ga[3]); w[2]=cvtpk_s(dv[4]*rs*gb[0],dv[5]*rs*gb[1]); w[3]=cvtpk_s(dv[6]*rs*gb[2],dv[7]*rs*gb[3]);
      ATTN_STORE16(Ow+(long)row*ldo+ch*8,w); } }
  asm volatile("s_waitcnt lgkmcnt(0)\n\ts_barrier":::"memory");
  #undef DMA_K
  #undef DMA_V
  #undef DMA_KX
  #undef DMA_VX
  #undef CMASK
  #undef RESC
  #undef ROT
}
constexpr int ATTN_LDS_BYTES=LDS_BYTES;
#undef SBAR
#undef WAIT_BAR
}
#ifndef ATT_A_MODE
#define ATT_A_MODE 1
#endif
#ifndef ATT_B_MODE
#define ATT_B_MODE 2
#endif
#ifndef ATT_THRL
#define ATT_THRL 8
#endif

constexpr int NWAVES = 8;
constexpr int BATCH = 16, T = 2048, D = 1024, HD = 64, FF = 2816, NQKV = 3072;
constexpr int M = BATCH * T;
constexpr float NORM_EPS = 1e-5f;
constexpr float LAMBDA_INIT = 0.35550906759096934f;
static_assert(M == pg8::TOK, "row count");

constexpr size_t MiB = 1u << 20;
constexpr size_t WS_CTL = 0, CTL_ZERO_BYTES = 1 * MiB;
constexpr size_t WS_ROPE = 1 * MiB;
constexpr size_t WS_SSP = 3 * MiB;
constexpr size_t WS_KMP = 5 * MiB;
constexpr size_t WS_W = 6 * MiB, W_LAYER = 25 * MiB;
constexpr size_t W_IN = 0, W_OUT = 6 * MiB, W_GU = 8 * MiB, W_DN = 19 * MiB;
constexpr size_t WS_HB = 56 * MiB;
constexpr size_t WS_OB = 120 * MiB;
constexpr size_t WS_QKV = 184 * MiB;
constexpr size_t WS_OS = 376 * MiB;
constexpr size_t WS_END = 504 * MiB;
static_assert(WS_ROPE == pg8::XWS_ROPE && WS_SSP == pg8::XWS_SSP && WS_KMP == pg8::XWS_KMP && WS_HB == pg8::XWS_HB && WS_QKV == pg8::XWS_QKV, "d_ws map vs epilogues");
constexpr int CW_BAR = 4096;
constexpr int RING_OFF = 0, RING_BYTES = 131072;
constexpr int LDSCTL_OFF = 143360, MISC_OFF = LDSCTL_OFF + 320;
constexpr int PTAB_OFF = LDSCTL_OFF + 512;
constexpr int RTAB_OFF = LDSCTL_OFF + 1024;
constexpr int LDS_BYTES = 163840;
static_assert(attn_body::X_BYTES <= LDSCTL_OFF && attn_body::DIL_LUT_OFF == RTAB_OFF && attn_body::DIL_LUT_OFF + 4 * attn_body::DIL_LUT_N <= LDS_BYTES && attn_body::ATTN_LDS_BYTES_DIFF <= RING_BYTES && RTAB_OFF + 11 * 1024 <= LDS_BYTES && MISC_OFF + 128 <= PTAB_OFF && PTAB_OFF + 160 <= RTAB_OFF, "LDS map");

#define GAS __attribute__((address_space(1)))
#define LAS __attribute__((address_space(3)))
typedef unsigned short bf16;
typedef unsigned v4u __attribute__((ext_vector_type(4)));
typedef unsigned v2u __attribute__((ext_vector_type(2)));
typedef float f32x4 __attribute__((ext_vector_type(4)));
typedef GAS unsigned gu32;
#define RLX_AGENT __ATOMIC_RELAXED, __HIP_MEMORY_SCOPE_AGENT
#define LDS_WAIT() asm volatile("s_waitcnt lgkmcnt(0)" ::: "memory")
#define VM_WAIT() asm volatile("s_waitcnt vmcnt(0)" ::: "memory")
__device__ __forceinline__ unsigned f2bf(float f) { unsigned u = __builtin_bit_cast(unsigned, f); return (u + 0x7fffu + ((u >> 16) & 1u)) >> 16; }
__device__ __forceinline__ unsigned pk2(float lo, float hi) { return f2bf(lo) | (f2bf(hi) << 16); }
__device__ __forceinline__ float bf_lo(unsigned w) { return __uint_as_float(w << 16); }
__device__ __forceinline__ float bf_hi(unsigned w) { return __uint_as_float(w & 0xffff0000u); }

#define XB_TMO      128
#define XB_XCNT(j)  (256  + 64 * (j))
#define XB_XSUB(j)  (1280 + 64 * (j))
#define XB_XGEN(j)  (2304 + 64 * (j))
#define XB_TOP      3328
#define XB_TOPGEN   3392
#define XCD_BAR_WORDS 3456
#define XB_SPIN_CAP (1u << 18)

__device__ __forceinline__ unsigned xb_ld(unsigned* p)              { return __hip_atomic_load(p, __ATOMIC_RELAXED, __HIP_MEMORY_SCOPE_AGENT); }
__device__ __forceinline__ unsigned xb_add(unsigned* p, unsigned v) { return __hip_atomic_fetch_add(p, v, __ATOMIC_RELAXED, __HIP_MEMORY_SCOPE_AGENT); }
__device__ __forceinline__ unsigned xb_xcc_id() { return (unsigned)__builtin_amdgcn_s_getreg((3 << 11) | 20) & 0xFu; }
#define XB_SPIN(cond, bar) do { unsigned _sp = 0; while (cond) { __builtin_amdgcn_s_sleep(1); \
    if ((++_sp & 255u) == 0u) { if (xb_ld(&(bar)[XB_TMO])) break; if (_sp > XB_SPIN_CAP) { atomicAdd(&(bar)[XB_TMO], 1u); break; } } } } while (0)

struct XcdBarrier {
    unsigned* bar; unsigned x;
    volatile LAS unsigned* st;
};

__device__ __forceinline__ XcdBarrier xcd_barrier_post(unsigned* bar, volatile LAS unsigned* st) {
    XcdBarrier b; b.bar = bar; b.x = xb_xcc_id(); b.st = st;
    if (threadIdx.x == 0) (void)xb_add(&bar[XB_XCNT(b.x)], 1u);
    return b;
}
__device__ __forceinline__ void xcd_barrier_complete(unsigned* bar, unsigned x, unsigned& nloc, unsigned& nx) {
    const unsigned G = gridDim.x * gridDim.y * gridDim.z;
    unsigned sum, cnt, mine, sp = 0u;
    for (;;) {
        sum = 0u; cnt = 0u; mine = 0u;
#pragma unroll
        for (unsigned j = 0; j < 16; ++j) { const unsigned c = xb_ld(&bar[XB_XCNT(j)]); sum += c; cnt += (c > 0u) ? 1u : 0u; mine = (j == x) ? c : mine; }
        if (sum == G) break;
        __builtin_amdgcn_s_sleep(1);
        if ((++sp & 255u) == 0u) { if (xb_ld(&bar[XB_TMO])) break; if (sp > XB_SPIN_CAP) { atomicAdd(&bar[XB_TMO], 1u); break; } }
    }
    nloc = mine > 0u ? mine : 1u; nx = cnt > 0u ? cnt : 1u;
}

__device__ __forceinline__ void xcd_barrier(const XcdBarrier& b) {
    asm volatile("s_waitcnt vmcnt(0)" ::: "memory");
    __syncthreads();
    if (threadIdx.x == 0) {
        unsigned* bar = b.bar;
        __builtin_amdgcn_s_waitcnt(0);
        unsigned nloc = b.st[0], nx = b.st[1];
        if (nloc == 0u) { xcd_barrier_complete(bar, b.x, nloc, nx); b.st[0] = nloc; b.st[1] = nx; }
        const unsigned old = xb_add(&bar[XB_XSUB(b.x)], 1u);
        const unsigned gen = old / nloc;
        if (old + 1u == (gen + 1u) * nloc) {
            __builtin_amdgcn_fence(__ATOMIC_RELEASE, "agent");
            asm volatile("s_waitcnt vmcnt(0)" ::: "memory");
            const unsigned og = xb_add(&bar[XB_TOP], 1u);
            const unsigned tg = og / nx;
            if (og + 1u == (tg + 1u) * nx) xb_add(&bar[XB_TOPGEN], 1u);
            else XB_SPIN(xb_ld(&bar[XB_TOPGEN]) == tg, bar);
            __builtin_amdgcn_fence(__ATOMIC_ACQUIRE, "agent");
            xb_add(&bar[XB_XGEN(b.x)], 1u);
            asm volatile("s_waitcnt vmcnt(0)" ::: "memory");
        } else {
            XB_SPIN(xb_ld(&bar[XB_XGEN(b.x)]) == gen, bar);
            __builtin_amdgcn_fence(__ATOMIC_ACQUIRE, "agent");
            asm volatile("s_waitcnt vmcnt(0)" ::: "memory");
        }
    }
    __syncthreads();
}


struct Frame {
    LAS unsigned char* lds;
    volatile LAS unsigned* MISC;
    gu32* ctl;
    int tid, lane, wave;
    int vcu, G, bx;
};
#ifndef FIN_ST
#define FIN_ST 1
#endif
#ifndef P0_ST
#define P0_ST 0
#endif
__device__ __forceinline__ float wave_sum(float v) {
#pragma unroll
    for (int o = 1; o < 64; o <<= 1) v += __shfl_xor(v, o);
    return v;
}
__device__ __forceinline__ void p0_transpose_item(const float* W, const float* g, int K, int N, bf16* WT, int mode, LAS float* scr, int item, int lane) {
    const int nblk = N / 32, kb = item / nblk, nb = item % nblk, k0 = 64 * kb, n0 = 32 * nb;
    const int orow = (mode == 0) ? n0 : (256 * (n0 >> 7) + (n0 & 127) + (mode == 2 ? 128 : 0));
    f32x4 w[8];
#pragma unroll
    for (int i = 0; i < 8; ++i) w[i] = MEM_NT ? __builtin_nontemporal_load((const GAS f32x4*)(W + (size_t)(k0 + 8 * i + (lane >> 3)) * N + n0 + 4 * (lane & 7))) : *(const GAS f32x4*)(W + (size_t)(k0 + 8 * i + (lane >> 3)) * N + n0 + 4 * (lane & 7));
    if (g) {
#pragma unroll
        for (int i = 0; i < 8; ++i) w[i] = w[i] * g[k0 + 8 * i + (lane >> 3)];
    }
#pragma unroll
    for (int i = 0; i < 8; ++i) { LAS float* d = scr + (8 * i + (lane >> 3)) * 33 + 4 * (lane & 7); d[0] = w[i].x; d[1] = w[i].y; d[2] = w[i].z; d[3] = w[i].w; }
    LDS_WAIT(); asm volatile("" ::: "memory");
    const int c = lane & 7;
#pragma unroll
    for (int j = 0; j < 4; ++j) { const int n = (lane >> 3) + 8 * j; const LAS float* s = scr + (8 * c) * 33 + n;
        v4u o; o.x = pk2(s[0 * 33], s[1 * 33]); o.y = pk2(s[2 * 33], s[3 * 33]); o.z = pk2(s[4 * 33], s[5 * 33]); o.w = pk2(s[6 * 33], s[7 * 33]);
        if (P0_ST == 2) ST16_SC1((GAS v4u*)(WT + (size_t)(orow + n) * K + k0 + 8 * c), o); else *(GAS v4u*)(WT + (size_t)(orow + n) * K + k0 + 8 * c) = o; }
    LDS_WAIT(); asm volatile("" ::: "memory");
}

struct Args { const void* in[18]; float* out; unsigned char* ws; };

template <class Sched> __device__ __forceinline__ void prep_rtab(Frame& F, const Sched& S, const float* ssp, int nparts) {
    LAS float* rt = (LAS float*)(F.lds + RTAB_OFF);
    pg8::Unit u;
    for (int i = 0; S.next(i, u); ++i) {
        if ((i & 1) == (F.tid >> 8)) {
            const int rl = F.tid & 255; const int row = u.pm * 256 + rl; float s = 0.f;
            for (int j = 0; j < nparts; ++j) s += ssp[(size_t)j * M + row];
            rt[i * 256 + rl] = 1.0f / sqrtf(s * (1.0f / D) + NORM_EPS);
        }
    }
    LDS_WAIT(); __syncthreads();
}


__device__ __forceinline__ unsigned char* get_ptr(volatile LAS unsigned* t, int k) {
    { unsigned a_ = (unsigned)(uintptr_t)t; asm volatile("" : "+v"(a_)); t = (volatile LAS unsigned*)a_; }
    const unsigned lo = (unsigned)__builtin_amdgcn_readfirstlane((int)t[2 * k]), hi = (unsigned)__builtin_amdgcn_readfirstlane((int)t[2 * k + 1]);
    unsigned long long v = (unsigned long long)lo | ((unsigned long long)hi << 32); asm volatile("" : "+s"(v)); return (unsigned char*)(GAS unsigned char*)v; }
#define PTAB ((volatile LAS unsigned*)((LAS unsigned char*)lds + PTAB_OFF))
#define IN_PTR(T, k) ((T*)get_ptr(PTAB, (k)))
#define OUT_PTR() ((float*)get_ptr(PTAB, 18))
#define WS_BASE() (get_ptr(PTAB, 19))
#define WS_PTR(T, off) ((T*)(WS_BASE() + (off)))
__device__ __forceinline__ int vcu_of(int bx, int G) { return (G % 8 == 0) ? (bx % 8) * (G / 8) + bx / 8 : bx; }
#define GRID_BAR() do { XcdBarrier b_; b_.bar = WS_PTR(unsigned, WS_CTL) + CW_BAR; b_.x = xb_xcc_id(); b_.st = (volatile LAS unsigned*)((LAS unsigned char*)lds + MISC_OFF) + 8; xcd_barrier(b_); } while (0)
constexpr int CW_GRP = 8192;
__device__ __forceinline__ void group_barrier(unsigned* cnt, unsigned nmemb, unsigned* tmo) {
    asm volatile("s_waitcnt vmcnt(0)" ::: "memory");
    __syncthreads();
    if (threadIdx.x == 0) {
        __builtin_amdgcn_fence(__ATOMIC_RELEASE, "agent");
        asm volatile("s_waitcnt vmcnt(0)" ::: "memory");
        const unsigned old = __hip_atomic_fetch_add(cnt, 1u, __ATOMIC_RELAXED, __HIP_MEMORY_SCOPE_AGENT);
        const unsigned target = (old / nmemb + 1u) * nmemb;
        unsigned sp = 0u;
        while (__hip_atomic_load(cnt, __ATOMIC_RELAXED, __HIP_MEMORY_SCOPE_AGENT) < target) {
            __builtin_amdgcn_s_sleep(1);
            if ((++sp & 255u) == 0u) { if (__hip_atomic_load(tmo, __ATOMIC_RELAXED, __HIP_MEMORY_SCOPE_AGENT)) break; if (sp > (1u << 20)) { atomicAdd(tmo, 1u); break; } }
        }
        __builtin_amdgcn_fence(__ATOMIC_ACQUIRE, "agent");
        asm volatile("s_waitcnt vmcnt(0)" ::: "memory");
    }
    __syncthreads();
}
__device__ __forceinline__ int opq_s(int v) { asm volatile("" : "+s"(v)); return v; }
__device__ __forceinline__ int opq_v(int v) { asm volatile("" : "+v"(v)); return v; }
#define GROUP_ID() (2 * (opq_s(blockIdx.x) & 7) + ((opq_s(blockIdx.x) >> 3) >> 4))
#define GROUP_BAR() do { unsigned* c_ = WS_PTR(unsigned, WS_CTL); group_barrier(c_ + CW_GRP + 64 * GROUP_ID(), 16u, c_ + CW_BAR + XB_TMO); } while (0)
#ifndef GRP_BAR
#define GRP_BAR 1
#endif
#if GRP && GRP_BAR
#define PHASE_BAR() GROUP_BAR()
#else
#define PHASE_BAR() GRID_BAR()
#endif
#define MK_FRAME() Frame F; F.lds = (LAS unsigned char*)lds; F.MISC = (volatile LAS unsigned*)(F.lds + MISC_OFF); F.ctl = nullptr; F.tid = opq_v(threadIdx.x); F.lane = F.tid & 63; \
    F.wave = __builtin_amdgcn_readfirstlane(F.tid >> 6); F.G = opq_s(gridDim.x); F.bx = opq_s(blockIdx.x); F.vcu = vcu_of(F.bx, F.G)


#ifndef REP_P0
#define REP_P0 1
#endif
#ifndef REP_QKV
#define REP_QKV 1
#endif
#ifndef REP_ATTN0
#define REP_ATTN0 1
#endif
#ifndef REP_ATTN1
#define REP_ATTN1 1
#endif
#ifndef REP_COMB
#define REP_COMB 1
#endif
#ifndef REP_OUT0
#define REP_OUT0 1
#endif
#ifndef REP_UP
#define REP_UP 1
#endif
#define REPEAT(n) for (int rep_ = 0; rep_ < opq_s(n); ++rep_)
__global__ void __launch_bounds__(NWAVES * 64, 2) mk_fwd(Args args) {
    extern __shared__ __attribute__((aligned(16))) unsigned char lds[];
    for (int u = threadIdx.x; u < (LDS_BYTES - LDSCTL_OFF) / 4; u += NWAVES * 64) ((LAS unsigned*)((LAS unsigned char*)lds + LDSCTL_OFF))[u] = 0u;
    __syncthreads();
    if (threadIdx.x < 20) { const unsigned long long v = threadIdx.x < 18 ? (unsigned long long)args.in[threadIdx.x < 18 ? threadIdx.x : 0] : (threadIdx.x == 18 ? (unsigned long long)args.out : (unsigned long long)args.ws);
        PTAB[2 * threadIdx.x] = (unsigned)v; PTAB[2 * threadIdx.x + 1] = (unsigned)(v >> 32); }
    LDS_WAIT(); __syncthreads();
    (void)xcd_barrier_post(WS_PTR(unsigned, WS_CTL) + CW_BAR, (volatile LAS unsigned*)((LAS unsigned char*)lds + MISC_OFF) + 8);

#ifndef SKIP_P0
    REPEAT(REP_P0) {
        MK_FRAME();
        unsigned char* ws = WS_BASE();
        const int gw = F.vcu * NWAVES + F.wave, NGW = F.G * NWAVES;
        LAS float* scr = (LAS float*)(F.lds + RING_OFF + F.wave * 16384);
        constexpr int I_IN = (D / 64) * (NQKV / 32), I_OUT = (D / 64) * (D / 32), I_G = (D / 64) * (FF / 32), I_D = (FF / 64) * (D / 32);
        constexpr int I_LAYER = I_IN + I_OUT + 2 * I_G + I_D, NITEMS = 2 * I_LAYER;
        for (int it = gw; it < NITEMS; it += NGW) {
            const int L = it / I_LAYER; int r = it % I_LAYER;
            unsigned char* wl = ws + WS_W + (size_t)L * W_LAYER;
            const float* ffn_g = IN_PTR(const float, 13) + (size_t)L * D;
            if (r < I_IN) { p0_transpose_item(IN_PTR(const float, L ? 6 : 3), IN_PTR(const float, L ? 5 : 2), D, NQKV, (bf16*)(wl + W_IN), 0, scr, r, F.lane); continue; } r -= I_IN;
            if (r < I_OUT) { p0_transpose_item(IN_PTR(const float, L ? 7 : 4), nullptr, D, D, (bf16*)(wl + W_OUT), 0, scr, r, F.lane); continue; } r -= I_OUT;
            if (r < I_G) { p0_transpose_item(IN_PTR(const float, 14) + (size_t)L * D * FF, ffn_g, D, FF, (bf16*)(wl + W_GU), 1, scr, r, F.lane); continue; } r -= I_G;
            if (r < I_G) { p0_transpose_item(IN_PTR(const float, 15) + (size_t)L * D * FF, ffn_g, D, FF, (bf16*)(wl + W_GU), 2, scr, r, F.lane); continue; } r -= I_G;
            p0_transpose_item(IN_PTR(const float, 16) + (size_t)L * FF * D, nullptr, FF, D, (bf16*)(wl + W_DN), 0, scr, r, F.lane);
        }
        const float* x = IN_PTR(const float, 0);
        bf16* HB = (bf16*)(ws + WS_HB); float* ssp = (float*)(ws + WS_SSP);
        for (int m0 = gw; m0 < M; m0 += 2 * NGW) {
            f32x4 v[2][4];
#pragma unroll
            for (int q = 0; q < 2; ++q) { const int mq = (m0 + q * NGW < M) ? m0 + q * NGW : m0; const GAS f32x4* xr = (const GAS f32x4*)(x + (size_t)mq * D) + F.lane;
#pragma unroll
                for (int j = 0; j < 4; ++j) v[q][j] = MEM_NT ? __builtin_nontemporal_load(xr + 64 * j) : xr[64 * j]; }
#pragma unroll
            for (int q = 0; q < 2; ++q) { const int m = (m0 + q * NGW < M) ? m0 + q * NGW : m0; float s = 0.f;
#pragma unroll
                for (int j = 0; j < 4; ++j) s += (v[q][j].x * v[q][j].x + v[q][j].y * v[q][j].y) + (v[q][j].z * v[q][j].z + v[q][j].w * v[q][j].w);
                s = wave_sum(s);
                GAS unsigned long long* o8 = (GAS unsigned long long*)(HB + (size_t)m * D) + F.lane;
#pragma unroll
                for (int j = 0; j < 4; ++j) { const unsigned long long pv = (unsigned long long)pk2(v[q][j].x, v[q][j].y) | ((unsigned long long)pk2(v[q][j].z, v[q][j].w) << 32); if (P0_ST == 2) ST8_SC1(o8 + 64 * j, pv); else if (P0_ST == 1) __builtin_nontemporal_store(pv, o8 + 64 * j); else o8[64 * j] = pv; }
                if (F.lane == 0) ssp[m] = s; }
        }
        const int* pos = IN_PTR(const int, 1); float* rope = (float*)(ws + WS_ROPE);
        for (int idx = gw * 64 + F.lane; idx < M * 8; idx += NGW * 64) {
            const int row = idx >> 3, i = idx & 7;
            const float invf = i == 0 ? 1.0f : i == 1 ? 0.1939227432012558f : i == 2 ? 0.03760603070259094f : i == 3 ? 0.007292664609849453f :
                               i == 4 ? 0.0014142135623842478f : i == 5 ? 0.00027424818836152554f : i == 6 ? 5.3182957344688475e-05f : 1.0313385246263351e-05f;
            const float ang = (float)pos[row] * invf;
            float sn, cs; sincosf(ang, &sn, &cs);
            rope[(size_t)row * 16 + i] = cs; rope[(size_t)row * 16 + 8 + i] = sn;
        }
    }
#endif
    GRID_BAR();
#if GRP
#ifndef STAGGER_SLEEPS
#define STAGGER_SLEEPS 4
#endif
    for (int i_ = 0; i_ < ((opq_s(blockIdx.x) >> 3) >> 4) * STAGGER_SLEEPS; ++i_) __builtin_amdgcn_s_sleep(127);
#endif

#pragma unroll 1
    for (int L = 0; L < 2; ++L) {
#ifndef SKIP_QKV
        REPEAT(REP_QKV) {
            MK_FRAME();
            unsigned char* ws = WS_BASE();
            pg8::Gemm g{(const bf16*)(ws + WS_HB), (const bf16*)(ws + WS_W + (size_t)L * W_LAYER + W_IN), M, NQKV, D}; pg8::QkvOrder S; S.init(M, NQKV, F.G, F.bx);
            prep_rtab(F, S, (const float*)(ws + WS_SSP), L == 0 ? 1 : 16);
            pg8::EpiQKV E{PTAB, (const LAS float*)(F.lds + RTAB_OFF), L == 0 ? 0x3CFu : 0xFFu, L == 0 ? 0xC3u : 0x0Fu, L == 0 ? 0x300u : 0u, attn_body::C2};
            pg8::gemm_phase<pg8::EpiQKV, pg8::QkvOrder, PG8_ALIGN, PG8_SP2>(F.lds + RING_OFF, g, S, E);
        }
#endif
        PHASE_BAR();
        if (L == 0) {
#ifndef SKIP_ATTN0
            const int G = opq_s(gridDim.x);
            {
                LAS float* lut = (LAS float*)((LAS unsigned char*)lds + RING_OFF + attn_body::DIL_LUT_OFF);
#pragma clang loop vectorize(disable) unroll(disable)
                for (int i = opq_v(threadIdx.x); i < attn_body::DIL_LUT_N; i += NWAVES * 64) ((volatile LAS float*)lut)[i] = attn_body::dil_bias(opq_v(i) - 256);
                LDS_WAIT(); __syncthreads();
            }
            REPEAT(REP_ATTN0) for (int it = vcu_of(opq_s(blockIdx.x), G); it < 256; it += G) {
                const int p = it >> 1, par = it & 1, b = p >> 3, hh = p & 7;
                int ring = 0, first = 1;
                attn_body::bf16x8 qp0 = {}, qp1 = {}, qp2 = {}, qp3 = {};
#pragma unroll 1
                for (int k = 0; k < 4; ++k) {
                    const int qb = par == 0 ? (k == 0 ? 7 : k == 1 ? 4 : k == 2 ? 3 : 0) : (k == 0 ? 6 : k == 1 ? 5 : k == 2 ? 2 : 1);
                    const int k1 = k < 3 ? k + 1 : 3, qb1 = par == 0 ? (k1 == 0 ? 7 : k1 == 1 ? 4 : k1 == 2 ? 3 : 0) : (k1 == 0 ? 6 : k1 == 1 ? 5 : k1 == 2 ? 2 : 1);
                    {
                        const attn_body::bf16* qkvb = WS_PTR(const attn_body::bf16, WS_QKV) + (size_t)b * T * NQKV + 64 * hh;
                        attn_body::bf16* ob = WS_PTR(attn_body::bf16, WS_OB) + (size_t)b * T * D + 64 * hh;
                        attn_body::attn_unit<ATT_A_MODE, ATT_THRL>(qb, qkvb, 0, 512, 1024, ob, D, nullptr, (char*)lds + RING_OFF, 0, 2048, 2560, first, ring, 1536, qb, qp0, qp1, qp2, qp3);
                        first = 0;
                    }
                    {
                        const attn_body::bf16* qkvb = WS_PTR(const attn_body::bf16, WS_QKV) + (size_t)b * T * NQKV + 64 * hh;
                        attn_body::bf16* ob = WS_PTR(attn_body::bf16, WS_OB) + (size_t)b * T * D + 64 * hh;
                        const float* km0 = WS_PTR(const float, WS_KMP) + (size_t)(b * 8) * 512 + 64 * hh;
                        attn_body::attn_unit<ATT_B_MODE, ATT_THRL>(qb, qkvb, 1536, 2048, 2560, ob + 512, D, km0, (char*)lds + RING_OFF, 0, 512, 1024, 0, ring, 0, qb1, qp0, qp1, qp2, qp3);
                    }
                }
                VM_WAIT(); __syncthreads();
            }
#ifdef XABL
            for (int it = vcu_of(opq_s(blockIdx.x), G); it < 256; it += G) {
                const int p = it >> 1, b = p >> 3, hh = p & 7;
                int ring = 0; attn_body::bf16x8 qp0 = {}, qp1 = {}, qp2 = {}, qp3 = {};
#pragma unroll 1
                for (int k = 0; k < 8; ++k) {
                    const attn_body::bf16* qkvb = WS_PTR(const attn_body::bf16, WS_QKV) + (size_t)b * T * NQKV + 64 * hh;
                    attn_body::bf16* osb = WS_PTR(attn_body::bf16, WS_OS) + (size_t)b * T * 2048 + 64 * hh;
                    attn_body::attn_unit<0, 8, XABL>(7, qkvb, 0, 512, 1024, osb, 2048, nullptr, (char*)lds + RING_OFF, 0, 512, 1024, k == 0 ? 1 : 0, ring, 0, 7, qp0, qp1, qp2, qp3);
                }
                VM_WAIT(); __syncthreads();
            }
#endif
#endif
        } else {
#ifndef SKIP_ATTN1
            const int G = opq_s(gridDim.x);
            {
                LAS float* dc = (LAS float*)((LAS unsigned char*)lds + RING_OFF + attn_body::X_DC);
                const int tid = opq_v(threadIdx.x);
                if (tid < 128) dc[tid] = IN_PTR(const float, 12)[tid] * (1.0f - LAMBDA_INIT);
                if (tid < 64) {
                    const float s1 = wave_sum(IN_PTR(const float, 8)[tid] * IN_PTR(const float, 9)[tid]), s2 = wave_sum(IN_PTR(const float, 10)[tid] * IN_PTR(const float, 11)[tid]);
                    if (tid == 0) dc[128] = expf(s1) - expf(s2) + LAMBDA_INIT;
                }
                LDS_WAIT(); __syncthreads();
            }
            REPEAT(REP_ATTN1) for (int it = vcu_of(opq_s(blockIdx.x), G); it < 256; it += G) {
                const int p = it >> 1, par = it & 1, b = p >> 3, h = p & 7;
                int ring = 0; attn_body::bf16x8 qp0 = {}, qp1 = {}, qp2 = {}, qp3 = {};
#pragma unroll 1
                for (int k = 0; k < 8; ++k) {
                    const int kq = k >> 1, i = k & 1, in_ = (k + 1) & 1;
                    const int qb = par == 0 ? (kq == 0 ? 7 : kq == 1 ? 4 : kq == 2 ? 3 : 0) : (kq == 0 ? 6 : kq == 1 ? 5 : kq == 2 ? 2 : 1);
                    const int kqn = (k < 7 ? k + 1 : 7) >> 1, qbn = par == 0 ? (kqn == 0 ? 7 : kqn == 1 ? 4 : kqn == 2 ? 3 : 0) : (kqn == 0 ? 6 : kqn == 1 ? 5 : kqn == 2 ? 2 : 1);
                    const attn_body::bf16* qkvb = WS_PTR(const attn_body::bf16, WS_QKV) + (size_t)b * T * NQKV;
                    attn_body::bf16* ob = WS_PTR(attn_body::bf16, WS_OB) + (size_t)b * T * D + 128 * h;
                    attn_body::attn_unit_dv128<ATT_THRL>(qb, qkvb, 64 * (2 * h + i), 1024 + 64 * (2 * h + i), 2048 + 128 * h, ob, D, (char*)lds + RING_OFF, i == 0 ? 1 : 3,
                                                  1024 + 64 * (2 * h + in_), k == 0 ? 1 : 0, ring, 64 * (2 * h + in_), qbn, qp0, qp1, qp2, qp3);
                }
                VM_WAIT(); __syncthreads();
            }
#endif
        }
        PHASE_BAR();
#ifndef SKIP_OUT
        {
            MK_FRAME();
            unsigned char* ws = WS_BASE();
            pg8::Gemm g{(const bf16*)(ws + WS_OB), (const bf16*)(ws + WS_W + (size_t)L * W_LAYER + W_OUT), M, D, D}; pg8::PhaseOrder S; S.init(M, D, F.G, F.bx);
            pg8::EpiResid E{PTAB};
            pg8::gemm_phase<pg8::EpiResid, pg8::PhaseOrder, PG8_ALIGN, PG8_SP2>(F.lds + RING_OFF, g, S, E);
        }
#endif
#ifndef XEPI
#define XEPI 1
#endif
#ifdef XOUT
        for (int xr = 0; xr < opq_s(XOUT); ++xr) {
            GRID_BAR();
            MK_FRAME();
            unsigned char* ws = WS_BASE();
            pg8::Gemm g{(const bf16*)(ws + WS_OB), (const bf16*)(ws + WS_W + (size_t)L * W_LAYER + W_OUT), M, D, D}; pg8::StaticOrder S; S.init(M, D, F.G, F.bx);
            pg8::EpiResidT<XEPI> E{PTAB};
            pg8::gemm_phase<pg8::EpiResidT<XEPI>, pg8::StaticOrder, PG8_ALIGN, PG8_SP2>(F.lds + RING_OFF, g, S, E);
        }
#endif
#ifndef XCLK_SRC
#define XCLK_SRC WS_HB
#endif
#ifdef XCLK
        {
            MK_FRAME();
            unsigned char* ws = WS_BASE();
            attn_body::bf16x8 xa = *(const GAS attn_body::bf16x8*)(ws + XCLK_SRC + (size_t)F.tid * 16), xb = *(const GAS attn_body::bf16x8*)(ws + XCLK_SRC + 65536 + (size_t)F.tid * 16);
            attn_body::f32x16 c0 = {}, c1 = {}, c2 = {}, c3 = {};
            for (int i = 0; i < opq_s(XCLK); ++i) {
                c0 = __builtin_amdgcn_mfma_f32_32x32x16_bf16(xa, xb, c0, 0, 0, 0); c1 = __builtin_amdgcn_mfma_f32_32x32x16_bf16(xb, xa, c1, 0, 0, 0);
                c2 = __builtin_amdgcn_mfma_f32_32x32x16_bf16(xa, xa, c2, 0, 0, 0); c3 = __builtin_amdgcn_mfma_f32_32x32x16_bf16(xb, xb, c3, 0, 0, 0);
            }
            asm volatile("" :: "v"(c0), "v"(c1), "v"(c2), "v"(c3));
        }
#endif
#ifdef XDOWN
        for (int xr = 0; xr < opq_s(XDOWN); ++xr) {
            GRID_BAR();
            MK_FRAME();
            unsigned char* ws = WS_BASE();
            pg8::Gemm g{(const bf16*)(ws + WS_QKV), (const bf16*)(ws + WS_W + (size_t)L * W_LAYER + W_DN), M, D, FF}; pg8::StaticOrder S; S.init(M, D, F.G, F.bx);
            pg8::EpiResidT<XEPI> E{PTAB};
            pg8::gemm_phase<pg8::EpiResidT<XEPI>, pg8::StaticOrder, PG8_ALIGN, PG8_SP2>(F.lds + RING_OFF, g, S, E);
        }
#endif
        PHASE_BAR();
#ifndef SKIP_UP
        REPEAT(REP_UP) {
            MK_FRAME();
            unsigned char* ws = WS_BASE();
            pg8::Gemm g{(const bf16*)(ws + WS_HB), (const bf16*)(ws + WS_W + (size_t)L * W_LAYER + W_GU), M, 2 * FF, D}; pg8::PhaseOrder S; S.init(M, 2 * FF, F.G, F.bx);
            prep_rtab(F, S, (const float*)(ws + WS_SSP), 16);
            pg8::EpiSwiGLU E{PTAB, (const LAS float*)(F.lds + RTAB_OFF)};
            pg8::gemm_phase<pg8::EpiSwiGLU, pg8::PhaseOrder, PG8_ALIGN, PG8_SP2>(F.lds + RING_OFF, g, S, E);
        }
#endif
        PHASE_BAR();
#ifndef SKIP_DOWN
        {
            MK_FRAME();
            unsigned char* ws = WS_BASE();
            pg8::Gemm g{(const bf16*)(ws + WS_QKV + (GRP ? (size_t)GROUP_ID() * MiB : (size_t)0)), (const bf16*)(ws + WS_W + (size_t)L * W_LAYER + W_DN), M, D, FF}; pg8::PhaseOrder S; S.init(M, D, F.G, F.bx);
            pg8::EpiResid E{PTAB};
            pg8::gemm_phase<pg8::EpiResid, pg8::PhaseOrder, PG8_ALIGN, PG8_SP2>(F.lds + RING_OFF, g, S, E);
        }
#endif
        PHASE_BAR();
    }
#ifndef SKIP_FINAL
    {
        MK_FRAME();
        unsigned char* ws = WS_BASE();
#if GRP
        const int gw = ((F.bx >> 3) & 15) * NWAVES + F.wave, NGW = 16 * NWAVES, row0 = GROUP_ID() * T, nrow = T;
#else
        const int gw = F.vcu * NWAVES + F.wave, NGW = F.G * NWAVES, row0 = 0, nrow = M;
#endif
        float* out = OUT_PTR();
        const bf16* HB = (const bf16*)(ws + WS_HB); const float* ssp = (const float*)(ws + WS_SSP);
        const float* gf = IN_PTR(const float, 17);
        f32x4 gv[2][2];
#pragma unroll
        for (int j = 0; j < 2; ++j) { gv[j][0] = *(const GAS f32x4*)(gf + 512 * j + 8 * F.lane); gv[j][1] = *(const GAS f32x4*)(gf + 512 * j + 8 * F.lane + 4); }
        for (int mm = gw; mm < nrow; mm += NGW) {
            const int m = row0 + mm; float s = 0.f;
#pragma unroll
            for (int j = 0; j < 16; ++j) s += ssp[(size_t)j * M + m];
            const float rs = 1.0f / sqrtf(s * (1.0f / D) + NORM_EPS);
#pragma unroll
            for (int j = 0; j < 2; ++j) {
                const v4u w = MEM_NT ? __builtin_nontemporal_load((const GAS v4u*)(HB + (size_t)m * D + 512 * j + 8 * F.lane)) : *(const GAS v4u*)(HB + (size_t)m * D + 512 * j + 8 * F.lane);
                const f32x4 a = (f32x4){bf_lo(w.x), bf_hi(w.x), bf_lo(w.y), bf_hi(w.y)}, b = (f32x4){bf_lo(w.z), bf_hi(w.z), bf_lo(w.w), bf_hi(w.w)};
                GAS f32x4* po = (GAS f32x4*)(out + (size_t)m * D + 512 * j + 8 * F.lane);
                if (FIN_ST == 2) { const f32x4 o0 = a * rs * gv[j][0], o1 = b * rs * gv[j][1]; ST16_SC1(po, o0); ST16_SC1(po + 1, o1); } else if (FIN_ST) { __builtin_nontemporal_store(a * rs * gv[j][0], po); __builtin_nontemporal_store(b * rs * gv[j][1], po + 1); } else { po[0] = a * rs * gv[j][0]; po[1] = b * rs * gv[j][1]; }
            }
        }
    }
#endif
}

extern "C" void kernel_launch(void* const* d_in, const int* in_sizes, int n_in, void* d_out, int out_size, void* d_ws, size_t ws_size, hipStream_t stream) {
    static int grid = 0;
    if (grid == 0) {
        if (n_in != 18 || in_sizes[0] != M * D || out_size != M * D || ws_size < WS_END) { fprintf(stderr, "kernel_launch: unexpected problem shape / workspace (n_in %d, in0 %d, out %d, ws %zu)\n", n_in, n_in > 0 ? in_sizes[0] : -1, out_size, ws_size); grid = -1; return; }
        int dev = 0, cus = 0, per_cu = 0;
        if (hipGetDevice(&dev) != hipSuccess || hipDeviceGetAttribute(&cus, hipDeviceAttributeMultiprocessorCount, dev) != hipSuccess) { grid = -1; return; }
        if (hipFuncSetAttribute((const void*)mk_fwd, hipFuncAttributeMaxDynamicSharedMemorySize, LDS_BYTES) != hipSuccess) { fprintf(stderr, "kernel_launch: hipFuncSetAttribute failed\n"); grid = -1; return; }
        if (hipOccupancyMaxActiveBlocksPerMultiprocessor(&per_cu, (const void*)mk_fwd, NWAVES * 64, LDS_BYTES) != hipSuccess || per_cu < 1) { fprintf(stderr, "kernel_launch: occupancy query says %d blocks per CU\n", per_cu); per_cu = 1; }
        (void)hipGetLastError();
        if (GRP && cus != 256) { fprintf(stderr, "kernel_launch: the batch-group schedule needs 256 CUs (have %d)\n", cus); grid = -1; return; }
        grid = cus;
    }
    if (grid < 0) return;
    if (hipMemsetAsync((char*)d_ws + WS_CTL, 0, CTL_ZERO_BYTES, stream) != hipSuccess) { fprintf(stderr, "kernel_launch: hipMemsetAsync failed\n"); return; }
    Args a{};
    for (int i = 0; i < 18; ++i) a.in[i] = d_in[i];
    a.out = (float*)d_out; a.ws = (unsigned char*)d_ws;
    hipLaunchKernelGGL(mk_fwd, dim3(grid), dim3(NWAVES * 64), LDS_BYTES, stream, a);
}
```

```cpp
#include <hip/hip_runtime.h>
#include <hip/hip_bf16.h>
#include <cstdio>
#include <cstdint>
#include <cmath>
namespace pg8 {
#define PG8_LAS __attribute__((address_space(3)))
typedef unsigned short bf16_t;
typedef short bf16x8 __attribute__((ext_vector_type(8)));
typedef float f32x4 __attribute__((ext_vector_type(4)));
typedef unsigned u32x4 __attribute__((ext_vector_type(4)));
typedef unsigned u32x2 __attribute__((ext_vector_type(2)));
#ifndef PG8_WGM
#define PG8_WGM 8
#endif
constexpr int BM = 256, BK = 64, HALF = 128, HTB = HALF * BK * 2  , STAGE_BYTES = 8 * HTB, NXCD = 8, WGM = PG8_WGM;

__host__ __device__ __forceinline__ int lds_byte(int r, int c) { const int st = (r >> 4) * 2 + (c >> 5), rr = r & 15, cc = c & 31, ob = rr * 64 + cc * 2; return st * 1024 + (ob ^ (((ob >> 9) & 1) << 5)); }
__host__ __device__ __forceinline__ void stage_rc(int b, int& R, int& C) { const int st = b / 1024, sb = b % 1024, swz = sb ^ (((sb >> 9) & 1) << 5); R = (st >> 1) * 16 + swz / 64; C = (st & 1) * 32 + (swz % 64) / 2; }
__host__ __device__ __forceinline__ int perm32(int rho) { const int n = rho >> 4, i = rho & 15; return 8 * (i >> 2) + 4 * n + (i & 3); }

struct Unit { int pm, pn, idx; };
struct Gemm { const bf16_t* A; const bf16_t* Bt; int M, N, K; };

struct StaticOrder {
    int nM, nN, nwg, G, c;
    __host__ __device__ void init(int M, int N, int G_, int c_) { nM = M / BM; nN = N / BM; nwg = nM * nN; G = G_; c = c_; }
    __host__ __device__ bool next(int i, Unit& u) const {
        const long L = (long)i * G + c; if (L >= nwg) return false;
        int wgid = (int)L; { const int q = nwg / NXCD, r = nwg % NXCD, xcd = wgid % NXCD, off = wgid / NXCD; wgid = (xcd < r ? xcd * (q + 1) : r * (q + 1) + (xcd - r) * q) + off; }
        const int nig = WGM * nN, gid = wgid / nig, fm = gid * WGM, gsz = (nM - fm) < WGM ? (nM - fm) : WGM;
        u.pm = fm + ((wgid % nig) % gsz); u.pn = (wgid % nig) / gsz; u.idx = i; return true;
    }
    __device__ __forceinline__ void a_ready(const Unit&) const {}
    __device__ __forceinline__ void done(const Unit&) const {}
};

__device__ __forceinline__ unsigned cvt_pk_bf16(float lo, float hi) { unsigned r; asm volatile("v_cvt_pk_bf16_f32 %0, %1, %2" : "=v"(r) : "v"(lo), "v"(hi)); return r; }

constexpr int TOK = 32768;
__device__ __forceinline__ unsigned char* tab_ptr(volatile PG8_LAS unsigned* t, int k) {
    { unsigned a_ = (unsigned)(uintptr_t)t; asm volatile("" : "+v"(a_)); t = (volatile PG8_LAS unsigned*)a_; }
    const unsigned lo = (unsigned)__builtin_amdgcn_readfirstlane((int)t[2 * k]), hi = (unsigned)__builtin_amdgcn_readfirstlane((int)t[2 * k + 1]);
    unsigned long long v = (unsigned long long)lo | ((unsigned long long)hi << 32); asm volatile("" : "+s"(v)); return (unsigned char*)(__attribute__((address_space(1))) unsigned char*)v; }
constexpr size_t XWS_ROPE = (size_t)1 << 20, XWS_SSP = (size_t)3 << 20, XWS_KMP = (size_t)5 << 20, XWS_HB = (size_t)56 << 20, XWS_QKV = (size_t)184 << 20;

#ifndef EPI_NT
#define EPI_NT 2
#endif

#ifndef MEM_NT
#define MEM_NT 1
#endif
#define ST16_SC1(p, v) asm volatile("global_store_dwordx4 %0, %1, off sc1\n\ts_nop 1" :: "v"(p), "v"(v) : "memory")
#define ST8_SC1(p, v) asm volatile("global_store_dwordx2 %0, %1, off sc1\n\ts_nop 1" :: "v"(p), "v"(v) : "memory")
#ifndef PG8_AUX_A
#define PG8_AUX_A 0
#endif
#ifndef PG8_AUX_B
#define PG8_AUX_B 0
#endif
#ifndef PG8_MMA_ORDER
#define PG8_MMA_ORDER 4
#endif
#ifndef PG8_MMA_PAIR
#define PG8_MMA_PAIR 0
#endif
#ifndef PG8_NOPRIO
#define PG8_NOPRIO 0
#endif
#ifndef EPI_ZERO
#define EPI_ZERO 0
#endif
#ifndef PG8_ZERO64
#define PG8_ZERO64 1
#endif
#ifndef PG8_WC_ROT
#define PG8_WC_ROT 0
#endif
#ifndef PG8_RELAX
#define PG8_RELAX 0
#endif
#ifndef RES_PF
#define RES_PF 1
#endif
#ifndef RES_LD
#define RES_LD 0
#endif
#ifndef EPI_QKV
#define EPI_QKV EPI_NT
#endif
#ifndef EPI_UP
#define EPI_UP 1
#endif
#ifndef EPI_RES
#define EPI_RES EPI_NT
#endif
template <int MODE> __device__ __forceinline__ void epi_st(void* p, const u32x4& v) {
    if constexpr (MODE == 2) asm volatile("global_store_dwordx4 %0, %1, off sc1\n\ts_nop 1" :: "v"((u32x4*)p), "v"(v) : "memory");
    else if constexpr (MODE == 3) asm volatile("global_store_dwordx4 %0, %1, off sc1 nt\n\ts_nop 1" :: "v"((u32x4*)p), "v"(v) : "memory");
    else if constexpr (MODE == 4) asm volatile("global_store_dwordx4 %0, %1, off sc0 sc1\n\ts_nop 1" :: "v"((u32x4*)p), "v"(v) : "memory");
    else if constexpr (MODE == 1) __builtin_nontemporal_store(v, (u32x4*)p);
    else *(u32x4*)p = v;
}
struct EpiQKV {
    static constexpr bool PERM = true, AFTER_DRAIN = false, PREFETCH = false; static constexpr int NSTORE = 16;
    volatile PG8_LAS unsigned* pt; const PG8_LAS float* rt; unsigned ropemask, qmask, kmmask; float qscale;
    __device__ __forceinline__ void operator()(f32x4 (&acc)[2][2][4][2], const Unit& u, int wr, int wc, int fr, int fq) const {
        unsigned char* ws = tab_ptr(pt, 19); bf16_t* O = (bf16_t*)(ws + XWS_QKV); const float* rope = (const float*)(ws + XWS_ROPE); float* kmp = (float*)(ws + XWS_KMP);
        const bool do_rope = (((ropemask >> u.pn) & 1u) != 0u) && ((wc & 1) == 0);
        const bool do_km = ((kmmask >> u.pn) & 1u) != 0u;
        const float sc = ((qmask >> u.pn) & 1u) ? qscale : 1.f;
        const int col0 = u.pn * BM + wc * 32 + 8 * fq;
        const float sgn = (fq == 0) ? -1.f : 1.f;
        f32x4 cs[2][2];
#pragma unroll
        for (int bj = 0; bj < 2; ++bj)
#pragma unroll
            for (int n = 0; n < 2; ++n) cs[bj][n] = (f32x4){0.f, 0.f, 0.f, 0.f};
#pragma unroll
        for (int ai = 0; ai < 2; ++ai) {
            f32x4 cc[4][2], sn[4][2];
            if (do_rope) {
#pragma unroll
                for (int m = 0; m < 4; ++m) { const f32x4* rp = (const f32x4*)(rope + (size_t)(u.pm * BM + ai * HALF + wr * 64 + m * 16 + fr) * 16);
                    cc[m][0] = rp[0]; cc[m][1] = rp[1]; sn[m][0] = rp[2]; sn[m][1] = rp[3]; }
            }
#pragma unroll
            for (int m = 0; m < 4; ++m) {
                const int rl = ai * HALF + wr * 64 + m * 16 + fr; const int row = u.pm * BM + rl;
                const float r = rt[u.idx * BM + rl];
                f32x4 v[2][2];
#pragma unroll
                for (int bj = 0; bj < 2; ++bj)
#pragma unroll
                    for (int n = 0; n < 2; ++n) { v[bj][n] = acc[ai][bj][m][n] * r; if (EPI_ZERO) { float z_ = 0.f; asm volatile("" : "+v"(z_)); acc[ai][bj][m][n] = (f32x4){z_, z_, z_, z_}; } }
                if (do_rope) {
#pragma unroll
                    for (int bj = 0; bj < 2; ++bj)
#pragma unroll
                        for (int n = 0; n < 2; ++n)
#pragma unroll
                            for (int e = 0; e < 4; ++e) {
                                const float p = __shfl_xor(v[bj][n][e], 16);
                                const float rot = v[bj][n][e] * cc[m][n][e] + sgn * p * sn[m][n][e];
                                if (fq < 2) v[bj][n][e] = rot;
                            }
                }
                if (do_km) {
#pragma unroll
                    for (int bj = 0; bj < 2; ++bj)
#pragma unroll
                        for (int n = 0; n < 2; ++n) cs[bj][n] += v[bj][n];
                }
                bf16_t* rowp = O + (size_t)row * 3072 + col0;
#pragma unroll
                for (int bj = 0; bj < 2; ++bj) { const f32x4 v0 = v[bj][0] * sc, v1 = v[bj][1] * sc;
                    u32x4 w; w.x = cvt_pk_bf16(v0[0], v0[1]); w.y = cvt_pk_bf16(v0[2], v0[3]); w.z = cvt_pk_bf16(v1[0], v1[1]); w.w = cvt_pk_bf16(v1[2], v1[3]);
                    epi_st<EPI_QKV>(rowp + bj * HALF, w); }
            }
        }
        if (do_km) {
#pragma unroll
            for (int bj = 0; bj < 2; ++bj)
#pragma unroll
                for (int n = 0; n < 2; ++n)
#pragma unroll
                    for (int e = 0; e < 4; ++e) { float s = cs[bj][n][e]; s += __shfl_xor(s, 1); s += __shfl_xor(s, 2); s += __shfl_xor(s, 4); s += __shfl_xor(s, 8); cs[bj][n][e] = s; }
            if (fr == 0) {
                float* kp = kmp + ((size_t)wr * 128 + u.pm) * 512 + (u.pn - 8) * BM + wc * 32 + 8 * fq;
#pragma unroll
                for (int bj = 0; bj < 2; ++bj)
#pragma unroll
                    for (int n = 0; n < 2; ++n) *(f32x4*)(kp + bj * HALF + 4 * n) = cs[bj][n];
            }
        }
    }
};

template <int SCR>
struct EpiResidT {
    static constexpr bool PERM = true, AFTER_DRAIN = false, PREFETCH = (RES_PF != 0); static constexpr int NSTORE = 16;
    volatile PG8_LAS unsigned* pt;
    __device__ __forceinline__ void prefetch(const Unit& u, int tid, int r, PG8_LAS unsigned char* junk) const {
        const unsigned char* ws = tab_ptr(pt, 19); const int li = r * 512 + tid, row = li >> 2, seg = li & 3;
        const unsigned char* p = ws + (SCR ? ((size_t)376 << 20) : XWS_HB) + ((size_t)(u.pm * BM + row) * 1024 + u.pn * BM + seg * 64) * 2;
        __builtin_amdgcn_global_load_lds((const unsigned*)p, (PG8_LAS unsigned*)junk, 4, 0, 0);
    }
    __device__ __forceinline__ void operator()(f32x4 (&acc)[2][2][4][2], const Unit& u, int wr, int wc, int fr, int fq) const {
        unsigned char* ws = tab_ptr(pt, 19);
        bf16_t* hb = (bf16_t*)(ws + (SCR ? ((size_t)376 << 20) : XWS_HB)); float* ssp = (float*)(ws + (SCR ? ((size_t)440 << 20) : XWS_SSP));
        const int ln_ = fr + 16 * fq, frx = (SCR == 5) ? (ln_ >> 3) : fr, bjs = (SCR == 5) ? 8 * 1024 : HALF;
        const int col0 = (SCR == 5) ? u.pn * BM + wc * 64 + 8 * (ln_ & 7) : u.pn * BM + wc * 32 + 8 * fq;
        u32x4 bw[2][4][2];
#pragma unroll
        for (int ai = 0; ai < 2; ++ai)
#pragma unroll
            for (int m = 0; m < 4; ++m) {
                const size_t off = (size_t)(u.pm * BM + ai * HALF + wr * 64 + m * 16 + frx) * 1024 + col0;
#pragma unroll
                for (int bj = 0; bj < 2; ++bj) { if constexpr (SCR == 2 || SCR == 4) bw[ai][m][bj] = (u32x4){0u, 0u, 0u, 0u}; else bw[ai][m][bj] = RES_LD ? __builtin_nontemporal_load((const u32x4*)(hb + off + bj * HALF)) : *(const u32x4*)(hb + off + bj * bjs); }
            }
#pragma unroll
        for (int ai = 0; ai < 2; ++ai)
#pragma unroll
            for (int m = 0; m < 4; ++m) {
                const int row = u.pm * BM + ai * HALF + wr * 64 + m * 16 + frx; const size_t off = (size_t)row * 1024 + col0; float ss = 0.f;
#pragma unroll
                for (int bj = 0; bj < 2; ++bj) {
                    const u32x4 w0 = bw[ai][m][bj];
                    const f32x4 b0 = (f32x4){__uint_as_float(w0.x << 16), __uint_as_float(w0.x & 0xffff0000u), __uint_as_float(w0.y << 16), __uint_as_float(w0.y & 0xffff0000u)};
                    const f32x4 b1 = (f32x4){__uint_as_float(w0.z << 16), __uint_as_float(w0.z & 0xffff0000u), __uint_as_float(w0.w << 16), __uint_as_float(w0.w & 0xffff0000u)};
                    const f32x4 o0 = b0 + acc[ai][bj][m][0], o1 = b1 + acc[ai][bj][m][1]; if (EPI_ZERO) { float z_ = 0.f; asm volatile("" : "+v"(z_)); acc[ai][bj][m][0] = (f32x4){z_, z_, z_, z_}; acc[ai][bj][m][1] = (f32x4){z_, z_, z_, z_}; }
                    ss += ((o0[0] * o0[0] + o0[1] * o0[1]) + (o0[2] * o0[2] + o0[3] * o0[3])) + ((o1[0] * o1[0] + o1[1] * o1[1]) + (o1[2] * o1[2] + o1[3] * o1[3]));
                    u32x4 w; w.x = cvt_pk_bf16(o0[0], o0[1]); w.y = cvt_pk_bf16(o0[2], o0[3]); w.z = cvt_pk_bf16(o1[0], o1[1]); w.w = cvt_pk_bf16(o1[2], o1[3]);
                    if constexpr (SCR == 3 || SCR == 4) { ss += __uint_as_float(w.x ^ w.y ^ w.z ^ w.w) * 1e-30f; } else epi_st<EPI_RES>(hb + off + bj * bjs, w);
                }
                ss += __shfl_xor(ss, 16); ss += __shfl_xor(ss, 32);
                if (fq == 0) ssp[(size_t)(u.pn * 4 + wc) * TOK + row] = ss;
            }
    }
};
typedef EpiResidT<0> EpiResid;

struct EpiSwiGLU {
    static constexpr bool PERM = true, AFTER_DRAIN = false, PREFETCH = false; static constexpr int NSTORE = 8;
    volatile PG8_LAS unsigned* pt; const PG8_LAS float* rt;
    __device__ __forceinline__ void operator()(f32x4 (&acc)[2][2][4][2], const Unit& u, int wr, int wc, int fr, int fq) const {
        bf16_t* O = (bf16_t*)(tab_ptr(pt, 19) + XWS_QKV);
        const int col0 = u.pn * HALF + wc * 32 + 8 * fq;
#pragma unroll
        for (int ai = 0; ai < 2; ++ai)
#pragma unroll
            for (int m = 0; m < 4; ++m) {
                const int rl = ai * HALF + wr * 64 + m * 16 + fr; const int row = u.pm * BM + rl;
                const float r = rt[u.idx * BM + rl];
                float a[8];
                typedef float f32x2_e __attribute__((ext_vector_type(2)));
                const float r2 = r * r, ncr = -1.4426950408889634f * r;
#pragma unroll
                for (int n = 0; n < 2; ++n)
#pragma unroll
                    for (int e = 0; e < 4; e += 2) { const f32x2_e g2 = {acc[ai][0][m][n][e], acc[ai][0][m][n][e + 1]}, u2 = {acc[ai][1][m][n][e], acc[ai][1][m][n][e + 1]};
                        f32x2_e p = g2 * u2; p = p * r2; const f32x2_e x = g2 * ncr; if (EPI_ZERO) { float z_ = 0.f; asm volatile("" : "+v"(z_)); acc[ai][0][m][n][e] = z_; acc[ai][0][m][n][e + 1] = z_; acc[ai][1][m][n][e] = z_; acc[ai][1][m][n][e + 1] = z_; }
                        f32x2_e d = {__builtin_amdgcn_exp2f(x.x), __builtin_amdgcn_exp2f(x.y)}; d = d + 1.0f;
                        const f32x2_e rc = {__builtin_amdgcn_rcpf(d.x), __builtin_amdgcn_rcpf(d.y)}; p = p * rc; a[4 * n + e] = p.x; a[4 * n + e + 1] = p.y; }
                u32x4 w; w.x = cvt_pk_bf16(a[0], a[1]); w.y = cvt_pk_bf16(a[2], a[3]); w.z = cvt_pk_bf16(a[4], a[5]); w.w = cvt_pk_bf16(a[6], a[7]);
                epi_st<EPI_UP>(O + (size_t)row * 2816 + col0, w);
            }
    }
};

template <class Epi, class Sched, bool ALIGN_EPI = false, bool SP2 = false>
__device__ __forceinline__ void gemm_phase(PG8_LAS unsigned char* lds, const Gemm g, const Sched& S, const Epi& E) {
    int tid_ = threadIdx.x; asm volatile("" : "+v"(tid_));
    const int tid = tid_, wid = __builtin_amdgcn_readfirstlane(tid >> 6), lane = tid & 63, wr = wid >> 2, wc = PG8_WC_ROT ? ((wid + (wid >> 2)) & 3) : (wid & 3),     fr = lane & 15, fq = lane >> 4;
    const int K = g.K, nt = K / BK;
    unsigned voffA[2], voffB[2];
#pragma unroll
    for (int i = 0; i < 2; ++i) { int R, C; stage_rc(tid * 16 + i * 8192, R, C); const int Rb = Epi::PERM ? ((R & ~31) + perm32(R & 31)) : R;
        voffA[i] = (unsigned)(R * K + C) * 2u; voffB[i] = (unsigned)(Rb * K + C) * 2u; }
    const size_t kstep = (size_t)(BK * 2);
    const size_t hstep = (size_t)HALF * K * 2;
    const size_t tstep = 2 * hstep;
    const unsigned ldsw = (unsigned)wid * 1024u;
    const int aoff = lds_byte(wr * 64 + fr, fq * 8), boff = lds_byte(wc * 32 + fr, fq * 8);
#define PG8_SA(b, h) (((b) * 2 + (h)) * HTB)
#define PG8_SB(b, h) ((4 + (b) * 2 + (h)) * HTB)
#define PG8_STAGE(bufoff, gbase, voff) do { _Pragma("unroll") for (int _i = 0; _i < 2; ++_i) \
        __builtin_amdgcn_global_load_lds((const unsigned*)((const char*)(gbase) + (voff)[_i]), (PG8_LAS unsigned*)(lds + (bufoff) + ldsw + _i * 8192), 16, 0, ((bufoff) < 4 * HTB) ? PG8_AUX_A : PG8_AUX_B); } while (0)
#define PG8_LDA(dst, b, h) do { _Pragma("unroll") for (int m = 0; m < 4; ++m) _Pragma("unroll") for (int k = 0; k < 2; ++k) dst[m][k] = *(const PG8_LAS bf16x8*)(lds + PG8_SA(b, h) + aoff + m * 2048 + k * 1024); } while (0)
#define PG8_LDB(dst, b, h) do { _Pragma("unroll") for (int n = 0; n < 2; ++n) _Pragma("unroll") for (int k = 0; k < 2; ++k) dst[n][k] = *(const PG8_LAS bf16x8*)(lds + PG8_SB(b, h) + boff + n * 2048 + k * 1024); } while (0)
#if PG8_NOPRIO
#define PG8_PRIO(p) do {} while (0)
#else
#define PG8_PRIO(p) __builtin_amdgcn_s_setprio(p)
#endif
#if PG8_MMA_ORDER == 1
#define PG8_MMA_LOOPS _Pragma("unroll") for (int k = 0; k < 2; ++k) _Pragma("unroll") for (int m = 0; m < 4; ++m) _Pragma("unroll") for (int n = 0; n < 2; ++n)
#elif PG8_MMA_ORDER == 3
#define PG8_MMA_LOOPS _Pragma("unroll") for (int k = 0; k < 2; ++k) _Pragma("unroll") for (int n = 0; n < 2; ++n) _Pragma("unroll") for (int m = 0; m < 4; ++m)
#elif PG8_MMA_ORDER == 2
#define PG8_MMA_LOOPS _Pragma("unroll") for (int n = 0; n < 2; ++n) _Pragma("unroll") for (int m = 0; m < 4; ++m) _Pragma("unroll") for (int k = 0; k < 2; ++k)
#else
#define PG8_MMA_LOOPS _Pragma("unroll") for (int m = 0; m < 4; ++m) _Pragma("unroll") for (int n = 0; n < 2; ++n) _Pragma("unroll") for (int k = 0; k < 2; ++k)
#endif
#if PG8_MMA_ORDER == 4
#define PG8_MMA(ai, bj, At, Bt) do { PG8_PRIO(1); _Pragma("unroll") for (int k = 0; k < 2; ++k) _Pragma("unroll") for (int m = 0; m < 4; ++m) _Pragma("unroll") for (int nn = 0; nn < 2; ++nn) { const int n = (m & 1) ? 1 - nn : nn; \
        acc[ai][bj][m][n] = __builtin_amdgcn_mfma_f32_16x16x32_bf16(Bt[n][k], At[m][k], acc[ai][bj][m][n], 0, 0, 0); } PG8_PRIO(0); } while (0)
#else
#define PG8_MMA(ai, bj, At, Bt) do { PG8_PRIO(1); PG8_MMA_LOOPS \
        acc[ai][bj][m][n] = __builtin_amdgcn_mfma_f32_16x16x32_bf16(Bt[n][k], At[m][k], acc[ai][bj][m][n], 0, 0, 0); PG8_PRIO(0); } while (0)
#endif
#define PG8_MMA2(ai, At, Ba, Bb) do { __builtin_amdgcn_s_setprio(1); _Pragma("unroll") for (int k = 0; k < 2; ++k) _Pragma("unroll") for (int m = 0; m < 4; ++m) { _Pragma("unroll") for (int n = 0; n < 2; ++n) \
        acc[ai][0][m][n] = __builtin_amdgcn_mfma_f32_16x16x32_bf16(Ba[n][k], At[m][k], acc[ai][0][m][n], 0, 0, 0); _Pragma("unroll") for (int n = 0; n < 2; ++n) \
        acc[ai][1][m][n] = __builtin_amdgcn_mfma_f32_16x16x32_bf16(Bb[n][k], At[m][k], acc[ai][1][m][n], 0, 0, 0); } __builtin_amdgcn_s_setprio(0); } while (0)
#if PG8_MMA_PAIR
#define PG8_MMX(ai) PG8_MMA2(ai, At, B0, B1)
#else
#define PG8_MMX(ai) do { PG8_MMA(ai, 0, At, B0); PG8_MMA(ai, 1, At, B1); } while (0)
#endif
#define PG8_WAIT_V(n) asm volatile("s_waitcnt vmcnt(" #n ")" ::: "memory")
#define PG8_WAIT_VXN(n) asm volatile("s_cmp_lg_u32 %0, 0\n\ts_cbranch_scc0 .Lwv_n_%=\n\ts_waitcnt vmcnt(" #n ")\n\ts_branch .Lwv_d_%=\n.Lwv_n_%=:\n\ts_waitcnt vmcnt(8)\n.Lwv_d_%=:" :: "s"(relax) : "memory", "scc")
#if PG8_RELAX
#define PG8_WAIT_VX() do { if constexpr (Epi::NSTORE >= 16) PG8_WAIT_VXN(24); else if constexpr (Epi::NSTORE >= 8) PG8_WAIT_VXN(16); else PG8_WAIT_V(8); } while (0)
#else
#define PG8_WAIT_VX() PG8_WAIT_V(8)
#endif
#define PG8_WAIT_L(n) asm volatile("s_waitcnt lgkmcnt(" #n ")" ::: "memory")
#define PG8_BAR __builtin_amdgcn_s_barrier()
#define PG8_SCHED __builtin_amdgcn_sched_barrier(0)
    Unit cur, nxt; int ui = 0;
    if (!S.next(0, cur)) return;
    f32x4 acc[2][2][4][2];
#pragma unroll
    for (int a = 0; a < 2; ++a)
#pragma unroll
        for (int b = 0; b < 2; ++b)
#pragma unroll
            for (int m = 0; m < 4; ++m)
#pragma unroll
                for (int n = 0; n < 2; ++n) acc[a][b][m][n] = (f32x4){0.f, 0.f, 0.f, 0.f};
    bf16x8 At[4][2], B0[2][2], B1[2][2];
    const char* cA = (const char*)g.A + (size_t)cur.pm * tstep; const char* cB = (const char*)g.Bt + (size_t)cur.pn * tstep;
    S.a_ready(cur);
    if constexpr (SP2) {
        PG8_STAGE(PG8_SB(0, 0), cB, voffB); PG8_STAGE(PG8_SB(0, 1), cB + hstep, voffB); PG8_STAGE(PG8_SA(0, 0), cA, voffA); PG8_STAGE(PG8_SA(0, 1), cA + hstep, voffA);
        if (wr == 1) PG8_BAR;
        PG8_WAIT_V(2); PG8_BAR;
        PG8_STAGE(PG8_SB(1, 0), cB + kstep, voffB); PG8_STAGE(PG8_SA(1, 0), cA + kstep, voffA); PG8_STAGE(PG8_SB(1, 1), cB + hstep + kstep, voffB);
        PG8_WAIT_V(6); PG8_BAR;
    } else {
        PG8_STAGE(PG8_SB(0, 0), cB, voffB); PG8_STAGE(PG8_SA(0, 0), cA, voffA); PG8_STAGE(PG8_SB(0, 1), cB + hstep, voffB); PG8_STAGE(PG8_SA(0, 1), cA + hstep, voffA);
        if (wr == 1) PG8_BAR;
        PG8_WAIT_V(4); PG8_BAR;
        PG8_STAGE(PG8_SB(1, 0), cB + kstep, voffB); PG8_STAGE(PG8_SA(1, 0), cA + kstep, voffA); PG8_STAGE(PG8_SB(1, 1), cB + hstep + kstep, voffB);
        PG8_WAIT_V(6); PG8_BAR;
    }
    for (;;) {
        const bool has_next = S.next(ui + 1, nxt);
        const char* nA = has_next ? (const char*)g.A + (size_t)nxt.pm * tstep : cA; const char* nB = has_next ? (const char*)g.Bt + (size_t)nxt.pn * tstep : cB;
        for (int t = 0; t < nt; t += 2) {
            const bool last = (t == nt - 2);
            const char* a1 = cA + (size_t)(t + 1) * kstep;
            const char* a2 = last ? nA : cA + (size_t)(t + 2) * kstep; const char* b2 = last ? nB : cB + (size_t)(t + 2) * kstep;
            const char* a3 = a2 + kstep; const char* b3 = b2 + kstep;
            if (last && has_next) S.a_ready(nxt);
            if constexpr (Epi::PREFETCH) { if (t == nt - 6 || t == nt - 4) E.prefetch(cur, tid, t == nt - 6 ? 0 : 1, lds + 131072 + wid * 256); }
            const int relax = __builtin_amdgcn_readfirstlane((t == 0 && ui > 0) ? 1 : 0);
            if constexpr (SP2) {
            PG8_LDB(B0, 0, 0); PG8_LDB(B1, 0, 1); PG8_SCHED; PG8_LDA(At, 0, 0); PG8_STAGE(PG8_SA(1, 1), a1 + hstep, voffA);
            PG8_WAIT_VX(); PG8_WAIT_L(0); PG8_BAR; PG8_MMX(0); PG8_BAR; PG8_SCHED;
            PG8_LDA(At, 0, 1); PG8_STAGE(PG8_SB(0, 0), b2, voffB); PG8_STAGE(PG8_SB(0, 1), b2 + hstep, voffB); PG8_STAGE(PG8_SA(0, 0), a2, voffA);
            PG8_WAIT_VX(); PG8_WAIT_L(0); PG8_BAR; PG8_MMX(1); PG8_BAR; PG8_SCHED;
            PG8_LDB(B0, 1, 0); PG8_LDB(B1, 1, 1); PG8_SCHED; PG8_LDA(At, 1, 0); PG8_STAGE(PG8_SA(0, 1), a2 + hstep, voffA);
            PG8_WAIT_V(8); PG8_WAIT_L(0); PG8_BAR; PG8_MMX(0); PG8_BAR; PG8_SCHED;
            PG8_LDA(At, 1, 1); PG8_STAGE(PG8_SB(1, 0), b3, voffB); PG8_STAGE(PG8_SB(1, 1), b3 + hstep, voffB); PG8_STAGE(PG8_SA(1, 0), a3, voffA);
            PG8_WAIT_V(8); PG8_WAIT_L(0); PG8_BAR; PG8_MMX(1); PG8_BAR; PG8_SCHED;
            } else {
            PG8_LDB(B0, 0, 0); PG8_SCHED; PG8_LDA(At, 0, 0); PG8_STAGE(PG8_SA(1, 1), a1 + hstep, voffA);
            PG8_WAIT_L(8); PG8_BAR; PG8_WAIT_L(0); PG8_MMA(0, 0, At, B0); PG8_BAR; PG8_SCHED;
            PG8_LDB(B1, 0, 1); PG8_STAGE(PG8_SB(0, 0), b2, voffB);
            PG8_BAR; PG8_WAIT_L(0); PG8_MMA(0, 1, At, B1); PG8_BAR;
            PG8_LDA(At, 0, 1); PG8_STAGE(PG8_SA(0, 0), a2, voffA);
            PG8_BAR; PG8_WAIT_L(0); PG8_MMA(1, 0, At, B0); PG8_BAR; PG8_SCHED;
            PG8_STAGE(PG8_SB(0, 1), b2 + hstep, voffB);
            PG8_WAIT_V(6); PG8_BAR; PG8_MMA(1, 1, At, B1); PG8_BAR;
            PG8_LDB(B0, 1, 0); PG8_SCHED; PG8_LDA(At, 1, 0); PG8_STAGE(PG8_SA(0, 1), a2 + hstep, voffA);
            PG8_WAIT_L(8); PG8_BAR; PG8_WAIT_L(0); PG8_MMA(0, 0, At, B0); PG8_BAR; PG8_SCHED;
            PG8_LDB(B1, 1, 1); PG8_STAGE(PG8_SB(1, 0), b3, voffB);
            PG8_BAR; PG8_WAIT_L(0); PG8_MMA(0, 1, At, B1); PG8_BAR;
            PG8_LDA(At, 1, 1); PG8_STAGE(PG8_SA(1, 0), a3, voffA);
            PG8_BAR; PG8_WAIT_L(0); PG8_MMA(1, 0, At, B0); PG8_BAR; PG8_SCHED;
            PG8_STAGE(PG8_SB(1, 1), b3 + hstep, voffB);
            PG8_WAIT_V(6); PG8_BAR; PG8_MMA(1, 1, At, B1); PG8_BAR;
            }
        }
        if constexpr (ALIGN_EPI) { if (wr == 0) PG8_BAR; }
        if constexpr (!Epi::AFTER_DRAIN) { E(acc, cur, wr, wc, fr, fq); S.done(cur); }
        if (!has_next) break;
        if constexpr (!EPI_ZERO || Epi::AFTER_DRAIN)
#pragma unroll
        for (int a = 0; a < 2; ++a)
#pragma unroll
            for (int b = 0; b < 2; ++b)
#pragma unroll
                for (int m = 0; m < 4; ++m)
#pragma unroll
                    for (int n = 0; n < 2; ++n) {
#if PG8_ZERO64
                        asm volatile("v_mov_b64 %0, 0" : "=v"(*(double*)&acc[a][b][m][n])); asm volatile("v_mov_b64 %0, 0" : "=v"(*((double*)&acc[a][b][m][n] + 1)));
#else
                        acc[a][b][m][n] = (f32x4){0.f, 0.f, 0.f, 0.f};
#endif
                    }
        cur = nxt; cA = nA; cB = nB; ++ui;
        if constexpr (ALIGN_EPI) { if (wr == 1) PG8_BAR; }
    }
    PG8_WAIT_V(0);
    if constexpr (!ALIGN_EPI) { if (wr == 0) PG8_BAR; }
    PG8_BAR;
    if constexpr (Epi::AFTER_DRAIN) { E.fused(acc, cur, wr, wc, fr, fq, lds, wid, lane); S.done(cur); }
#undef PG8_SA
#undef PG8_SB
#undef PG8_STAGE
#undef PG8_LDA
#undef PG8_LDB
#undef PG8_MMA
#undef PG8_MMA2
#undef PG8_MMX
#undef PG8_MMA_LOOPS
#undef PG8_WAIT_V
#undef PG8_WAIT_L
#undef PG8_WAIT_VX
#undef PG8_WAIT_VXN
#undef PG8_BAR
#undef PG8_SCHED
}
}

#ifndef PG8_SP2
#define PG8_SP2 true
#endif
#ifndef PG8_ALIGN
#define PG8_ALIGN true
#endif
#ifndef ATT_NOREF
#define ATT_NOREF 1
#endif
#ifndef ATT_BANDSKIP
#define ATT_BANDSKIP 1
#endif
#ifndef ATT_SKIPBAR
#define ATT_SKIPBAR 1
#endif
#ifndef ATT_PHPRIO
#define ATT_PHPRIO 0
#endif
#if ATT_PHPRIO == 1
#define ATT_PRIO_A() __builtin_amdgcn_s_setprio(1)
#define ATT_PRIO_B() __builtin_amdgcn_s_setprio(0)
#elif ATT_PHPRIO == 2
#define ATT_PRIO_A() __builtin_amdgcn_s_setprio(0)
#define ATT_PRIO_B() __builtin_amdgcn_s_setprio(1)
#else
#define ATT_PRIO_A() do{}while(0)
#define ATT_PRIO_B() do{}while(0)
#endif
namespace attn_body {
constexpr bool NOREF = ATT_NOREF != 0;
using bf16=__hip_bfloat16;
using bf16x8=__attribute__((ext_vector_type(8)))short;
using s16x4=__attribute__((ext_vector_type(4)))short;
using f32x16=__attribute__((ext_vector_type(16)))float;
using f32x4=__attribute__((ext_vector_type(4)))float;
using u32x4=__attribute__((ext_vector_type(4)))unsigned;
constexpr int SEQ=2048,D=64,LDQ=3072;
constexpr int NW=8,QBLK=32,QB=QBLK*NW,KVBLK=64,NQB=SEQ/QB;
__device__ __forceinline__ int crow(int r,int hi){return (r&3)+8*(r>>2)+4*hi;}
#define SBAR() __builtin_amdgcn_sched_barrier(0)
__device__ __forceinline__ void cmask(f32x16&p0,f32x16&p1,int jb,int qrel,int hi){
  const float NEG=-INFINITY; int kb=64*jb+4*hi;
  #pragma unroll
  for(int r=0;r<16;++r){int kv=kb+(r&3)+8*(r>>2); if(kv>qrel)p0[r]=NEG; if(kv+32>qrel)p1[r]=NEG;}
}
__device__ __forceinline__ float dil_bias(int d){
  const unsigned u=(unsigned)d;
  const int c=(int)(u<=128u)+(int)((u<=512u)&&((u&3u)==0u))+(int)((d>=0)&&((u&15u)==0u));
  return c==0?-INFINITY:(c==1?0.f:(c==2?1.0f:1.5849625007211562f));
}
constexpr int DIL_LUT_OFF=144384, DIL_LUT_N=2336;
__device__ __forceinline__ void dil_hook(f32x16&p0,f32x16&p1,int dt,const char*shm){
#ifdef DIL_NO_LUT
  #pragma unroll
  for(int r=0;r<16;++r){const int d=dt-((r&3)+8*(r>>2)); p0[r]+=dil_bias(d); p1[r]+=dil_bias(d-32);}
#else
  const __attribute__((address_space(3))) float*Tl=(const __attribute__((address_space(3))) float*)(shm+DIL_LUT_OFF)+(dt+197);
  #pragma unroll
  for(int r=0;r<16;++r){const int off=(r&3)+8*(r>>2); float a0=Tl[59-off],a1=Tl[27-off],x0=p0[r],x1=p1[r],y0,y1;
    asm volatile("v_add_f32_e32 %0, %1, %2":"=v"(y0):"v"(x0),"v"(a0)); asm volatile("v_add_f32_e32 %0, %1, %2":"=v"(y1):"v"(x1),"v"(a1)); p0[r]=y0; p1[r]=y1;}
#endif
}
__device__ __forceinline__ void all_neg(f32x16&p0,f32x16&p1){
  #pragma unroll
  for(int r=0;r<16;++r){p0[r]=-INFINITY;p1[r]=-INFINITY;}
}

constexpr int NSLOT=3, SLOTB=8192;
constexpr int LDS_K=0, LDS_V=NSLOT*SLOTB, LDS_WS=2*NSLOT*SLOTB, LDS_OST=LDS_WS+NW*64*4, LDS_BYTES=LDS_OST+NW*4096;
constexpr float C2=0.125f*1.4426950408889634f;
__device__ __forceinline__ void glds16(const void*sbase,unsigned voff,unsigned lds_dst){unsigned keep;
  asm volatile("s_nop 4\n\ts_mov_b32 %0, m0\n\ts_mov_b32 m0, %3\n\ts_nop 0\n\tglobal_load_lds_dwordx4 %1, %2\n\ts_mov_b32 m0, %0":"=&s"(keep):"v"(voff),"s"(sbase),"s"(lds_dst):"memory");}
__device__ __forceinline__ float max3f(float a,float b,float c){float r;asm("v_max3_f32 %0, %1, %2, %3":"=v"(r):"v"(a),"v"(b),"v"(c));return r;}
__device__ __forceinline__ float max2f(float a,float b){float r;asm("v_max_f32_e32 %0, %1, %2":"=v"(r):"v"(a),"v"(b));return r;}
__device__ __forceinline__ float fadd_s(float a,float b){float r;asm("v_add_f32_e32 %0, %1, %2":"=v"(r):"v"(a),"v"(b));return r;}
__device__ __forceinline__ float fsub_s(float a,float b){float r;asm("v_sub_f32_e32 %0, %1, %2":"=v"(r):"v"(a),"v"(b));return r;}
typedef float f32x2_t __attribute__((ext_vector_type(2))); typedef __bf16 bf16x2_t __attribute__((ext_vector_type(2)));
__device__ __forceinline__ unsigned cvtpk_s(float lo,float hi){f32x2_t v={lo,hi};bf16x2_t b=__builtin_convertvector(v,bf16x2_t);return __builtin_bit_cast(unsigned,b);}
#define WAIT_BAR(N) asm volatile("s_waitcnt vmcnt(" #N ") lgkmcnt(0)\n\ts_barrier":::"memory")

__device__ __forceinline__ void qkt(f32x16&p0,f32x16&p1,const char*Kslot,const bf16x8*qr,int r32,int hi){
  const f32x16 negm=f32x16{};
  const char*kb=Kslot+hi*1024+r32*16;
  #pragma unroll
  for(int d0=0;d0<4;++d0){
    const bf16x8 b0=*reinterpret_cast<const bf16x8*>(kb+d0*2048);
    const bf16x8 b1=*reinterpret_cast<const bf16x8*>(kb+d0*2048+512);
    if(d0==0){p0=__builtin_amdgcn_mfma_f32_32x32x16_bf16(b0,qr[0],negm,0,0,0);p1=__builtin_amdgcn_mfma_f32_32x32x16_bf16(b1,qr[0],negm,0,0,0);}
    else{p0=__builtin_amdgcn_mfma_f32_32x32x16_bf16(b0,qr[d0],p0,0,0,0);p1=__builtin_amdgcn_mfma_f32_32x32x16_bf16(b1,qr[d0],p1,0,0,0);}}
}
typedef __attribute__((address_space(3))) const char* lds_cptr;
typedef short v4i16_t __attribute__((ext_vector_type(4)));
__device__ __forceinline__ void kload8(bf16x8*kf,lds_cptr kp){
  kf[0]=*(const __attribute__((address_space(3))) bf16x8*)(kp);      kf[1]=*(const __attribute__((address_space(3))) bf16x8*)(kp+512);
  kf[2]=*(const __attribute__((address_space(3))) bf16x8*)(kp+2048); kf[3]=*(const __attribute__((address_space(3))) bf16x8*)(kp+2560);
  kf[4]=*(const __attribute__((address_space(3))) bf16x8*)(kp+4096); kf[5]=*(const __attribute__((address_space(3))) bf16x8*)(kp+4608);
  kf[6]=*(const __attribute__((address_space(3))) bf16x8*)(kp+6144); kf[7]=*(const __attribute__((address_space(3))) bf16x8*)(kp+6656);
}
__device__ __forceinline__ void kload2(bf16x8*kf,lds_cptr kp,int j){ kf[2*j]=*(const __attribute__((address_space(3))) bf16x8*)(kp+j*2048); kf[2*j+1]=*(const __attribute__((address_space(3))) bf16x8*)(kp+j*2048+512); }
__device__ __forceinline__ s16x4 vtr(lds_cptr p){ return __builtin_bit_cast(s16x4,__builtin_amdgcn_ds_read_tr16_b64_v4i16((__attribute__((address_space(3))) v4i16_t*)p)); }
__device__ __forceinline__ float rowmax(const f32x16&p0,const f32x16&p1){
  float a=max3f(p0[0],p0[1],p1[0]),b=max3f(p0[2],p0[3],p1[1]);a=max3f(a,p1[2],p1[3]);
  #pragma unroll
  for(int r=4;r<16;r+=4){a=max3f(a,p0[r],p0[r+1]);b=max3f(b,p0[r+2],p0[r+3]);a=max3f(a,p1[r],p1[r+1]);b=max3f(b,p1[r+2],p1[r+3]);}
  const float m=max2f(a,b);
  auto rr=__builtin_amdgcn_permlane32_swap(__float_as_uint(m),__float_as_uint(m),false,false);
  return max2f(__uint_as_float(rr[0]),__uint_as_float(rr[1]));
}
__device__ __forceinline__ void pv(f32x16*o,int vb,bf16x8 pa0,bf16x8 pa1,bf16x8 pa2,bf16x8 pa3){
  #pragma unroll
  for(int d0=0;d0<2;++d0){s16x4 lo[4],hi[4];
    #pragma unroll
    for(int ks=0;ks<4;++ks){
      asm volatile("ds_read_b64_tr_b16 %0,%1 offset:%c2":"=&v"(lo[ks]):"v"(vb),"i"(d0*4096+ks*1024):"memory");
      asm volatile("ds_read_b64_tr_b16 %0,%1 offset:%c2":"=&v"(hi[ks]):"v"(vb),"i"(d0*4096+ks*1024+512):"memory");}
    asm volatile("s_waitcnt lgkmcnt(0)":::"memory");SBAR();
    #define PK(k) (bf16x8){lo[k][0],lo[k][1],lo[k][2],lo[k][3],hi[k][0],hi[k][1],hi[k][2],hi[k][3]}
    o[d0]=__builtin_amdgcn_mfma_f32_32x32x16_bf16(pa0,PK(0),o[d0],0,0,0);
    o[d0]=__builtin_amdgcn_mfma_f32_32x32x16_bf16(pa1,PK(1),o[d0],0,0,0);
    o[d0]=__builtin_amdgcn_mfma_f32_32x32x16_bf16(pa2,PK(2),o[d0],0,0,0);
    o[d0]=__builtin_amdgcn_mfma_f32_32x32x16_bf16(pa3,PK(3),o[d0],0,0,0);
    #undef PK
  }
}

#ifndef ATTN_STORE16
#ifndef ATT_ST
#define ATT_ST 1
#endif
#define ATTN_STORE16(p,v) do{ if(ATT_ST==2){ const u32x4 v__=(v); ST16_SC1((u32x4*)(p),v__); } else if(ATT_ST) __builtin_nontemporal_store((v),(u32x4*)(p)); else *(u32x4*)(p)=(v); }while(0)
#endif
constexpr int LDS_S1=83968, LDS_SSB=LDS_S1+NW*4096, LDS_DC=LDS_SSB+NW*128, ATTN_LDS_BYTES_DIFF=LDS_DC+544;
template<int MODE,int THRL,int ABL=0>
__device__ __forceinline__ void attn_unit(int qb,const bf16*__restrict__ QKVb,int qcol,int kcol,int vcol,bf16*Og,int ldo,const float*km0,char*shm,int est,int kncol,int vncol,int first,int&ring,int qncol,int qbn,bf16x8&qp0,bf16x8&qp1,bf16x8&qp2,bf16x8&qp3){
  const bf16*Qg=QKVb+qcol,*Kg=QKVb+kcol,*Vg=QKVb+vcol,*Kn=QKVb+kncol,*Vn=QKVb+vncol,*Qn=QKVb+qncol; const float*km1=km0+128*512;
  int tid_=threadIdx.x; asm volatile("":"+v"(tid_));
  #define CLOSE_BAR() do{ if constexpr((ABL&2048)!=0){ asm volatile("s_waitcnt lgkmcnt(0)\n\ts_barrier":::"memory"); } else if constexpr((ABL&32)!=0){ if(wid<4){ WBX(2); } } else { WBX(2); } }while(0)
  #define WBX(N) do{ if constexpr((ABL&8)!=0){ asm volatile("s_waitcnt vmcnt(" #N ") lgkmcnt(0)":::"memory"); } else { WAIT_BAR(N); } }while(0)
  const int tid=tid_,lane=tid&63,r32=lane&31,hi=lane>>5; const int wid=__builtin_amdgcn_readfirstlane(tid>>6);
  const int q0=qb*QB;
  const bf16*Qw=Qg+(long)(q0+wid*QBLK)*LDQ;
  const bf16*Kh=Kg,*Vh=Vg;
  const unsigned lds0=(unsigned)(uintptr_t)shm;
  float*wsf=(float*)(shm+LDS_WS)+wid*64;
  const bf16*ksrc=Kh+wid*8;
  const bf16*vsrc=Vh+(long)(16*(wid&3))*LDQ+(wid>>2)*32;
  const bf16*knsrc=Kn+wid*8; const bf16*vnsrc=Vn+(long)(16*(wid&3))*LDQ+(wid>>2)*32;
  const unsigned koff=(unsigned)lane*(LDQ*2u), voff=(unsigned)(lane>>2)*(LDQ*2u)+(unsigned)(lane&3)*16u;
  const unsigned kdst=lds0+LDS_K+wid*1024, vdst=lds0+LDS_V+wid*1024;
  #define DMA_K(t,slot) glds16(ksrc+(long)(t)*KVBLK*LDQ,koff,(unsigned)__builtin_amdgcn_readfirstlane(kdst+(slot)))
  #define DMA_V(t,slot) glds16(vsrc+(long)(t)*KVBLK*LDQ,voff,(unsigned)__builtin_amdgcn_readfirstlane(vdst+(slot)))
  #define DMA_KX(t,slot) do{ const int t_=(t); const bf16*s_=(t_<NT)?(ksrc+(long)t_*KVBLK*LDQ):(knsrc+(long)(t_-NT)*KVBLK*LDQ); glds16(s_,koff,(unsigned)__builtin_amdgcn_readfirstlane(kdst+(slot))); }while(0)
  #define DMA_VX(t,slot) do{ const int t_=(t); const bf16*s_=(t_<NT)?(vsrc+(long)t_*KVBLK*LDQ):(vnsrc+(long)(t_-NT)*KVBLK*LDQ); glds16(s_,voff,(unsigned)__builtin_amdgcn_readfirstlane(vdst+(slot))); }while(0)
  const int vb0=(int)(lds0+LDS_V)+((lane>>4)&1)*32+(lane&3)*8+(4*hi+((lane&15)>>2))*64;
  const int s0=ring, s1=(s0==(NSLOT-1)*SLOTB)?0:s0+SLOTB, s2=(s1==(NSLOT-1)*SLOTB)?0:s1+SLOTB;
  const char*Kbase=shm+LDS_K+s0; bf16x8 kf[8];
  const lds_cptr shm3=(lds_cptr)shm; const lds_cptr kp0=shm3+LDS_K+hi*1024+r32*16; const lds_cptr vp0=shm3+LDS_V+((lane>>4)&1)*32+(lane&3)*8+(4*hi+((lane&15)>>2))*64;
  const int NT=(q0+QB)/KVBLK;
  if(first){DMA_K(0,s0);DMA_V(0,s0);DMA_K(1,s1);}
  bf16x8 qr[4];
  if(first){
    #pragma unroll
    for(int d0=0;d0<4;++d0)qr[d0]=*reinterpret_cast<const bf16x8*>(&Qw[(long)r32*LDQ+d0*16+hi*8]); }
  else{
    qr[0]=qp0;qr[1]=qp1;qr[2]=qp2;qr[3]=qp3; }
  float mhat=0.f,l_reg=0.f;f32x16 o[2];o[0]=f32x16{};o[1]=f32x16{};const f32x16 zero16=f32x16{};
  const int qrel=wid*QBLK+r32;
  unsigned selmask=0u;
  if constexpr(MODE==2){
    if(qb<=3)selmask=(1u<<qb)-1u;
    else{
      float g[8];
      #pragma unroll
      for(int n=0;n<8;++n){
        if(n<qb){ float s=0.f;
          #pragma unroll
          for(int d0=0;d0<4;++d0){
            const f32x4 a0=*(const f32x4*)(km0+(long)n*512+d0*16+hi*8),a1=*(const f32x4*)(km0+(long)n*512+d0*16+hi*8+4);
            const f32x4 b0=*(const f32x4*)(km1+(long)n*512+d0*16+hi*8),b1=*(const f32x4*)(km1+(long)n*512+d0*16+hi*8+4);
            const f32x4 k0=a0+b0,k1=a1+b1;
            #pragma unroll
            for(int e=0;e<4;++e){
              const unsigned w=(unsigned)(unsigned short)qr[d0][e],w2=(unsigned)(unsigned short)qr[d0][4+e];
              s+=__uint_as_float(w<<16)*k0[e]; s+=__uint_as_float(w2<<16)*k1[e]; } }
          s+=__shfl_xor(s,32); g[n]=s; }
        else g[n]=-INFINITY; }
      #pragma unroll
      for(int n=0;n<8;++n){ int rank=0;
        #pragma unroll
        for(int m=0;m<8;++m){ if(m!=n){ rank+=(g[m]>g[n]||(g[m]==g[n]&&m<n))?1:0; } }
        if(n<qb&&rank<3)selmask|=(1u<<n); }
    }
    ((unsigned*)(shm+LDS_OST))[wid*1024+lane]=selmask;
  }
  const int dq=q0+qrel-4*hi;
  #define MHOOK(P0,P1,t) do{ if constexpr(MODE==1){ dil_hook(P0,P1,dq-64*(t),shm); } \
      else if constexpr(MODE==2){ if((t)<NT-4){ const unsigned sm_=((const unsigned*)(shm+LDS_OST))[wid*1024+lane]; if(!((sm_>>((t)>>2))&1u)) all_neg(P0,P1); } } }while(0)
  #define CMASK(P0,P1,t) do{ if constexpr(MODE!=1){ int jb_=(t)-(NT-4); if(jb_>=0)cmask(P0,P1,jb_,qrel,hi);} }while(0)
  bool resc=false;
  #define START(P0,P1) do{ resc=false; \
    if constexpr(!NOREF){ const float rm=rowmax(P0,P1); const float dl=(rm>-1e30f)?rm:0.f; mhat=fadd_s(mhat,dl); \
      _Pragma("unroll") for(int r=0;r<16;++r){P0[r]=fsub_s(P0[r],dl);P1[r]=fsub_s(P1[r],dl);} \
      } \
    _Pragma("unroll") for(int r=0;r<16;++r)P0[r]=__builtin_amdgcn_exp2f(P0[r]); }while(0)
  #define RESC() do{ if(resc){ asm volatile("s_waitcnt lgkmcnt(0)":::"memory"); \
      _Pragma("unroll") for(int d_=0;d_<2;++d_) _Pragma("unroll") for(int r=0;r<16;++r)o[d_][r]*=wsf[crow(r,hi)]; } }while(0)
  f32x16 pA0,pA1,pB0,pB1;
  int sl_prev=s0,sl_cur=s0,sl_next=s1;
  #define ROT() do{sl_prev=sl_cur;sl_cur=sl_next;sl_next=(sl_next==(NSLOT-1)*SLOTB)?0:sl_next+SLOTB;}while(0)
  if(first){DMA_K(2,s2);}
  if(first||!ATT_SKIPBAR){ WBX(3); }
  qkt(pA0,pA1,Kbase,qr,r32,hi);asm volatile("s_nop 15\n\ts_nop 7":"+v"(pA0),"+v"(pA1));CMASK(pA0,pA1,0);MHOOK(pA0,pA1,0);
  START(pA0,pA1);
  _Pragma("unroll") for(int r=0;r<16;++r)pA1[r]=__builtin_amdgcn_exp2f(pA1[r]);
  WBX(0);
  DMA_K(3,s0);DMA_V(1,s1);
  ROT();
  kload8(kf,kp0+sl_cur);
  WBX(2);
  s16x4 vlo[8],vhi[8]; u32x4 pw0,pw1,pw2,pw3;
  if constexpr((ABL&16)!=0){ _Pragma("unroll") for(int i_=0;i_<8;++i_){vlo[i_]=s16x4{};vhi[i_]=s16x4{};} }
  if constexpr((ABL&4)!=0){ pA0=f32x16{};pA1=f32x16{};pB0=f32x16{};pB1=f32x16{}; }
  if constexpr((ABL&512)!=0){ pw0=u32x4{};pw1=u32x4{};pw2=u32x4{};pw3=u32x4{}; }
  #define PKW(P,B) cvtpk_s(P[B],P[B+1])
  #define PAF(k) __builtin_bit_cast(bf16x8,pw##k)
  #define VFR(i) (bf16x8){vlo[i][0],vlo[i][1],vlo[i][2],vlo[i][3],vhi[i][0],vhi[i][1],vhi[i][2],vhi[i][3]}
  #define PIN(x) asm volatile("":"+v"(x))
  #define MX3(a,b,c) __builtin_fmaxf(__builtin_fmaxf((a),(b)),(c))
  #define GAPA(MF,A0,A1,A2,A3,W0,W1,PW) do{ if constexpr((ABL&4)==0){ MF; } if constexpr((ABL&512)==0){ sacc+=A0; sacc+=A1; sacc+=A2; sacc+=A3; PIN(sacc); W0; W1; PIN(PW); } if constexpr((ABL&1024)!=0){ rmx_=MX3(rmx_,A0,A1); rmx_=MX3(rmx_,A2,A3); PIN(rmx_); } SBAR(); }while(0)
  #define EX(v) (((ABL&1)!=0)?(v):__builtin_amdgcn_exp2f(v))
  #define GAPB(MF,X,B) do{ if constexpr((ABL&2)==0){ MF; } if constexpr((ABL&1024)!=0){ X[B]=fsub_s(X[B],mhat);X[B+1]=fsub_s(X[B+1],mhat);X[B+2]=fsub_s(X[B+2],mhat);X[B+3]=fsub_s(X[B+3],mhat); } X[B]=EX(X[B]); X[B+1]=EX(X[B+1]); X[B+2]=EX(X[B+2]); X[B+3]=EX(X[B+3]); PIN(X); SBAR(); }while(0)
  #define VRD(i) do{ if constexpr((ABL&16)!=0) break; vlo[i]=vtr(vp_+(((i)>>2)*4096+((i)&3)*1024)); vhi[i]=vtr(vp_+(((i)>>2)*4096+((i)&3)*1024+512)); }while(0)
  #define KRD(G,j) do{ if constexpr((ABL&128)==0){ if(G){ kload2(kf,kp0+sl_next,j); SBAR(); } } }while(0)
  #define STEP(C0,C1,P0,P1,t,GL) do{ SBAR(); ATT_PRIO_A(); \
    const lds_cptr vp_=vp0+sl_prev; \
    VRD(0); SBAR(); float sacc=(P0[0]+P0[1]); float rmx_=0.f; \
    GAPA(C0=__builtin_amdgcn_mfma_f32_32x32x16_bf16(kf[0],qr[0],zero16,0,0,0), P0[2],P0[3],P0[4],P0[5],     pw0[0]=PKW(P0,0), pw0[1]=PKW(P0,2), pw0); \
    VRD(4); SBAR(); GAPA(C1=__builtin_amdgcn_mfma_f32_32x32x16_bf16(kf[1],qr[0],zero16,0,0,0), P0[6],P0[7],P0[8],P0[9],     pw0[2]=PKW(P0,4), pw0[3]=PKW(P0,6), pw0); \
    VRD(1); SBAR(); GAPA(C0=__builtin_amdgcn_mfma_f32_32x32x16_bf16(kf[2],qr[1],C0,0,0,0),   P0[10],P0[11],P0[12],P0[13], pw1[0]=PKW(P0,8), pw1[1]=PKW(P0,10), pw1); \
    VRD(5); SBAR(); GAPA(C1=__builtin_amdgcn_mfma_f32_32x32x16_bf16(kf[3],qr[1],C1,0,0,0),   P0[14],P0[15],P1[0],P1[1],   pw1[2]=PKW(P0,12),pw1[3]=PKW(P0,14), pw1); \
    VRD(2); SBAR(); GAPA(C0=__builtin_amdgcn_mfma_f32_32x32x16_bf16(kf[4],qr[2],C0,0,0,0),   P1[2],P1[3],P1[4],P1[5],     pw2[0]=PKW(P1,0), pw2[1]=PKW(P1,2), pw2); \
    VRD(6); SBAR(); GAPA(C1=__builtin_amdgcn_mfma_f32_32x32x16_bf16(kf[5],qr[2],C1,0,0,0),   P1[6],P1[7],P1[8],P1[9],     pw2[2]=PKW(P1,4), pw2[3]=PKW(P1,6), pw2); \
    VRD(3); SBAR(); GAPA(C0=__builtin_amdgcn_mfma_f32_32x32x16_bf16(kf[6],qr[3],C0,0,0,0),   P1[10],P1[11],P1[12],P1[13], pw3[0]=PKW(P1,8), pw3[1]=PKW(P1,10), pw3); \
    VRD(7); SBAR(); GAPA(C1=__builtin_amdgcn_mfma_f32_32x32x16_bf16(kf[7],qr[3],C1,0,0,0),   P1[14],P1[15],0.f,0.f,       pw3[2]=PKW(P1,12),pw3[3]=PKW(P1,14), pw3); \
    l_reg+=sacc; if constexpr((ABL&1024)!=0){ asm volatile(""::"v"(rmx_)); } \
    if constexpr((ABL&64)==0){ STEP_DMA(t); } \
    if constexpr((ABL&32)!=0){ if(wid>=4){ WAIT_BAR(2); } } \
    if constexpr(NOREF){ if constexpr(MODE==1){ asm volatile("s_nop 7\n\ts_nop 7":"+v"(C0),"+v"(C1)); } CMASKX(C0,C1,t); MHOOK(C0,C1,t); resc=false; } else \
    if constexpr((ABL&256)==0){ \
    asm volatile("s_nop 7\n\ts_nop 7":"+v"(C0),"+v"(C1)); \
    _Pragma("unroll") for(int r=0;r<16;++r){C0[r]=fsub_s(C0[r],mhat);C1[r]=fsub_s(C1[r],mhat);} \
    CMASKX(C0,C1,t); MHOOK(C0,C1,t); \
    { float a=MX3(C0[0],C0[1],C1[0]),b=MX3(C0[2],C0[3],C1[1]); a=MX3(a,C1[2],C1[3]); \
      _Pragma("unroll") for(int r=4;r<16;r+=4){a=MX3(a,C0[r],C0[r+1]);b=MX3(b,C0[r+2],C0[r+3]);a=MX3(a,C1[r],C1[r+1]);b=MX3(b,C1[r+2],C1[r+3]);} \
      float rm=__builtin_fmaxf(a,b); { auto rr=__builtin_amdgcn_permlane32_swap(__float_as_uint(rm),__float_as_uint(rm),false,false); rm=__builtin_fmaxf(__uint_as_float(rr[0]),__uint_as_float(rr[1])); } \
      resc=false; \
      if(__builtin_expect(__any(rm>(float)THRL),0)){ const float dl=__builtin_fmaxf(rm,0.f); mhat+=dl; \
        _Pragma("unroll") for(int r=0;r<16;++r){C0[r]-=dl;C1[r]-=dl;} \
        const float f=__builtin_amdgcn_exp2f(-dl); l_reg*=f; if(hi==0)wsf[r32]=f; resc=true; } } \
    } else { resc=false; } \
    SBAR(); ATT_PRIO_B(); \
    GAPB(o[0]=__builtin_amdgcn_mfma_f32_32x32x16_bf16(PAF(0),VFR(0),o[0],0,0,0), C0,0); \
    GAPB(o[1]=__builtin_amdgcn_mfma_f32_32x32x16_bf16(PAF(0),VFR(4),o[1],0,0,0), C0,4); \
    KRD(GL,0); GAPB(o[0]=__builtin_amdgcn_mfma_f32_32x32x16_bf16(PAF(1),VFR(1),o[0],0,0,0), C0,8); \
    KRD(GL,1); GAPB(o[1]=__builtin_amdgcn_mfma_f32_32x32x16_bf16(PAF(1),VFR(5),o[1],0,0,0), C0,12); \
    KRD(GL,2); GAPB(o[0]=__builtin_amdgcn_mfma_f32_32x32x16_bf16(PAF(2),VFR(2),o[0],0,0,0), C1,0); \
    KRD(GL,3); GAPB(o[1]=__builtin_amdgcn_mfma_f32_32x32x16_bf16(PAF(2),VFR(6),o[1],0,0,0), C1,4); \
    GAPB(o[0]=__builtin_amdgcn_mfma_f32_32x32x16_bf16(PAF(3),VFR(3),o[0],0,0,0), C1,8); \
    GAPB(o[1]=__builtin_amdgcn_mfma_f32_32x32x16_bf16(PAF(3),VFR(7),o[1],0,0,0), C1,12); \
    }while(0)
  int t=1;
  #define CMASKX(P0,P1,t) do{}while(0)
  #define STEP_DMA(t) DMA_K((t)+3,sl_cur); DMA_V((t)+1,sl_next)
  for(;t+5<NT;t+=2){
    STEP(pB0,pB1,pA0,pA1,t,true);     CLOSE_BAR(); RESC(); ROT();
    STEP(pA0,pA1,pB0,pB1,t+1,true);   CLOSE_BAR(); RESC(); ROT();
  }
  #undef STEP_DMA
  #define STEP_DMA(t) DMA_KX((t)+3,sl_cur); DMA_VX((t)+1,sl_next)
  #undef CMASKX
  #define CMASKX(P0,P1,t) CMASK(P0,P1,t)
  for(;t+1<NT;t+=2){
    STEP(pB0,pB1,pA0,pA1,t,(t+1<NT));       CLOSE_BAR(); RESC(); ROT();
    STEP(pA0,pA1,pB0,pB1,t+1,(t+2<NT));     CLOSE_BAR(); RESC(); ROT();
  }
  if(!ATT_BANDSKIP||wid>=4){ STEP(pB0,pB1,pA0,pA1,NT-1,false); } else { STEP_DMA(NT-1); }
  CLOSE_BAR(); RESC();
  ring=sl_next;
  #undef STEP_DMA
  if(!ATT_BANDSKIP||(wid>>1)>=3)
  { float sacc=pB0[0]+pB0[1]; _Pragma("unroll") for(int r=2;r<16;++r)sacc+=pB0[r]; _Pragma("unroll") for(int r=0;r<16;++r)sacc+=pB1[r]; l_reg+=sacc;
    pw0=(u32x4){PKW(pB0,0),PKW(pB0,2),PKW(pB0,4),PKW(pB0,6)};pw1=(u32x4){PKW(pB0,8),PKW(pB0,10),PKW(pB0,12),PKW(pB0,14)};pw2=(u32x4){PKW(pB1,0),PKW(pB1,2),PKW(pB1,4),PKW(pB1,6)};pw3=(u32x4){PKW(pB1,8),PKW(pB1,10),PKW(pB1,12),PKW(pB1,14)};
    SBAR(); pv(o,vb0+sl_cur,PAF(0),PAF(1),PAF(2),PAF(3)); }
  #undef PKW
  #undef PAF
  #undef VFR
  #undef PIN
  #undef MX3
  #undef GAPA
  #undef GAPB
  #undef EX
  #undef VRD
  #undef KRD
  #undef STEP
  #undef CMASKX
  { const bf16*Qnw=Qn+(long)(qbn*QB+wid*QBLK)*LDQ;
    qp0=*reinterpret_cast<const bf16x8*>(&Qnw[(long)r32*LDQ+0*16+hi*8]); qp1=*reinterpret_cast<const bf16x8*>(&Qnw[(long)r32*LDQ+1*16+hi*8]);
    qp2=*reinterpret_cast<const bf16x8*>(&Qnw[(long)r32*LDQ+2*16+hi*8]); qp3=*reinterpret_cast<const bf16x8*>(&Qnw[(long)r32*LDQ+3*16+hi*8]); }
  {auto rr=__builtin_amdgcn_permlane32_swap(__float_as_uint(l_reg),__float_as_uint(l_reg),false,false);l_reg=__uint_as_float(rr[0])+__uint_as_float(rr[1]);}
  if(hi==0)wsf[32+r32]=l_reg;asm volatile("s_waitcnt lgkmcnt(0)":::"memory");
  float rli[16];
  #pragma unroll
  for(int r=0;r<16;++r)rli[r]=__builtin_amdgcn_rcpf(wsf[32+crow(r,hi)]);
  bf16*Ow=Og+(long)(q0+wid*QBLK)*ldo;
  if(est==0){ bf16*stg=(bf16*)(shm+LDS_OST)+wid*2048;
    #pragma unroll
    for(int r=0;r<16;++r){const int orow=crow(r,hi);
      #pragma unroll
      for(int d0=0;d0<2;++d0)stg[orow*64+d0*32+r32]=__float2bfloat16(o[d0][r]*rli[r]);}
    asm volatile("s_waitcnt lgkmcnt(0)":::"memory");
    #pragma unroll
    for(int i=0;i<4;++i){const int row=i*8+(lane>>3),ch=lane&7; const u32x4 v=*(const u32x4*)(stg+row*64+ch*8); ATTN_STORE16(Ow+(long)row*ldo+ch*8,v);} }
  else if(est==1){ bf16*s1=(bf16*)(shm+LDS_S1)+wid*2048;
    #pragma unroll
    for(int r=0;r<16;++r){const int orow=crow(r,hi);
      #pragma unroll
      for(int d0=0;d0<2;++d0)s1[orow*64+d0*32+r32]=__float2bfloat16(o[d0][r]*rli[r]);} }
  else{ bf16*s1=(bf16*)(shm+LDS_S1)+wid*2048; bf16*stg=(bf16*)(shm+LDS_OST)+wid*2048; bf16*dst=(est==2)?stg:s1;
    const float*dc=(const float*)(shm+LDS_DC); float*ssb=(float*)(shm+LDS_SSB)+wid*32; const float lam=dc[128];
    #pragma unroll
    for(int r=0;r<16;++r){const int orow=crow(r,hi);
      #pragma unroll
      for(int d0=0;d0<2;++d0){const int idx=orow*64+d0*32+r32; const float o1=__bfloat162float(s1[idx]); dst[idx]=__float2bfloat16(o1-lam*(o[d0][r]*rli[r]));}}
    asm volatile("s_waitcnt lgkmcnt(0)":::"memory");
    const int ch=lane&7;
    #pragma unroll
    for(int i=0;i<4;++i){const int row=i*8+(lane>>3); const u32x4 v=*(const u32x4*)(dst+row*64+ch*8);
      float dv[8];
      #pragma unroll
      for(int e=0;e<4;++e){dv[2*e]=__uint_as_float(v[e]<<16);dv[2*e+1]=__uint_as_float(v[e]&0xffff0000u);}
      float ss=0.f;
      #pragma unroll
      for(int e=0;e<8;++e)ss+=dv[e]*dv[e];
      ss+=__shfl_xor(ss,1);ss+=__shfl_xor(ss,2);ss+=__shfl_xor(ss,4);
      if(est==2){ if(ch==0)ssb[row]=ss; }
      else{ const float rs=1.0f/sqrtf((ss+ssb[row])*(1.0f/128.0f)+1e-5f);
        const u32x4 v0=*(const u32x4*)(stg+row*64+ch*8);
        const f32x4 g0a=*(const f32x4*)(dc+ch*8),g0b=*(const f32x4*)(dc+ch*8+4),g1a=*(const f32x4*)(dc+64+ch*8),g1b=*(const f32x4*)(dc+64+ch*8+4);
        u32x4 w0,w1;
        #pragma unroll
        for(int e=0;e<4;++e){ const float ga=(e<2)?g0a[2*e]:g0b[2*e-4], gb=(e<2)?g0a[2*e+1]:g0b[2*e-3], ha=(e<2)?g1a[2*e]:g1b[2*e-4], hb=(e<2)?g1a[2*e+1]:g1b[2*e-3];
          w0[e]=cvtpk_s(__uint_as_float(v0[e]<<16)*rs*ga,__uint_as_float(v0[e]&0xffff0000u)*rs*gb);
          w1[e]=cvtpk_s(dv[2*e]*rs*ha,dv[2*e+1]*rs*hb); }
        ATTN_STORE16(Ow+(long)row*ldo+ch*8,w0); ATTN_STORE16(Ow+(long)row*ldo+64+ch*8,w1); } } }
  asm volatile("s_waitcnt lgkmcnt(0)\n\ts_barrier":::"memory");
  #undef DMA_K
  #undef DMA_V
  #undef DMA_KX
  #undef DMA_VX
  #undef CMASK
  #undef MHOOK
  #undef START
  #undef RESC
  #undef ROT
  #undef WBX
  #undef CLOSE_BAR
}
constexpr int V_SLOTB=16384;
constexpr int X_K=0, X_V=NSLOT*SLOTB, X_WS=X_V+NSLOT*V_SLOTB, X_ST=X_WS+NW*256, X_DC=X_ST+NW*8192, X_BYTES=X_DC+544;
__device__ __forceinline__ void pv128(f32x16*o,int vb,bf16x8 pa0,bf16x8 pa1,bf16x8 pa2,bf16x8 pa3){
  #pragma unroll
  for(int d0=0;d0<4;++d0){s16x4 lo[4],hi[4];
    #pragma unroll
    for(int ks=0;ks<4;++ks){
      asm volatile("ds_read_b64_tr_b16 %0,%1 offset:%c2":"=&v"(lo[ks]):"v"(vb),"i"(d0*4096+ks*1024):"memory");
      asm volatile("ds_read_b64_tr_b16 %0,%1 offset:%c2":"=&v"(hi[ks]):"v"(vb),"i"(d0*4096+ks*1024+512):"memory");}
    asm volatile("s_waitcnt lgkmcnt(0)":::"memory");SBAR();
    #define PK(k) (bf16x8){lo[k][0],lo[k][1],lo[k][2],lo[k][3],hi[k][0],hi[k][1],hi[k][2],hi[k][3]}
    o[d0]=__builtin_amdgcn_mfma_f32_32x32x16_bf16(pa0,PK(0),o[d0],0,0,0);
    o[d0]=__builtin_amdgcn_mfma_f32_32x32x16_bf16(pa1,PK(1),o[d0],0,0,0);
    o[d0]=__builtin_amdgcn_mfma_f32_32x32x16_bf16(pa2,PK(2),o[d0],0,0,0);
    o[d0]=__builtin_amdgcn_mfma_f32_32x32x16_bf16(pa3,PK(3),o[d0],0,0,0);
    #undef PK
  }
}
template<int THRL> __device__ __forceinline__ void attn_unit_dv128(int qb,const bf16*__restrict__ QKVb,int qcol,int kcol,int vcol,bf16*Og,int ldo,char*shm,int est,int kncol,int first,int&ring,int qncol,int qbn,bf16x8&qp0,bf16x8&qp1,bf16x8&qp2,bf16x8&qp3){
  const bf16*Qg=QKVb+qcol,*Kg=QKVb+kcol,*Vg=QKVb+vcol,*Kn=QKVb+kncol,*Qn=QKVb+qncol;
  int tid_=threadIdx.x; asm volatile("":"+v"(tid_));
  const int tid=tid_,lane=tid&63,r32=lane&31,hi=lane>>5; const int wid=__builtin_amdgcn_readfirstlane(tid>>6);
  const int q0=qb*QB;
  const bf16*Qw=Qg+(long)(q0+wid*QBLK)*LDQ;
  const unsigned lds0=(unsigned)(uintptr_t)shm;
  float*wsf=(float*)(shm+X_WS)+wid*64;
  const bf16*ksrc=Kg+wid*8, *knsrc=Kn+wid*8;
  const bf16*vsrc=Vg+(long)(16*(wid&3))*LDQ+(wid>>2)*32;
  const unsigned koff=(unsigned)lane*(LDQ*2u), voff=(unsigned)(lane>>2)*(LDQ*2u)+(unsigned)(lane&3)*16u;
  const unsigned kdst=lds0+X_K+wid*1024, vdst=lds0+X_V+wid*1024;
  const int NT=(q0+QB)/KVBLK;
  #define DMA_K(t,slot) glds16(ksrc+(long)(t)*KVBLK*LDQ,koff,(unsigned)__builtin_amdgcn_readfirstlane(kdst+(slot)))
  #define DMA_V(t,vslot) do{ const bf16*s_=vsrc+(long)(t)*KVBLK*LDQ; glds16(s_,voff,(unsigned)__builtin_amdgcn_readfirstlane(vdst+(vslot))); glds16(s_+64,voff,(unsigned)__builtin_amdgcn_readfirstlane(vdst+(vslot)+8192)); }while(0)
  #define DMA_KX(t,slot) do{ const int t_=(t); const bf16*s_=(t_<NT)?(ksrc+(long)t_*KVBLK*LDQ):(knsrc+(long)(t_-NT)*KVBLK*LDQ); glds16(s_,koff,(unsigned)__builtin_amdgcn_readfirstlane(kdst+(slot))); }while(0)
  #define DMA_VX(t,vslot) do{ const int t_=(t); DMA_V((t_<NT)?t_:(t_-NT),vslot); }while(0)
  const int vb0=(int)(lds0+X_V)+((lane>>4)&1)*32+(lane&3)*8+(4*hi+((lane&15)>>2))*64;
  const int s0=ring, s1=(s0==(NSLOT-1)*SLOTB)?0:s0+SLOTB, s2=(s1==(NSLOT-1)*SLOTB)?0:s1+SLOTB;
  const char*Kbase=shm+X_K+s0; bf16x8 kf[8];
  const lds_cptr shm3=(lds_cptr)shm; const lds_cptr kp0=shm3+X_K+hi*1024+r32*16; const lds_cptr vp0=shm3+X_V+((lane>>4)&1)*32+(lane&3)*8+(4*hi+((lane&15)>>2))*64;
  if(first){DMA_K(0,s0);DMA_V(0,2*s0);DMA_K(1,s1);}
  bf16x8 qr[4];
  if(first){
    #pragma unroll
    for(int d0=0;d0<4;++d0)qr[d0]=*reinterpret_cast<const bf16x8*>(&Qw[(long)r32*LDQ+d0*16+hi*8]); }
  else{ qr[0]=qp0;qr[1]=qp1;qr[2]=qp2;qr[3]=qp3; }
  float mhat=0.f,l_reg=0.f;f32x16 o[4];o[0]=f32x16{};o[1]=f32x16{};o[2]=f32x16{};o[3]=f32x16{};const f32x16 zero16=f32x16{};
  const int qrel=wid*QBLK+r32;
  #define CMASK(P0,P1,t) do{ int jb_=(t)-(NT-4); if(jb_>=0)cmask(P0,P1,jb_,qrel,hi); }while(0)
  bool resc=false;
  #define RESC() do{ if(resc){ asm volatile("s_waitcnt lgkmcnt(0)":::"memory"); \
      _Pragma("unroll") for(int d_=0;d_<4;++d_) _Pragma("unroll") for(int r=0;r<16;++r)o[d_][r]*=wsf[crow(r,hi)]; } }while(0)
  f32x16 c0,c1; u32x4 pw0,pw1,pw2,pw3;
  int sl_prev=s0,sl_cur=s0,sl_next=s1;
  #define ROT() do{sl_prev=sl_cur;sl_cur=sl_next;sl_next=(sl_next==(NSLOT-1)*SLOTB)?0:sl_next+SLOTB;}while(0)
  if(first){DMA_K(2,s2);}
  if(first||!ATT_SKIPBAR){ WAIT_BAR(4); }
  #define PKW(P,B) cvtpk_s(P[B],P[B+1])
  qkt(c0,c1,Kbase,qr,r32,hi);asm volatile("s_nop 15\n\ts_nop 7":"+v"(c0),"+v"(c1));CMASK(c0,c1,0);
  { float dl=0.f; if constexpr(!NOREF){ const float rm=rowmax(c0,c1); dl=(rm>-1e30f)?rm:0.f; } mhat=dl;
    #pragma unroll
    for(int r=0;r<16;++r){c0[r]=__builtin_amdgcn_exp2f(c0[r]-dl);c1[r]=__builtin_amdgcn_exp2f(c1[r]-dl);}
    float sa=0.f,sb=0.f;
    #pragma unroll
    for(int r=0;r<16;++r){sa+=c0[r];sb+=c1[r];}
    l_reg=sa+sb;
    pw0=(u32x4){PKW(c0,0),PKW(c0,2),PKW(c0,4),PKW(c0,6)};pw1=(u32x4){PKW(c0,8),PKW(c0,10),PKW(c0,12),PKW(c0,14)};pw2=(u32x4){PKW(c1,0),PKW(c1,2),PKW(c1,4),PKW(c1,6)};pw3=(u32x4){PKW(c1,8),PKW(c1,10),PKW(c1,12),PKW(c1,14)}; }
  WAIT_BAR(0);
  DMA_K(3,s0);DMA_V(1,2*s1);
  ROT();
  kload8(kf,kp0+sl_cur);
  WAIT_BAR(3);
  s16x4 vlo[4],vhi[4];
  #define PAF(k) __builtin_bit_cast(bf16x8,pw##k)
  #define VFR(i) (bf16x8){vlo[i][0],vlo[i][1],vlo[i][2],vlo[i][3],vhi[i][0],vhi[i][1],vhi[i][2],vhi[i][3]}
  #define PIN(x) asm volatile("":"+v"(x))
  #define MX3(a,b,c) __builtin_fmaxf(__builtin_fmaxf((a),(b)),(c))
  #define EX(v) __builtin_amdgcn_exp2f(v)
  #define VRDX(s,KS) do{ vlo[s]=vtr(vp_+((s)*4096+(KS)*1024)); vhi[s]=vtr(vp_+((s)*4096+(KS)*1024+512)); }while(0)
  #define QKA(MF) do{ MF; SBAR(); }while(0)
  #define GAPX(MF,X,B,RF) do{ MF; RF; X[B]=EX(X[B]); X[B+1]=EX(X[B+1]); sacc+=X[B]; sacc+=X[B+1]; PIN(sacc); PIN(X); SBAR(); }while(0)
  #define PACKW(PW,W,X,B) do{ PW[W]=PKW(X,B); PIN(PW); }while(0)
  #define KRD(G,j) do{ if(G){ kload2(kf,kp0+sl_next,j); SBAR(); } }while(0)
  #define STEP(t,GL) do{ SBAR(); ATT_PRIO_A(); \
    const lds_cptr vp_=vp0+2*sl_prev; \
    VRDX(0,0); SBAR(); QKA(c0=__builtin_amdgcn_mfma_f32_32x32x16_bf16(kf[0],qr[0],zero16,0,0,0)); \
    QKA(c1=__builtin_amdgcn_mfma_f32_32x32x16_bf16(kf[1],qr[0],zero16,0,0,0)); \
    VRDX(1,0); SBAR(); QKA(c0=__builtin_amdgcn_mfma_f32_32x32x16_bf16(kf[2],qr[1],c0,0,0,0)); \
    QKA(c1=__builtin_amdgcn_mfma_f32_32x32x16_bf16(kf[3],qr[1],c1,0,0,0)); \
    VRDX(2,0); SBAR(); QKA(c0=__builtin_amdgcn_mfma_f32_32x32x16_bf16(kf[4],qr[2],c0,0,0,0)); \
    QKA(c1=__builtin_amdgcn_mfma_f32_32x32x16_bf16(kf[5],qr[2],c1,0,0,0)); \
    VRDX(3,0); SBAR(); QKA(c0=__builtin_amdgcn_mfma_f32_32x32x16_bf16(kf[6],qr[3],c0,0,0,0)); \
    QKA(c1=__builtin_amdgcn_mfma_f32_32x32x16_bf16(kf[7],qr[3],c1,0,0,0)); \
    STEP_DMA(t); \
    if constexpr(NOREF){ CMASKX(c0,c1,t); resc=false; } else { \
    asm volatile("s_nop 7\n\ts_nop 7":"+v"(c0),"+v"(c1)); \
    _Pragma("unroll") for(int r=0;r<16;++r){c0[r]=fsub_s(c0[r],mhat);c1[r]=fsub_s(c1[r],mhat);} \
    CMASKX(c0,c1,t); \
    { float a=MX3(c0[0],c0[1],c1[0]),b=MX3(c0[2],c0[3],c1[1]); a=MX3(a,c1[2],c1[3]); \
      _Pragma("unroll") for(int r=4;r<16;r+=4){a=MX3(a,c0[r],c0[r+1]);b=MX3(b,c0[r+2],c0[r+3]);a=MX3(a,c1[r],c1[r+1]);b=MX3(b,c1[r+2],c1[r+3]);} \
      float rm=__builtin_fmaxf(a,b); { auto rr=__builtin_amdgcn_permlane32_swap(__float_as_uint(rm),__float_as_uint(rm),false,false); rm=__builtin_fmaxf(__uint_as_float(rr[0]),__uint_as_float(rr[1])); } \
      resc=false; \
      if(__builtin_expect(__any(rm>(float)THRL),0)){ const float dl=__builtin_fmaxf(rm,0.f); mhat+=dl; \
        _Pragma("unroll") for(int r=0;r<16;++r){c0[r]-=dl;c1[r]-=dl;} \
        const float f=__builtin_amdgcn_exp2f(-dl); l_reg*=f; if(hi==0)wsf[r32]=f; resc=true; } } \
    } \
    SBAR(); ATT_PRIO_B(); float sacc=0.f; \
    GAPX(o[0]=__builtin_amdgcn_mfma_f32_32x32x16_bf16(PAF(0),VFR(0),o[0],0,0,0), c0,0,  VRDX(0,1)); \
    GAPX(o[1]=__builtin_amdgcn_mfma_f32_32x32x16_bf16(PAF(0),VFR(1),o[1],0,0,0), c0,2,  VRDX(1,1)); \
    GAPX(o[2]=__builtin_amdgcn_mfma_f32_32x32x16_bf16(PAF(0),VFR(2),o[2],0,0,0), c0,4,  VRDX(2,1)); \
    GAPX(o[3]=__builtin_amdgcn_mfma_f32_32x32x16_bf16(PAF(0),VFR(3),o[3],0,0,0), c0,6,  VRDX(3,1)); \
    GAPX(o[0]=__builtin_amdgcn_mfma_f32_32x32x16_bf16(PAF(1),VFR(0),o[0],0,0,0), c0,8,  VRDX(0,2)); PACKW(pw0,0,c0,0); SBAR(); \
    GAPX(o[1]=__builtin_amdgcn_mfma_f32_32x32x16_bf16(PAF(1),VFR(1),o[1],0,0,0), c0,10, VRDX(1,2)); PACKW(pw0,1,c0,2); SBAR(); \
    GAPX(o[2]=__builtin_amdgcn_mfma_f32_32x32x16_bf16(PAF(1),VFR(2),o[2],0,0,0), c0,12, VRDX(2,2)); PACKW(pw0,2,c0,4); SBAR(); \
    GAPX(o[3]=__builtin_amdgcn_mfma_f32_32x32x16_bf16(PAF(1),VFR(3),o[3],0,0,0), c0,14, VRDX(3,2)); PACKW(pw0,3,c0,6); SBAR(); \
    KRD(GL,0); GAPX(o[0]=__builtin_amdgcn_mfma_f32_32x32x16_bf16(PAF(2),VFR(0),o[0],0,0,0), c1,0,  VRDX(0,3)); PACKW(pw1,0,c0,8);  SBAR(); \
    KRD(GL,1); GAPX(o[1]=__builtin_amdgcn_mfma_f32_32x32x16_bf16(PAF(2),VFR(1),o[1],0,0,0), c1,2,  VRDX(1,3)); PACKW(pw1,1,c0,10); SBAR(); \
    KRD(GL,2); GAPX(o[2]=__builtin_amdgcn_mfma_f32_32x32x16_bf16(PAF(2),VFR(2),o[2],0,0,0), c1,4,  VRDX(2,3)); PACKW(pw1,2,c0,12); SBAR(); \
    KRD(GL,3); GAPX(o[3]=__builtin_amdgcn_mfma_f32_32x32x16_bf16(PAF(2),VFR(3),o[3],0,0,0), c1,6,  VRDX(3,3)); PACKW(pw1,3,c0,14); SBAR(); \
    GAPX(o[0]=__builtin_amdgcn_mfma_f32_32x32x16_bf16(PAF(3),VFR(0),o[0],0,0,0), c1,8,  (void)0); PACKW(pw2,0,c1,0); SBAR(); \
    GAPX(o[1]=__builtin_amdgcn_mfma_f32_32x32x16_bf16(PAF(3),VFR(1),o[1],0,0,0), c1,10, (void)0); PACKW(pw2,1,c1,2); SBAR(); \
    GAPX(o[2]=__builtin_amdgcn_mfma_f32_32x32x16_bf16(PAF(3),VFR(2),o[2],0,0,0), c1,12, (void)0); PACKW(pw2,2,c1,4); SBAR(); \
    GAPX(o[3]=__builtin_amdgcn_mfma_f32_32x32x16_bf16(PAF(3),VFR(3),o[3],0,0,0), c1,14, (void)0); PACKW(pw2,3,c1,6); SBAR(); \
    PACKW(pw3,0,c1,8); PACKW(pw3,1,c1,10); PACKW(pw3,2,c1,12); PACKW(pw3,3,c1,14); \
    l_reg+=sacc; \
    }while(0)
  int t=1;
  #define CMASKX(P0,P1,t) do{}while(0)
  #define STEP_DMA(t) DMA_K((t)+3,sl_cur); DMA_V((t)+1,2*sl_next)
  for(;t+5<NT;t+=2){
    STEP(t,true);     WAIT_BAR(3); RESC(); ROT();
    STEP(t+1,true);   WAIT_BAR(3); RESC(); ROT();
  }
  #undef CMASKX
  #undef STEP_DMA
  #define CMASKX(P0,P1,t) CMASK(P0,P1,t)
  #define STEP_DMA(t) DMA_KX((t)+3,sl_cur); DMA_VX((t)+1,2*sl_next)
#ifndef ATT_BANDSKIP
#define ATT_BANDSKIP 1
#endif
  const int jmax=ATT_BANDSKIP?(wid>>1):3;
#if ATT_BANDSKIP >= 2
  const int tlast=(jmax<2)?NT-3+jmax:NT-1;
  bool early=false;
  for(;t+1<NT;t+=2){
    if(t>tlast){ early=true; break; }
    STEP(t,(t+1<NT));       WAIT_BAR(3); RESC(); ROT();
    if(t+1>tlast){ t+=1; early=true; break; }
    STEP(t+1,(t+2<NT));     WAIT_BAR(3); RESC(); ROT();
  }
  if(!early&&tlast==NT-1){ STEP(NT-1,false); WAIT_BAR(3); RESC(); t=NT; }
  for(;t<NT;++t){ STEP_DMA(t); WAIT_BAR(3); if(t<NT-1){ ROT(); } }
#else
  for(;t+1<NT;t+=2){
    STEP(t,(t+1<NT));       WAIT_BAR(3); RESC(); ROT();
    STEP(t+1,(t+2<NT));     WAIT_BAR(3); RESC(); ROT();
  }
  if(!ATT_BANDSKIP||wid>=4){ STEP(NT-1,false); } else { STEP_DMA(NT-1); }
  WAIT_BAR(3); RESC();
#endif
  ring=sl_next;
  #undef STEP_DMA
  #undef CMASKX
  if(jmax>=3){ SBAR(); pv128(o,vb0+2*sl_cur,PAF(0),PAF(1),PAF(2),PAF(3)); }
  #undef PKW
  #undef PAF
  #undef PACKW
  #undef VFR
  #undef PIN
  #undef MX3
  #undef EX
  #undef VRDX
  #undef QKA
  #undef GAPX
  #undef KRD
  #undef STEP
  { const bf16*Qnw=Qn+(long)(qbn*QB+wid*QBLK)*LDQ;
    qp0=*reinterpret_cast<const bf16x8*>(&Qnw[(long)r32*LDQ+0*16+hi*8]); qp1=*reinterpret_cast<const bf16x8*>(&Qnw[(long)r32*LDQ+1*16+hi*8]);
    qp2=*reinterpret_cast<const bf16x8*>(&Qnw[(long)r32*LDQ+2*16+hi*8]); qp3=*reinterpret_cast<const bf16x8*>(&Qnw[(long)r32*LDQ+3*16+hi*8]); }
  {auto rr=__builtin_amdgcn_permlane32_swap(__float_as_uint(l_reg),__float_as_uint(l_reg),false,false);l_reg=__uint_as_float(rr[0])+__uint_as_float(rr[1]);}
  if(hi==0)wsf[32+r32]=l_reg;asm volatile("s_waitcnt lgkmcnt(0)":::"memory");
  float rli[16];
  #pragma unroll
  for(int r=0;r<16;++r)rli[r]=__builtin_amdgcn_rcpf(wsf[32+crow(r,hi)]);
  bf16*st=(bf16*)(shm+X_ST)+wid*4096;
  if(est==1){
    #pragma unroll
    for(int r=0;r<16;++r){const int orow=crow(r,hi);
      #pragma unroll
      for(int d0=0;d0<4;++d0)st[orow*128+d0*32+r32]=__float2bfloat16(o[d0][r]*rli[r]);} }
  else{ const float*dc=(const float*)(shm+X_DC); const float lam=dc[128];
    #pragma unroll
    for(int r=0;r<16;++r){const int orow=crow(r,hi);
      #pragma unroll
      for(int d0=0;d0<4;++d0){const int idx=orow*128+d0*32+r32; const float o1=__bfloat162float(st[idx]); st[idx]=__float2bfloat16(o1-lam*(o[d0][r]*rli[r]));}}
    asm volatile("s_waitcnt lgkmcnt(0)":::"memory");
    bf16*Ow=Og+(long)(q0+wid*QBLK)*ldo; const int ch=lane&15;
    const f32x4 ga=*(const f32x4*)(dc+ch*8),gb=*(const f32x4*)(dc+ch*8+4);
    #pragma unroll
    for(int i=0;i<8;++i){const int row=i*4+(lane>>4); const u32x4 v=*(const u32x4*)(st+row*128+ch*8);
      float dv[8];
      #pragma unroll
      for(int e=0;e<4;++e){dv[2*e]=__uint_as_float(v[e]<<16);dv[2*e+1]=__uint_as_float(v[e]&0xffff0000u);}
      float ss=0.f;
      #pragma unroll
      for(int e=0;e<8;++e)ss+=dv[e]*dv[e];
      ss+=__shfl_xor(ss,1);ss+=__shfl_xor(ss,2);ss+=__shfl_xor(ss,4);ss+=__shfl_xor(ss,8);
      const float rs=1.0f/sqrtf(ss*(1.0f/128.0f)+1e-5f);
      u32x4 w; w[0]=cvtpk_s(dv[0]*rs*ga[0],dv[1]*rs*ga[1]); w[1]=cvtpk_s(dv[2]*rs*ga[2],dv[3]*rs*ga[3]); w[2]=cvtpk_s(dv[4]*rs*gb[0],dv[5]*rs*gb[1]); w[3]=cvtpk_s(dv[6]*rs*gb[2],dv[7]*rs*gb[3]);
      ATTN_STORE16(Ow+(long)row*ldo+ch*8,w); } }
  asm volatile("s_waitcnt lgkmcnt(0)\n\ts_barrier":::"memory");
  #undef DMA_K
  #undef DMA_V
  #undef DMA_KX
  #undef DMA_VX
  #undef CMASK
  #undef RESC
  #undef ROT
}
constexpr int ATTN_LDS_BYTES=LDS_BYTES;
#undef SBAR
#undef WAIT_BAR
}
#ifndef ATT_A_MODE
#define ATT_A_MODE 1
#endif
#ifndef ATT_B_MODE
#define ATT_B_MODE 2
#endif
#ifndef ATT_THRL
#define ATT_THRL 8
#endif

constexpr int NWAVES = 8;
constexpr int BATCH = 16, T = 2048, D = 1024, HD = 64, FF = 2816, NQKV = 3072;
constexpr int M = BATCH * T;
constexpr float NORM_EPS = 1e-5f;
constexpr float LAMBDA_INIT = 0.35550906759096934f;
static_assert(M == pg8::TOK, "row count");

constexpr size_t MiB = 1u << 20;
constexpr size_t WS_CTL = 0, CTL_ZERO_BYTES = 65536;
constexpr size_t WS_ROPE = 1 * MiB;
constexpr size_t WS_SSP = 3 * MiB;
constexpr size_t WS_KMP = 5 * MiB;
constexpr size_t WS_W = 6 * MiB, W_LAYER = 25 * MiB;
constexpr size_t W_IN = 0, W_OUT = 6 * MiB, W_GU = 8 * MiB, W_DN = 19 * MiB;
constexpr size_t WS_HB = 56 * MiB;
constexpr size_t WS_OB = 120 * MiB;
constexpr size_t WS_QKV = 184 * MiB;
constexpr size_t WS_OS = 376 * MiB;
constexpr size_t WS_END = 504 * MiB;
static_assert(WS_ROPE == pg8::XWS_ROPE && WS_SSP == pg8::XWS_SSP && WS_KMP == pg8::XWS_KMP && WS_HB == pg8::XWS_HB && WS_QKV == pg8::XWS_QKV, "d_ws map vs epilogues");
constexpr int CW_BAR = 4096;
constexpr int RING_OFF = 0, RING_BYTES = 131072;
constexpr int LDSCTL_OFF = 143360, MISC_OFF = LDSCTL_OFF + 320;
constexpr int PTAB_OFF = LDSCTL_OFF + 512;
constexpr int RTAB_OFF = LDSCTL_OFF + 1024;
constexpr int LDS_BYTES = 163840;
static_assert(attn_body::X_BYTES <= LDSCTL_OFF && attn_body::DIL_LUT_OFF == RTAB_OFF && attn_body::DIL_LUT_OFF + 4 * attn_body::DIL_LUT_N <= LDS_BYTES && attn_body::ATTN_LDS_BYTES_DIFF <= RING_BYTES && RTAB_OFF + 11 * 1024 <= LDS_BYTES && MISC_OFF + 128 <= PTAB_OFF && PTAB_OFF + 160 <= RTAB_OFF, "LDS map");

#define GAS __attribute__((address_space(1)))
#define LAS __attribute__((address_space(3)))
typedef unsigned short bf16;
typedef unsigned v4u __attribute__((ext_vector_type(4)));
typedef unsigned v2u __attribute__((ext_vector_type(2)));
typedef float f32x4 __attribute__((ext_vector_type(4)));
typedef GAS unsigned gu32;
#define RLX_AGENT __ATOMIC_RELAXED, __HIP_MEMORY_SCOPE_AGENT
#define LDS_WAIT() asm volatile("s_waitcnt lgkmcnt(0)" ::: "memory")
#define VM_WAIT() asm volatile("s_waitcnt vmcnt(0)" ::: "memory")
__device__ __forceinline__ unsigned f2bf(float f) { unsigned u = __builtin_bit_cast(unsigned, f); return (u + 0x7fffu + ((u >> 16) & 1u)) >> 16; }
__device__ __forceinline__ unsigned pk2(float lo, float hi) { return f2bf(lo) | (f2bf(hi) << 16); }
__device__ __forceinline__ float bf_lo(unsigned w) { return __uint_as_float(w << 16); }
__device__ __forceinline__ float bf_hi(unsigned w) { return __uint_as_float(w & 0xffff0000u); }

#define XB_TMO      128
#define XB_XCNT(j)  (256  + 64 * (j))
#define XB_XSUB(j)  (1280 + 64 * (j))
#define XB_XGEN(j)  (2304 + 64 * (j))
#define XB_TOP      3328
#define XB_TOPGEN   3392
#define XCD_BAR_WORDS 3456
#define XB_SPIN_CAP (1u << 18)

__device__ __forceinline__ unsigned xb_ld(unsigned* p)              { return __hip_atomic_load(p, __ATOMIC_RELAXED, __HIP_MEMORY_SCOPE_AGENT); }
__device__ __forceinline__ unsigned xb_add(unsigned* p, unsigned v) { return __hip_atomic_fetch_add(p, v, __ATOMIC_RELAXED, __HIP_MEMORY_SCOPE_AGENT); }
__device__ __forceinline__ unsigned xb_xcc_id() { return (unsigned)__builtin_amdgcn_s_getreg((3 << 11) | 20) & 0xFu; }
#define XB_SPIN(cond, bar) do { unsigned _sp = 0; while (cond) { __builtin_amdgcn_s_sleep(1); \
    if ((++_sp & 255u) == 0u) { if (xb_ld(&(bar)[XB_TMO])) break; if (_sp > XB_SPIN_CAP) { atomicAdd(&(bar)[XB_TMO], 1u); break; } } } } while (0)

struct XcdBarrier {
    unsigned* bar; unsigned x;
    volatile LAS unsigned* st;
};

__device__ __forceinline__ XcdBarrier xcd_barrier_post(unsigned* bar, volatile LAS unsigned* st) {
    XcdBarrier b; b.bar = bar; b.x = xb_xcc_id(); b.st = st;
    if (threadIdx.x == 0) (void)xb_add(&bar[XB_XCNT(b.x)], 1u);
    return b;
}
__device__ __forceinline__ void xcd_barrier_complete(unsigned* bar, unsigned x, unsigned& nloc, unsigned& nx) {
    const unsigned G = gridDim.x * gridDim.y * gridDim.z;
    unsigned sum, cnt, mine, sp = 0u;
    for (;;) {
        sum = 0u; cnt = 0u; mine = 0u;
#pragma unroll
        for (unsigned j = 0; j < 16; ++j) { const unsigned c = xb_ld(&bar[XB_XCNT(j)]); sum += c; cnt += (c > 0u) ? 1u : 0u; mine = (j == x) ? c : mine; }
        if (sum == G) break;
        __builtin_amdgcn_s_sleep(1);
        if ((++sp & 255u) == 0u) { if (xb_ld(&bar[XB_TMO])) break; if (sp > XB_SPIN_CAP) { atomicAdd(&bar[XB_TMO], 1u); break; } }
    }
    nloc = mine > 0u ? mine : 1u; nx = cnt > 0u ? cnt : 1u;
}

__device__ __forceinline__ void xcd_barrier(const XcdBarrier& b) {
    asm volatile("s_waitcnt vmcnt(0)" ::: "memory");
    __syncthreads();
    if (threadIdx.x == 0) {
        unsigned* bar = b.bar;
        __builtin_amdgcn_s_waitcnt(0);
        unsigned nloc = b.st[0], nx = b.st[1];
        if (nloc == 0u) { xcd_barrier_complete(bar, b.x, nloc, nx); b.st[0] = nloc; b.st[1] = nx; }
        const unsigned old = xb_add(&bar[XB_XSUB(b.x)], 1u);
        const unsigned gen = old / nloc;
        if (old + 1u == (gen + 1u) * nloc) {
            __builtin_amdgcn_fence(__ATOMIC_RELEASE, "agent");
            asm volatile("s_waitcnt vmcnt(0)" ::: "memory");
            const unsigned og = xb_add(&bar[XB_TOP], 1u);
            const unsigned tg = og / nx;
            if (og + 1u == (tg + 1u) * nx) xb_add(&bar[XB_TOPGEN], 1u);
            else XB_SPIN(xb_ld(&bar[XB_TOPGEN]) == tg, bar);
            __builtin_amdgcn_fence(__ATOMIC_ACQUIRE, "agent");
            xb_add(&bar[XB_XGEN(b.x)], 1u);
            asm volatile("s_waitcnt vmcnt(0)" ::: "memory");
        } else {
            XB_SPIN(xb_ld(&bar[XB_XGEN(b.x)]) == gen, bar);
            __builtin_amdgcn_fence(__ATOMIC_ACQUIRE, "agent");
            asm volatile("s_waitcnt vmcnt(0)" ::: "memory");
        }
    }
    __syncthreads();
}


struct Frame {
    LAS unsigned char* lds;
    volatile LAS unsigned* MISC;
    gu32* ctl;
    int tid, lane, wave;
    int vcu, G, bx;
};
#ifndef FUSE_FINAL
#define FUSE_FINAL 1
#endif
#ifndef FIN_ST
#define FIN_ST 1
#endif
#ifndef P0_ST
#define P0_ST 0
#endif
__device__ __forceinline__ float wave_sum(float v) {
#pragma unroll
    for (int o = 1; o < 64; o <<= 1) v += __shfl_xor(v, o);
    return v;
}
__device__ __forceinline__ void p0_transpose_item(const float* W, const float* g, int K, int N, bf16* WT, int mode, LAS float* scr, int item, int lane) {
    const int nblk = N / 32, kb = item / nblk, nb = item % nblk, k0 = 64 * kb, n0 = 32 * nb;
    const int orow = (mode == 0) ? n0 : (256 * (n0 >> 7) + (n0 & 127) + (mode == 2 ? 128 : 0));
    f32x4 w[8];
#pragma unroll
    for (int i = 0; i < 8; ++i) w[i] = MEM_NT ? __builtin_nontemporal_load((const GAS f32x4*)(W + (size_t)(k0 + 8 * i + (lane >> 3)) * N + n0 + 4 * (lane & 7))) : *(const GAS f32x4*)(W + (size_t)(k0 + 8 * i + (lane >> 3)) * N + n0 + 4 * (lane & 7));
    if (g) {
#pragma unroll
        for (int i = 0; i < 8; ++i) w[i] = w[i] * g[k0 + 8 * i + (lane >> 3)];
    }
#pragma unroll
    for (int i = 0; i < 8; ++i) { LAS float* d = scr + (8 * i + (lane >> 3)) * 33 + 4 * (lane & 7); d[0] = w[i].x; d[1] = w[i].y; d[2] = w[i].z; d[3] = w[i].w; }
    LDS_WAIT(); asm volatile("" ::: "memory");
    const int c = lane & 7;
#pragma unroll
    for (int j = 0; j < 4; ++j) { const int n = (lane >> 3) + 8 * j; const LAS float* s = scr + (8 * c) * 33 + n;
        v4u o; o.x = pk2(s[0 * 33], s[1 * 33]); o.y = pk2(s[2 * 33], s[3 * 33]); o.z = pk2(s[4 * 33], s[5 * 33]); o.w = pk2(s[6 * 33], s[7 * 33]);
        if (P0_ST == 2) ST16_SC1((GAS v4u*)(WT + (size_t)(orow + n) * K + k0 + 8 * c), o); else *(GAS v4u*)(WT + (size_t)(orow + n) * K + k0 + 8 * c) = o; }
    LDS_WAIT(); asm volatile("" ::: "memory");
}

constexpr int CW_PANEL = 8192;
struct EpiFinal {
    static constexpr bool PERM = true, AFTER_DRAIN = false, PREFETCH = (RES_PF != 0); static constexpr int NSTORE = 16;
    volatile LAS unsigned* pt; LAS float* rl; unsigned* pcnt; unsigned* tmo;
    __device__ __forceinline__ void prefetch(const pg8::Unit& u, int tid, int r, LAS unsigned char* junk) const {
        const unsigned char* ws = pg8::tab_ptr(pt, 19); const int li = r * 512 + tid, row = li >> 2, seg = li & 3;
        const unsigned char* p = ws + WS_HB + ((size_t)(u.pm * pg8::BM + row) * 1024 + u.pn * pg8::BM + seg * 64) * 2;
        __builtin_amdgcn_global_load_lds((const unsigned*)p, (LAS unsigned*)junk, 4, 0, 0);
    }
    __device__ __forceinline__ void operator()(pg8::f32x4 (&acc)[2][2][4][2], const pg8::Unit& u, int wr, int wc, int fr, int fq) const {
        using pg8::u32x4; using pg8::BM; using pg8::HALF;
        unsigned char* ws = pg8::tab_ptr(pt, 19);
        const bf16* hb = (const bf16*)(ws + WS_HB); float* ssp = (float*)(ws + WS_SSP);
        const int col0 = u.pn * BM + wc * 32 + 8 * fq;
        u32x4 bw[2][4][2];
#pragma unroll
        for (int ai = 0; ai < 2; ++ai)
#pragma unroll
            for (int m = 0; m < 4; ++m) {
                const size_t off = (size_t)(u.pm * BM + ai * HALF + wr * 64 + m * 16 + fr) * 1024 + col0;
#pragma unroll
                for (int bj = 0; bj < 2; ++bj) bw[ai][m][bj] = *(const u32x4*)(hb + off + bj * HALF);
            }
#pragma unroll
        for (int ai = 0; ai < 2; ++ai)
#pragma unroll
            for (int m = 0; m < 4; ++m) {
                const int row = u.pm * BM + ai * HALF + wr * 64 + m * 16 + fr; float ss = 0.f;
#pragma unroll
                for (int bj = 0; bj < 2; ++bj) {
                    const u32x4 w0 = bw[ai][m][bj];
                    const f32x4 b0 = (f32x4){bf_lo(w0.x), bf_hi(w0.x), bf_lo(w0.y), bf_hi(w0.y)}, b1 = (f32x4){bf_lo(w0.z), bf_hi(w0.z), bf_lo(w0.w), bf_hi(w0.w)};
                    const f32x4 o0 = b0 + acc[ai][bj][m][0], o1 = b1 + acc[ai][bj][m][1];
                    ss += ((o0[0] * o0[0] + o0[1] * o0[1]) + (o0[2] * o0[2] + o0[3] * o0[3])) + ((o1[0] * o1[0] + o1[1] * o1[1]) + (o1[2] * o1[2] + o1[3] * o1[3]));
                    acc[ai][bj][m][0] = o0; acc[ai][bj][m][1] = o1;
                }
                ss += __shfl_xor(ss, 16); ss += __shfl_xor(ss, 32);
                if (fq == 0) ssp[(size_t)(u.pn * 4 + wc) * M + row] = ss;
            }
        asm volatile("s_waitcnt vmcnt(0)" ::: "memory");
        __syncthreads();
        if (threadIdx.x == 0) {
            unsigned* c = pcnt + 16 * u.pm;
            __builtin_amdgcn_fence(__ATOMIC_RELEASE, "agent");
            asm volatile("s_waitcnt vmcnt(0)" ::: "memory");
            (void)__hip_atomic_fetch_add(c, 1u, __ATOMIC_RELAXED, __HIP_MEMORY_SCOPE_AGENT);
            unsigned sp = 0u;
            while (__hip_atomic_load(c, __ATOMIC_RELAXED, __HIP_MEMORY_SCOPE_AGENT) < 4u) {
                __builtin_amdgcn_s_sleep(1);
                if ((++sp & 255u) == 0u) { if (__hip_atomic_load(tmo, __ATOMIC_RELAXED, __HIP_MEMORY_SCOPE_AGENT)) break; if (sp > (1u << 20)) { atomicAdd(tmo, 1u); break; } }
            }
            __builtin_amdgcn_fence(__ATOMIC_ACQUIRE, "agent");
            asm volatile("s_waitcnt vmcnt(0)" ::: "memory");
        }
        __syncthreads();
        { const int tid = threadIdx.x;
          if (tid < 256) { const int row = u.pm * BM + tid; float s = 0.f;
#pragma unroll
              for (int j = 0; j < 16; ++j) s += ssp[(size_t)j * M + row];
              rl[tid] = 1.0f / sqrtf(s * (1.0f / D) + NORM_EPS); }
          LDS_WAIT(); __syncthreads(); }
        float* out = (float*)pg8::tab_ptr(pt, 18); const float* gf = (const float*)pg8::tab_ptr(pt, 17);
        f32x4 g0[2], g1[2];
#pragma unroll
        for (int bj = 0; bj < 2; ++bj) { g0[bj] = *(const f32x4*)(gf + col0 + bj * HALF); g1[bj] = *(const f32x4*)(gf + col0 + bj * HALF + 4); }
#pragma unroll
        for (int ai = 0; ai < 2; ++ai)
#pragma unroll
            for (int m = 0; m < 4; ++m) {
                const int rloc = ai * HALF + wr * 64 + m * 16 + fr; const float r = rl[rloc]; float* po = out + (size_t)(u.pm * BM + rloc) * 1024 + col0;
#pragma unroll
                for (int bj = 0; bj < 2; ++bj) { __builtin_nontemporal_store(acc[ai][bj][m][0] * r * g0[bj], (f32x4*)(po + bj * HALF)); __builtin_nontemporal_store(acc[ai][bj][m][1] * r * g1[bj], (f32x4*)(po + bj * HALF + 4)); }
            }
        LDS_WAIT(); __syncthreads();
    }
};

struct Args { const void* in[18]; float* out; unsigned char* ws; };

template <class Sched> __device__ __forceinline__ void prep_rtab(Frame& F, const Sched& S, const float* ssp, int nparts) {
    LAS float* rt = (LAS float*)(F.lds + RTAB_OFF); LAS float* tmp = rt + 11 * 256;
    pg8::Unit u; int last_pm = -1; float val = 0.f;
    const int rl = F.tid & 255, hf = F.tid >> 8;
    for (int i = 0; S.next(i, u); ++i) {
        if (u.pm != last_pm) {
            last_pm = u.pm; const int row = u.pm * 256 + rl; float s = 0.f;
            if (nparts == 1) { if (hf == 0) s = ssp[row]; }
            else {
#pragma unroll
                for (int j = 0; j < 8; ++j) s += ssp[(size_t)(hf * 8 + j) * M + row];
            }
            __syncthreads();
            tmp[hf * 256 + rl] = s; LDS_WAIT(); __syncthreads();
            val = 1.0f / sqrtf((tmp[rl] + tmp[256 + rl]) * (1.0f / D) + NORM_EPS);
        }
        if ((i & 1) == hf) rt[i * 256 + rl] = val;
    }
    LDS_WAIT(); __syncthreads();
}


__device__ __forceinline__ unsigned char* get_ptr(volatile LAS unsigned* t, int k) {
    { unsigned a_ = (unsigned)(uintptr_t)t; asm volatile("" : "+v"(a_)); t = (volatile LAS unsigned*)a_; }
    const unsigned lo = (unsigned)__builtin_amdgcn_readfirstlane((int)t[2 * k]), hi = (unsigned)__builtin_amdgcn_readfirstlane((int)t[2 * k + 1]);
    unsigned long long v = (unsigned long long)lo | ((unsigned long long)hi << 32); asm volatile("" : "+s"(v)); return (unsigned char*)(GAS unsigned char*)v; }
#define PTAB ((volatile LAS unsigned*)((LAS unsigned char*)lds + PTAB_OFF))
#define IN_PTR(T, k) ((T*)get_ptr(PTAB, (k)))
#define OUT_PTR() ((float*)get_ptr(PTAB, 18))
#define WS_BASE() (get_ptr(PTAB, 19))
#define WS_PTR(T, off) ((T*)(WS_BASE() + (off)))
__device__ __forceinline__ int vcu_of(int bx, int G) { return (G % 8 == 0) ? (bx % 8) * (G / 8) + bx / 8 : bx; }
#define GRID_BAR() do { XcdBarrier b_; b_.bar = WS_PTR(unsigned, WS_CTL) + CW_BAR; b_.x = xb_xcc_id(); b_.st = (volatile LAS unsigned*)((LAS unsigned char*)lds + MISC_OFF) + 8; xcd_barrier(b_); } while (0)
__device__ __forceinline__ int opq_s(int v) { asm volatile("" : "+s"(v)); return v; }
__device__ __forceinline__ int opq_v(int v) { asm volatile("" : "+v"(v)); return v; }
#define MK_FRAME() Frame F; F.lds = (LAS unsigned char*)lds; F.MISC = (volatile LAS unsigned*)(F.lds + MISC_OFF); F.ctl = nullptr; F.tid = opq_v(threadIdx.x); F.lane = F.tid & 63; \
    F.wave = __builtin_amdgcn_readfirstlane(F.tid >> 6); F.G = opq_s(gridDim.x); F.bx = opq_s(blockIdx.x); F.vcu = vcu_of(F.bx, F.G)


#ifndef REP_P0
#define REP_P0 1
#endif
#ifndef REP_QKV
#define REP_QKV 1
#endif
#ifndef REP_ATTN0
#define REP_ATTN0 1
#endif
#ifndef REP_ATTN1
#define REP_ATTN1 1
#endif
#ifndef REP_COMB
#define REP_COMB 1
#endif
#ifndef REP_OUT0
#define REP_OUT0 1
#endif
#ifndef REP_UP
#define REP_UP 1
#endif
#define REPEAT(n) for (int rep_ = 0; rep_ < opq_s(n); ++rep_)
__global__ void __launch_bounds__(NWAVES * 64, 2) mk_fwd(Args args) {
    extern __shared__ __attribute__((aligned(16))) unsigned char lds[];
    for (int u = threadIdx.x; u < (LDS_BYTES - LDSCTL_OFF) / 4; u += NWAVES * 64) ((LAS unsigned*)((LAS unsigned char*)lds + LDSCTL_OFF))[u] = 0u;
    __syncthreads();
    if (threadIdx.x < 20) { const unsigned long long v = threadIdx.x < 18 ? (unsigned long long)args.in[threadIdx.x < 18 ? threadIdx.x : 0] : (threadIdx.x == 18 ? (unsigned long long)args.out : (unsigned long long)args.ws);
        PTAB[2 * threadIdx.x] = (unsigned)v; PTAB[2 * threadIdx.x + 1] = (unsigned)(v >> 32); }
    LDS_WAIT(); __syncthreads();
    (void)xcd_barrier_post(WS_PTR(unsigned, WS_CTL) + CW_BAR, (volatile LAS unsigned*)((LAS unsigned char*)lds + MISC_OFF) + 8);

#ifndef SKIP_P0
    REPEAT(REP_P0) {
        MK_FRAME();
        unsigned char* ws = WS_BASE();
        const int gw = F.vcu * NWAVES + F.wave, NGW = F.G * NWAVES;
        LAS float* scr = (LAS float*)(F.lds + RING_OFF + F.wave * 16384);
        constexpr int I_IN = (D / 64) * (NQKV / 32), I_OUT = (D / 64) * (D / 32), I_G = (D / 64) * (FF / 32), I_D = (FF / 64) * (D / 32);
        constexpr int I_LAYER = I_IN + I_OUT + 2 * I_G + I_D, NITEMS = 2 * I_LAYER;
        for (int it = gw; it < NITEMS; it += NGW) {
            const int L = it / I_LAYER; int r = it % I_LAYER;
            unsigned char* wl = ws + WS_W + (size_t)L * W_LAYER;
            const float* ffn_g = IN_PTR(const float, 13) + (size_t)L * D;
            if (r < I_IN) { p0_transpose_item(IN_PTR(const float, L ? 6 : 3), IN_PTR(const float, L ? 5 : 2), D, NQKV, (bf16*)(wl + W_IN), 0, scr, r, F.lane); continue; } r -= I_IN;
            if (r < I_OUT) { p0_transpose_item(IN_PTR(const float, L ? 7 : 4), nullptr, D, D, (bf16*)(wl + W_OUT), 0, scr, r, F.lane); continue; } r -= I_OUT;
            if (r < I_G) { p0_transpose_item(IN_PTR(const float, 14) + (size_t)L * D * FF, ffn_g, D, FF, (bf16*)(wl + W_GU), 1, scr, r, F.lane); continue; } r -= I_G;
            if (r < I_G) { p0_transpose_item(IN_PTR(const float, 15) + (size_t)L * D * FF, ffn_g, D, FF, (bf16*)(wl + W_GU), 2, scr, r, F.lane); continue; } r -= I_G;
            p0_transpose_item(IN_PTR(const float, 16) + (size_t)L * FF * D, nullptr, FF, D, (bf16*)(wl + W_DN), 0, scr, r, F.lane);
        }
        const float* x = IN_PTR(const float, 0);
        bf16* HB = (bf16*)(ws + WS_HB); float* ssp = (float*)(ws + WS_SSP);
#ifndef P0_ADJ
#define P0_ADJ 0
#endif
        for (int m0 = P0_ADJ ? 2 * gw : gw; m0 < M; m0 += 2 * NGW) {
            f32x4 v[2][4];
#pragma unroll
            for (int q = 0; q < 2; ++q) { const int mq = P0_ADJ ? ((m0 + q < M) ? m0 + q : m0) : ((m0 + q * NGW < M) ? m0 + q * NGW : m0); const GAS f32x4* xr = (const GAS f32x4*)(x + (size_t)mq * D) + F.lane;
#pragma unroll
                for (int j = 0; j < 4; ++j) v[q][j] = MEM_NT ? __builtin_nontemporal_load(xr + 64 * j) : xr[64 * j]; }
#pragma unroll
            for (int q = 0; q < 2; ++q) { const int m = P0_ADJ ? ((m0 + q < M) ? m0 + q : m0) : ((m0 + q * NGW < M) ? m0 + q * NGW : m0); float s = 0.f;
#pragma unroll
                for (int j = 0; j < 4; ++j) s += (v[q][j].x * v[q][j].x + v[q][j].y * v[q][j].y) + (v[q][j].z * v[q][j].z + v[q][j].w * v[q][j].w);
                s = wave_sum(s);
                GAS unsigned long long* o8 = (GAS unsigned long long*)(HB + (size_t)m * D) + F.lane;
#pragma unroll
                for (int j = 0; j < 4; ++j) { const unsigned long long pv = (unsigned long long)pk2(v[q][j].x, v[q][j].y) | ((unsigned long long)pk2(v[q][j].z, v[q][j].w) << 32); if (P0_ST == 2) ST8_SC1(o8 + 64 * j, pv); else if (P0_ST == 1) __builtin_nontemporal_store(pv, o8 + 64 * j); else o8[64 * j] = pv; }
                if (F.lane == 0) ssp[m] = s; }
        }
        const int* pos = IN_PTR(const int, 1); float* rope = (float*)(ws + WS_ROPE);
        for (int idx = gw * 64 + F.lane; idx < M * 8; idx += NGW * 64) {
            const int row = idx >> 3, i = idx & 7;
            const float invf = i == 0 ? 1.0f : i == 1 ? 0.1939227432012558f : i == 2 ? 0.03760603070259094f : i == 3 ? 0.007292664609849453f :
                               i == 4 ? 0.0014142135623842478f : i == 5 ? 0.00027424818836152554f : i == 6 ? 5.3182957344688475e-05f : 1.0313385246263351e-05f;
            const float ang = (float)pos[row] * invf;
            float sn, cs; sincosf(ang, &sn, &cs);
            rope[(size_t)row * 16 + i] = cs; rope[(size_t)row * 16 + 8 + i] = sn;
        }
    }
#endif
    GRID_BAR();

#pragma unroll 1
    for (int L = 0; L < 2; ++L) {
#ifndef SKIP_QKV
        REPEAT(REP_QKV) {
            MK_FRAME();
            unsigned char* ws = WS_BASE();
            pg8::Gemm g{(const bf16*)(ws + WS_HB), (const bf16*)(ws + WS_W + (size_t)L * W_LAYER + W_IN), M, NQKV, D}; pg8::StaticOrder S; S.init(M, NQKV, F.G, F.bx);
            prep_rtab(F, S, (const float*)(ws + WS_SSP), L == 0 ? 1 : 16);
            pg8::EpiQKV E{PTAB, (const LAS float*)(F.lds + RTAB_OFF), L == 0 ? 0x3CFu : 0xFFu, L == 0 ? 0xC3u : 0x0Fu, L == 0 ? 0x300u : 0u, attn_body::C2};
            pg8::gemm_phase<pg8::EpiQKV, pg8::StaticOrder, PG8_ALIGN, PG8_SP2>(F.lds + RING_OFF, g, S, E);
        }
#endif
        GRID_BAR();
        if (L == 0) {
#ifndef SKIP_ATTN0
            const int G = opq_s(gridDim.x);
            {
                LAS float* lut = (LAS float*)((LAS unsigned char*)lds + RING_OFF + attn_body::DIL_LUT_OFF);
#pragma clang loop vectorize(disable) unroll(disable)
                for (int i = opq_v(threadIdx.x); i < attn_body::DIL_LUT_N; i += NWAVES * 64) ((volatile LAS float*)lut)[i] = attn_body::dil_bias(opq_v(i) - 256);
                LDS_WAIT(); __syncthreads();
            }
            REPEAT(REP_ATTN0) for (int it = vcu_of(opq_s(blockIdx.x), G); it < 256; it += G) {
                const int p = it >> 1, par = it & 1, b = p >> 3, hh = p & 7;
                int ring = 0, first = 1;
                attn_body::bf16x8 qp0 = {}, qp1 = {}, qp2 = {}, qp3 = {};
#pragma unroll 1
                for (int k = 0; k < 4; ++k) {
                    const int qb = par == 0 ? (k == 0 ? 7 : k == 1 ? 4 : k == 2 ? 3 : 0) : (k == 0 ? 6 : k == 1 ? 5 : k == 2 ? 2 : 1);
                    const int k1 = k < 3 ? k + 1 : 3, qb1 = par == 0 ? (k1 == 0 ? 7 : k1 == 1 ? 4 : k1 == 2 ? 3 : 0) : (k1 == 0 ? 6 : k1 == 1 ? 5 : k1 == 2 ? 2 : 1);
                    {
                        const attn_body::bf16* qkvb = WS_PTR(const attn_body::bf16, WS_QKV) + (size_t)b * T * NQKV + 64 * hh;
                        attn_body::bf16* ob = WS_PTR(attn_body::bf16, WS_OB) + (size_t)b * T * D + 64 * hh;
                        attn_body::attn_unit<ATT_A_MODE, ATT_THRL>(qb, qkvb, 0, 512, 1024, ob, D, nullptr, (char*)lds + RING_OFF, 0, 2048, 2560, first, ring, 1536, qb, qp0, qp1, qp2, qp3);
                        first = 0;
                    }
                    {
                        const attn_body::bf16* qkvb = WS_PTR(const attn_body::bf16, WS_QKV) + (size_t)b * T * NQKV + 64 * hh;
                        attn_body::bf16* ob = WS_PTR(attn_body::bf16, WS_OB) + (size_t)b * T * D + 64 * hh;
                        const float* km0 = WS_PTR(const float, WS_KMP) + (size_t)(b * 8) * 512 + 64 * hh;
                        attn_body::attn_unit<ATT_B_MODE, ATT_THRL>(qb, qkvb, 1536, 2048, 2560, ob + 512, D, km0, (char*)lds + RING_OFF, 0, 512, 1024, 0, ring, 0, qb1, qp0, qp1, qp2, qp3);
                    }
                }
                VM_WAIT(); __syncthreads();
            }
#ifdef XABL
            for (int it = vcu_of(opq_s(blockIdx.x), G); it < 256; it += G) {
                const int p = it >> 1, b = p >> 3, hh = p & 7;
                int ring = 0; attn_body::bf16x8 qp0 = {}, qp1 = {}, qp2 = {}, qp3 = {};
#pragma unroll 1
                for (int k = 0; k < 8; ++k) {
                    const attn_body::bf16* qkvb = WS_PTR(const attn_body::bf16, WS_QKV) + (size_t)b * T * NQKV + 64 * hh;
                    attn_body::bf16* osb = WS_PTR(attn_body::bf16, WS_OS) + (size_t)b * T * 2048 + 64 * hh;
                    attn_body::attn_unit<0, 8, XABL>(7, qkvb, 0, 512, 1024, osb, 2048, nullptr, (char*)lds + RING_OFF, 0, 512, 1024, k == 0 ? 1 : 0, ring, 0, 7, qp0, qp1, qp2, qp3);
                }
                VM_WAIT(); __syncthreads();
            }
#endif
#endif
        } else {
#ifndef SKIP_ATTN1
            const int G = opq_s(gridDim.x);
            {
                LAS float* dc = (LAS float*)((LAS unsigned char*)lds + RING_OFF + attn_body::X_DC);
                const int tid = opq_v(threadIdx.x);
                if (tid < 128) dc[tid] = IN_PTR(const float, 12)[tid] * (1.0f - LAMBDA_INIT);
                if (tid < 64) {
                    const float s1 = wave_sum(IN_PTR(const float, 8)[tid] * IN_PTR(const float, 9)[tid]), s2 = wave_sum(IN_PTR(const float, 10)[tid] * IN_PTR(const float, 11)[tid]);
                    if (tid == 0) dc[128] = expf(s1) - expf(s2) + LAMBDA_INIT;
                }
                LDS_WAIT(); __syncthreads();
            }
            REPEAT(REP_ATTN1) for (int it = vcu_of(opq_s(blockIdx.x), G); it < 256; it += G) {
                const int p = it >> 1, par = it & 1, b = p >> 3, h = p & 7;
                int ring = 0; attn_body::bf16x8 qp0 = {}, qp1 = {}, qp2 = {}, qp3 = {};
#pragma unroll 1
                for (int k = 0; k < 8; ++k) {
                    const int kq = k >> 1, i = k & 1, in_ = (k + 1) & 1;
                    const int qb = par == 0 ? (kq == 0 ? 7 : kq == 1 ? 4 : kq == 2 ? 3 : 0) : (kq == 0 ? 6 : kq == 1 ? 5 : kq == 2 ? 2 : 1);
                    const int kqn = (k < 7 ? k + 1 : 7) >> 1, qbn = par == 0 ? (kqn == 0 ? 7 : kqn == 1 ? 4 : kqn == 2 ? 3 : 0) : (kqn == 0 ? 6 : kqn == 1 ? 5 : kqn == 2 ? 2 : 1);
                    const attn_body::bf16* qkvb = WS_PTR(const attn_body::bf16, WS_QKV) + (size_t)b * T * NQKV;
                    attn_body::bf16* ob = WS_PTR(attn_body::bf16, WS_OB) + (size_t)b * T * D + 128 * h;
                    attn_body::attn_unit_dv128<ATT_THRL>(qb, qkvb, 64 * (2 * h + i), 1024 + 64 * (2 * h + i), 2048 + 128 * h, ob, D, (char*)lds + RING_OFF, i == 0 ? 1 : 3,
                                                  1024 + 64 * (2 * h + in_), k == 0 ? 1 : 0, ring, 64 * (2 * h + in_), qbn, qp0, qp1, qp2, qp3);
                }
                VM_WAIT(); __syncthreads();
            }
#endif
        }
        GRID_BAR();
#ifndef SKIP_OUT
        {
            MK_FRAME();
            unsigned char* ws = WS_BASE();
            pg8::Gemm g{(const bf16*)(ws + WS_OB), (const bf16*)(ws + WS_W + (size_t)L * W_LAYER + W_OUT), M, D, D}; pg8::StaticOrder S; S.init(M, D, F.G, F.bx);
            pg8::EpiResid E{PTAB};
            pg8::gemm_phase<pg8::EpiResid, pg8::StaticOrder, PG8_ALIGN, PG8_SP2>(F.lds + RING_OFF, g, S, E);
        }
#endif
#ifndef XEPI
#define XEPI 1
#endif
#ifdef XOUT
        for (int xr = 0; xr < opq_s(XOUT); ++xr) {
            GRID_BAR();
            MK_FRAME();
            unsigned char* ws = WS_BASE();
            pg8::Gemm g{(const bf16*)(ws + WS_OB), (const bf16*)(ws + WS_W + (size_t)L * W_LAYER + W_OUT), M, D, D}; pg8::StaticOrder S; S.init(M, D, F.G, F.bx);
            pg8::EpiResidT<XEPI> E{PTAB};
            pg8::gemm_phase<pg8::EpiResidT<XEPI>, pg8::StaticOrder, PG8_ALIGN, PG8_SP2>(F.lds + RING_OFF, g, S, E);
        }
#endif
#ifdef XDOWN
        for (int xr = 0; xr < opq_s(XDOWN); ++xr) {
            GRID_BAR();
            MK_FRAME();
            unsigned char* ws = WS_BASE();
            pg8::Gemm g{(const bf16*)(ws + WS_QKV), (const bf16*)(ws + WS_W + (size_t)L * W_LAYER + W_DN), M, D, FF}; pg8::StaticOrder S; S.init(M, D, F.G, F.bx);
            pg8::EpiResidT<XEPI> E{PTAB};
            pg8::gemm_phase<pg8::EpiResidT<XEPI>, pg8::StaticOrder, PG8_ALIGN, PG8_SP2>(F.lds + RING_OFF, g, S, E);
        }
#endif
        GRID_BAR();
#ifndef SKIP_UP
        REPEAT(REP_UP) {
            MK_FRAME();
            unsigned char* ws = WS_BASE();
            pg8::Gemm g{(const bf16*)(ws + WS_HB), (const bf16*)(ws + WS_W + (size_t)L * W_LAYER + W_GU), M, 2 * FF, D}; pg8::StaticOrder S; S.init(M, 2 * FF, F.G, F.bx);
            prep_rtab(F, S, (const float*)(ws + WS_SSP), 16);
            pg8::EpiSwiGLU E{PTAB, (const LAS float*)(F.lds + RTAB_OFF)};
            pg8::gemm_phase<pg8::EpiSwiGLU, pg8::StaticOrder, PG8_ALIGN, PG8_SP2>(F.lds + RING_OFF, g, S, E);
        }
#endif
        GRID_BAR();
#ifndef SKIP_DOWN
        {
            MK_FRAME();
            unsigned char* ws = WS_BASE();
            pg8::Gemm g{(const bf16*)(ws + WS_QKV), (const bf16*)(ws + WS_W + (size_t)L * W_LAYER + W_DN), M, D, FF}; pg8::StaticOrder S; S.init(M, D, F.G, F.bx);
#if FUSE_FINAL
            static_assert(PG8_ALIGN, "EpiFinal has workgroup barriers inside the epilogue");
            if (L == 1) {
                unsigned* c_ = WS_PTR(unsigned, WS_CTL);
                EpiFinal E{PTAB, (LAS float*)(F.lds + RTAB_OFF), c_ + CW_PANEL, c_ + CW_BAR + XB_TMO};
                pg8::gemm_phase<EpiFinal, pg8::StaticOrder, PG8_ALIGN, PG8_SP2>(F.lds + RING_OFF, g, S, E);
            } else
#endif
            {
            pg8::EpiResid E{PTAB};
            pg8::gemm_phase<pg8::EpiResid, pg8::StaticOrder, PG8_ALIGN, PG8_SP2>(F.lds + RING_OFF, g, S, E);
            }
        }
#endif
        if (!FUSE_FINAL || L == 0) GRID_BAR();
    }
#if !defined(SKIP_FINAL) && !FUSE_FINAL
    {
        MK_FRAME();
        unsigned char* ws = WS_BASE();
        const int gw = F.vcu * NWAVES + F.wave, NGW = F.G * NWAVES;
        float* out = OUT_PTR();
        const bf16* HB = (const bf16*)(ws + WS_HB); const float* ssp = (const float*)(ws + WS_SSP);
        const float* gf = IN_PTR(const float, 17);
        f32x4 gv[2][2];
#pragma unroll
        for (int j = 0; j < 2; ++j) { gv[j][0] = *(const GAS f32x4*)(gf + 512 * j + 8 * F.lane); gv[j][1] = *(const GAS f32x4*)(gf + 512 * j + 8 * F.lane + 4); }
        for (int m = gw; m < M; m += NGW) {
            float s = 0.f;
#pragma unroll
            for (int j = 0; j < 16; ++j) s += ssp[(size_t)j * M + m];
            const float rs = 1.0f / sqrtf(s * (1.0f / D) + NORM_EPS);
#pragma unroll
            for (int j = 0; j < 2; ++j) {
                const v4u w = MEM_NT ? __builtin_nontemporal_load((const GAS v4u*)(HB + (size_t)m * D + 512 * j + 8 * F.lane)) : *(const GAS v4u*)(HB + (size_t)m * D + 512 * j + 8 * F.lane);
                const f32x4 a = (f32x4){bf_lo(w.x), bf_hi(w.x), bf_lo(w.y), bf_hi(w.y)}, b = (f32x4){bf_lo(w.z), bf_hi(w.z), bf_lo(w.w), bf_hi(w.w)};
                GAS f32x4* po = (GAS f32x4*)(out + (size_t)m * D + 512 * j + 8 * F.lane);
                if (FIN_ST == 2) { const f32x4 o0 = a * rs * gv[j][0], o1 = b * rs * gv[j][1]; ST16_SC1(po, o0); ST16_SC1(po + 1, o1); } else if (FIN_ST) { __builtin_nontemporal_store(a * rs * gv[j][0], po); __builtin_nontemporal_store(b * rs * gv[j][1], po + 1); } else { po[0] = a * rs * gv[j][0]; po[1] = b * rs * gv[j][1]; }
            }
        }
    }
#endif
}

extern "C" void kernel_launch(void* const* d_in, const int* in_sizes, int n_in, void* d_out, int out_size, void* d_ws, size_t ws_size, hipStream_t stream) {
    static int grid = 0;
    if (grid == 0) {
        if (n_in != 18 || in_sizes[0] != M * D || out_size != M * D || ws_size < WS_END) { fprintf(stderr, "kernel_launch: unexpected problem shape / workspace (n_in %d, in0 %d, out %d, ws %zu)\n", n_in, n_in > 0 ? in_sizes[0] : -1, out_size, ws_size); grid = -1; return; }
        int dev = 0, cus = 0, per_cu = 0;
        if (hipGetDevice(&dev) != hipSuccess || hipDeviceGetAttribute(&cus, hipDeviceAttributeMultiprocessorCount, dev) != hipSuccess) { grid = -1; return; }
        if (hipFuncSetAttribute((const void*)mk_fwd, hipFuncAttributeMaxDynamicSharedMemorySize, LDS_BYTES) != hipSuccess) { fprintf(stderr, "kernel_launch: hipFuncSetAttribute failed\n"); grid = -1; return; }
        if (hipOccupancyMaxActiveBlocksPerMultiprocessor(&per_cu, (const void*)mk_fwd, NWAVES * 64, LDS_BYTES) != hipSuccess || per_cu < 1) { fprintf(stderr, "kernel_launch: occupancy query says %d blocks per CU\n", per_cu); per_cu = 1; }
        (void)hipGetLastError();
        grid = cus;
    }
    if (grid < 0) return;
    if (hipMemsetAsync((char*)d_ws + WS_CTL, 0, CTL_ZERO_BYTES, stream) != hipSuccess) { fprintf(stderr, "kernel_launch: hipMemsetAsync failed\n"); return; }
    Args a{};
    for (int i = 0; i < 18; ++i) a.in[i] = d_in[i];
    a.out = (float*)d_out; a.ws = (unsigned char*)d_ws;
    hipLaunchKernelGGL(mk_fwd, dim3(grid), dim3(NWAVES * 64), LDS_BYTES, stream, a);
}
```

```cpp
#include <hip/hip_runtime.h>
#include <hip/hip_bf16.h>
#include <cstdio>
#include <cstdint>
#include <cmath>
namespace pg8 {
#define PG8_LAS __attribute__((address_space(3)))
typedef unsigned short bf16_t;
typedef short bf16x8 __attribute__((ext_vector_type(8)));
typedef float f32x4 __attribute__((ext_vector_type(4)));
typedef unsigned u32x4 __attribute__((ext_vector_type(4)));
typedef unsigned u32x2 __attribute__((ext_vector_type(2)));
#ifndef PG8_WGM
#define PG8_WGM 8
#endif
constexpr int BM = 256, BK = 64, HALF = 128, HTB = HALF * BK * 2  , STAGE_BYTES = 8 * HTB, NXCD = 8, WGM = PG8_WGM;

__host__ __device__ __forceinline__ int lds_byte(int r, int c) { const int st = (r >> 4) * 2 + (c >> 5), rr = r & 15, cc = c & 31, ob = rr * 64 + cc * 2; return st * 1024 + (ob ^ (((ob >> 9) & 1) << 5)); }
__host__ __device__ __forceinline__ void stage_rc(int b, int& R, int& C) { const int st = b / 1024, sb = b % 1024, swz = sb ^ (((sb >> 9) & 1) << 5); R = (st >> 1) * 16 + swz / 64; C = (st & 1) * 32 + (swz % 64) / 2; }
__host__ __device__ __forceinline__ int perm32(int rho) { const int n = rho >> 4, i = rho & 15; return 8 * (i >> 2) + 4 * n + (i & 3); }

struct Unit { int pm, pn, idx; };
struct Gemm { const bf16_t* A; const bf16_t* Bt; int M, N, K; int lda = 0, ldb = 0; };

struct StaticOrder {
    int nM, nN, nwg, G, c;
    __host__ __device__ void init(int M, int N, int G_, int c_) { nM = M / BM; nN = N / BM; nwg = nM * nN; G = G_; c = c_; }
    __host__ __device__ bool next(int i, Unit& u) const {
        const long L = (long)i * G + c; if (L >= nwg) return false;
        int wgid = (int)L; { const int q = nwg / NXCD, r = nwg % NXCD, xcd = wgid % NXCD, off = wgid / NXCD; wgid = (xcd < r ? xcd * (q + 1) : r * (q + 1) + (xcd - r) * q) + off; }
        const int nig = WGM * nN, gid = wgid / nig, fm = gid * WGM, gsz = (nM - fm) < WGM ? (nM - fm) : WGM;
        u.pm = fm + ((wgid % nig) % gsz); u.pn = (wgid % nig) / gsz; u.idx = i; return true;
    }
    __device__ __forceinline__ void a_ready(const Unit&) const {}
    __device__ __forceinline__ void done(const Unit&) const {}
};

__device__ __forceinline__ unsigned cvt_pk_bf16(float lo, float hi) { unsigned r; asm volatile("v_cvt_pk_bf16_f32 %0, %1, %2" : "=v"(r) : "v"(lo), "v"(hi)); return r; }

constexpr int TOK = 32768;
__device__ __forceinline__ unsigned char* tab_ptr(volatile PG8_LAS unsigned* t, int k) {
    { unsigned a_ = (unsigned)(uintptr_t)t; asm volatile("" : "+v"(a_)); t = (volatile PG8_LAS unsigned*)a_; }
    const unsigned lo = (unsigned)__builtin_amdgcn_readfirstlane((int)t[2 * k]), hi = (unsigned)__builtin_amdgcn_readfirstlane((int)t[2 * k + 1]);
    unsigned long long v = (unsigned long long)lo | ((unsigned long long)hi << 32); asm volatile("" : "+s"(v)); return (unsigned char*)(__attribute__((address_space(1))) unsigned char*)v; }
constexpr size_t XWS_ROPE = (size_t)1 << 20, XWS_SSP = (size_t)3 << 20, XWS_KMP = (size_t)5 << 20, XWS_HB = (size_t)56 << 20, XWS_QKV = (size_t)184 << 20;

#ifndef EPI_NT
#define EPI_NT 2
#endif

#ifndef MEM_NT
#define MEM_NT 1
#endif
#define ST16_SC1(p, v) asm volatile("global_store_dwordx4 %0, %1, off sc1\n\ts_nop 1" :: "v"(p), "v"(v) : "memory")
#define ST8_SC1(p, v) asm volatile("global_store_dwordx2 %0, %1, off sc1\n\ts_nop 1" :: "v"(p), "v"(v) : "memory")
#ifndef PG8_AUX_A
#define PG8_AUX_A 0
#endif
#ifndef PG8_AUX_B
#define PG8_AUX_B 0
#endif
#ifndef PG8_MMA_ORDER
#define PG8_MMA_ORDER 4
#endif
#ifndef PG8_MMA_PAIR
#define PG8_MMA_PAIR 0
#endif
#ifndef PG8_NOPRIO
#define PG8_NOPRIO 0
#endif
#ifndef EPI_ZERO
#define EPI_ZERO 0
#endif
#ifndef PG8_ZERO64
#define PG8_ZERO64 1
#endif
#ifndef PG8_WC_ROT
#define PG8_WC_ROT 0
#endif
#ifndef ACT_LD
#define ACT_LD 3072
#endif
#ifndef PG8_RELAX
#define PG8_RELAX 0
#endif
#ifndef RES_PF
#define RES_PF 1
#endif
#ifndef RES_LD
#define RES_LD 0
#endif
#ifndef EPI_QKV
#define EPI_QKV EPI_NT
#endif
#ifndef EPI_UP
#define EPI_UP 1
#endif
#ifndef EPI_RES
#define EPI_RES EPI_NT
#endif
template <int MODE> __device__ __forceinline__ void epi_st(void* p, const u32x4& v) {
    if constexpr (MODE == 2) asm volatile("global_store_dwordx4 %0, %1, off sc1\n\ts_nop 1" :: "v"((u32x4*)p), "v"(v) : "memory");
    else if constexpr (MODE == 3) asm volatile("global_store_dwordx4 %0, %1, off sc1 nt\n\ts_nop 1" :: "v"((u32x4*)p), "v"(v) : "memory");
    else if constexpr (MODE == 4) asm volatile("global_store_dwordx4 %0, %1, off sc0 sc1\n\ts_nop 1" :: "v"((u32x4*)p), "v"(v) : "memory");
    else if constexpr (MODE == 1) __builtin_nontemporal_store(v, (u32x4*)p);
    else *(u32x4*)p = v;
}
struct EpiQKV {
    static constexpr bool PERM = true, AFTER_DRAIN = false, PREFETCH = false; static constexpr int NSTORE = 16;
    volatile PG8_LAS unsigned* pt; const PG8_LAS float* rt; unsigned ropemask, qmask, kmmask; float qscale;
    __device__ __forceinline__ void operator()(f32x4 (&acc)[2][2][4][2], const Unit& u, int wr, int wc, int fr, int fq) const {
        unsigned char* ws = tab_ptr(pt, 19); bf16_t* O = (bf16_t*)(ws + XWS_QKV); const float* rope = (const float*)(ws + XWS_ROPE); float* kmp = (float*)(ws + XWS_KMP);
        const bool do_rope = (((ropemask >> u.pn) & 1u) != 0u) && ((wc & 1) == 0);
        const bool do_km = ((kmmask >> u.pn) & 1u) != 0u;
        const float sc = ((qmask >> u.pn) & 1u) ? qscale : 1.f;
        const int col0 = u.pn * BM + wc * 32 + 8 * fq;
        const float sgn = (fq == 0) ? -1.f : 1.f;
        f32x4 cs[2][2];
#pragma unroll
        for (int bj = 0; bj < 2; ++bj)
#pragma unroll
            for (int n = 0; n < 2; ++n) cs[bj][n] = (f32x4){0.f, 0.f, 0.f, 0.f};
#pragma unroll
        for (int ai = 0; ai < 2; ++ai) {
            f32x4 cc[4][2], sn[4][2];
            if (do_rope) {
#pragma unroll
                for (int m = 0; m < 4; ++m) { const f32x4* rp = (const f32x4*)(rope + (size_t)(u.pm * BM + ai * HALF + wr * 64 + m * 16 + fr) * 16);
                    cc[m][0] = rp[0]; cc[m][1] = rp[1]; sn[m][0] = rp[2]; sn[m][1] = rp[3]; }
            }
#pragma unroll
            for (int m = 0; m < 4; ++m) {
                const int rl = ai * HALF + wr * 64 + m * 16 + fr; const int row = u.pm * BM + rl;
                const float r = rt[u.idx * BM + rl];
                f32x4 v[2][2];
#pragma unroll
                for (int bj = 0; bj < 2; ++bj)
#pragma unroll
                    for (int n = 0; n < 2; ++n) { v[bj][n] = acc[ai][bj][m][n] * r; if (EPI_ZERO) { float z_ = 0.f; asm volatile("" : "+v"(z_)); acc[ai][bj][m][n] = (f32x4){z_, z_, z_, z_}; } }
                if (do_rope) {
#pragma unroll
                    for (int bj = 0; bj < 2; ++bj)
#pragma unroll
                        for (int n = 0; n < 2; ++n)
#pragma unroll
                            for (int e = 0; e < 4; ++e) {
                                const float p = __shfl_xor(v[bj][n][e], 16);
                                const float rot = v[bj][n][e] * cc[m][n][e] + sgn * p * sn[m][n][e];
                                if (fq < 2) v[bj][n][e] = rot;
                            }
                }
                if (do_km) {
#pragma unroll
                    for (int bj = 0; bj < 2; ++bj)
#pragma unroll
                        for (int n = 0; n < 2; ++n) cs[bj][n] += v[bj][n];
                }
                bf16_t* rowp = O + (size_t)row * 3072 + col0;
#pragma unroll
                for (int bj = 0; bj < 2; ++bj) { const f32x4 v0 = v[bj][0] * sc, v1 = v[bj][1] * sc;
                    u32x4 w; w.x = cvt_pk_bf16(v0[0], v0[1]); w.y = cvt_pk_bf16(v0[2], v0[3]); w.z = cvt_pk_bf16(v1[0], v1[1]); w.w = cvt_pk_bf16(v1[2], v1[3]);
                    epi_st<EPI_QKV>(rowp + bj * HALF, w); }
            }
        }
        if (do_km) {
#pragma unroll
            for (int bj = 0; bj < 2; ++bj)
#pragma unroll
                for (int n = 0; n < 2; ++n)
#pragma unroll
                    for (int e = 0; e < 4; ++e) { float s = cs[bj][n][e]; s += __shfl_xor(s, 1); s += __shfl_xor(s, 2); s += __shfl_xor(s, 4); s += __shfl_xor(s, 8); cs[bj][n][e] = s; }
            if (fr == 0) {
                float* kp = kmp + ((size_t)wr * 128 + u.pm) * 512 + (u.pn - 8) * BM + wc * 32 + 8 * fq;
#pragma unroll
                for (int bj = 0; bj < 2; ++bj)
#pragma unroll
                    for (int n = 0; n < 2; ++n) *(f32x4*)(kp + bj * HALF + 4 * n) = cs[bj][n];
            }
        }
    }
};

template <int SCR>
struct EpiResidT {
    static constexpr bool PERM = true, AFTER_DRAIN = false, PREFETCH = (RES_PF != 0); static constexpr int NSTORE = 16;
    volatile PG8_LAS unsigned* pt;
    __device__ __forceinline__ void prefetch(const Unit& u, int tid, int r, PG8_LAS unsigned char* junk) const {
        const unsigned char* ws = tab_ptr(pt, 19); const int li = r * 512 + tid, row = li >> 2, seg = li & 3;
        const unsigned char* p = ws + (SCR ? ((size_t)376 << 20) : XWS_HB) + ((size_t)(u.pm * BM + row) * 1024 + u.pn * BM + seg * 64) * 2;
        __builtin_amdgcn_global_load_lds((const unsigned*)p, (PG8_LAS unsigned*)junk, 4, 0, 0);
    }
    __device__ __forceinline__ void operator()(f32x4 (&acc)[2][2][4][2], const Unit& u, int wr, int wc, int fr, int fq) const {
        unsigned char* ws = tab_ptr(pt, 19);
        bf16_t* hb = (bf16_t*)(ws + (SCR ? ((size_t)376 << 20) : XWS_HB)); float* ssp = (float*)(ws + (SCR ? ((size_t)440 << 20) : XWS_SSP));
        const int ln_ = fr + 16 * fq, frx = (SCR == 5) ? (ln_ >> 3) : fr, bjs = (SCR == 5) ? 8 * 1024 : HALF;
        const int col0 = (SCR == 5) ? u.pn * BM + wc * 64 + 8 * (ln_ & 7) : u.pn * BM + wc * 32 + 8 * fq;
        u32x4 bw[2][4][2];
#pragma unroll
        for (int ai = 0; ai < 2; ++ai)
#pragma unroll
            for (int m = 0; m < 4; ++m) {
                const size_t off = (size_t)(u.pm * BM + ai * HALF + wr * 64 + m * 16 + frx) * 1024 + col0;
#pragma unroll
                for (int bj = 0; bj < 2; ++bj) { if constexpr (SCR == 2 || SCR == 4) bw[ai][m][bj] = (u32x4){0u, 0u, 0u, 0u}; else bw[ai][m][bj] = RES_LD ? __builtin_nontemporal_load((const u32x4*)(hb + off + bj * HALF)) : *(const u32x4*)(hb + off + bj * bjs); }
            }
#pragma unroll
        for (int ai = 0; ai < 2; ++ai)
#pragma unroll
            for (int m = 0; m < 4; ++m) {
                const int row = u.pm * BM + ai * HALF + wr * 64 + m * 16 + frx; const size_t off = (size_t)row * 1024 + col0; float ss = 0.f;
#pragma unroll
                for (int bj = 0; bj < 2; ++bj) {
                    const u32x4 w0 = bw[ai][m][bj];
                    const f32x4 b0 = (f32x4){__uint_as_float(w0.x << 16), __uint_as_float(w0.x & 0xffff0000u), __uint_as_float(w0.y << 16), __uint_as_float(w0.y & 0xffff0000u)};
                    const f32x4 b1 = (f32x4){__uint_as_float(w0.z << 16), __uint_as_float(w0.z & 0xffff0000u), __uint_as_float(w0.w << 16), __uint_as_float(w0.w & 0xffff0000u)};
                    const f32x4 o0 = b0 + acc[ai][bj][m][0], o1 = b1 + acc[ai][bj][m][1]; if (EPI_ZERO) { float z_ = 0.f; asm volatile("" : "+v"(z_)); acc[ai][bj][m][0] = (f32x4){z_, z_, z_, z_}; acc[ai][bj][m][1] = (f32x4){z_, z_, z_, z_}; }
                    ss += ((o0[0] * o0[0] + o0[1] * o0[1]) + (o0[2] * o0[2] + o0[3] * o0[3])) + ((o1[0] * o1[0] + o1[1] * o1[1]) + (o1[2] * o1[2] + o1[3] * o1[3]));
                    u32x4 w; w.x = cvt_pk_bf16(o0[0], o0[1]); w.y = cvt_pk_bf16(o0[2], o0[3]); w.z = cvt_pk_bf16(o1[0], o1[1]); w.w = cvt_pk_bf16(o1[2], o1[3]);
                    if constexpr (SCR == 3 || SCR == 4) { ss += __uint_as_float(w.x ^ w.y ^ w.z ^ w.w) * 1e-30f; } else epi_st<EPI_RES>(hb + off + bj * bjs, w);
                }
                ss += __shfl_xor(ss, 16); ss += __shfl_xor(ss, 32);
                if (fq == 0) ssp[(size_t)(u.pn * 4 + wc) * TOK + row] = ss;
            }
    }
};
typedef EpiResidT<0> EpiResid;

struct EpiSwiGLU {
    static constexpr bool PERM = true, AFTER_DRAIN = false, PREFETCH = false; static constexpr int NSTORE = 8;
    volatile PG8_LAS unsigned* pt; const PG8_LAS float* rt;
    __device__ __forceinline__ void operator()(f32x4 (&acc)[2][2][4][2], const Unit& u, int wr, int wc, int fr, int fq) const {
        bf16_t* O = (bf16_t*)(tab_ptr(pt, 19) + XWS_QKV);
        const int col0 = u.pn * HALF + wc * 32 + 8 * fq;
#pragma unroll
        for (int ai = 0; ai < 2; ++ai)
#pragma unroll
            for (int m = 0; m < 4; ++m) {
                const int rl = ai * HALF + wr * 64 + m * 16 + fr; const int row = u.pm * BM + rl;
                const float r = rt[u.idx * BM + rl];
                float a[8];
                typedef float f32x2_e __attribute__((ext_vector_type(2)));
                const float r2 = r * r, ncr = -1.4426950408889634f * r;
#pragma unroll
                for (int n = 0; n < 2; ++n)
#pragma unroll
                    for (int e = 0; e < 4; e += 2) { const f32x2_e g2 = {acc[ai][0][m][n][e], acc[ai][0][m][n][e + 1]}, u2 = {acc[ai][1][m][n][e], acc[ai][1][m][n][e + 1]};
                        f32x2_e p = g2 * u2; p = p * r2; const f32x2_e x = g2 * ncr; if (EPI_ZERO) { float z_ = 0.f; asm volatile("" : "+v"(z_)); acc[ai][0][m][n][e] = z_; acc[ai][0][m][n][e + 1] = z_; acc[ai][1][m][n][e] = z_; acc[ai][1][m][n][e + 1] = z_; }
                        f32x2_e d = {__builtin_amdgcn_exp2f(x.x), __builtin_amdgcn_exp2f(x.y)}; d = d + 1.0f;
                        const f32x2_e rc = {__builtin_amdgcn_rcpf(d.x), __builtin_amdgcn_rcpf(d.y)}; p = p * rc; a[4 * n + e] = p.x; a[4 * n + e + 1] = p.y; }
                u32x4 w; w.x = cvt_pk_bf16(a[0], a[1]); w.y = cvt_pk_bf16(a[2], a[3]); w.z = cvt_pk_bf16(a[4], a[5]); w.w = cvt_pk_bf16(a[6], a[7]);
                epi_st<EPI_UP>(O + (size_t)row * ACT_LD + col0, w);
            }
    }
};

template <class Epi, class Sched, bool ALIGN_EPI = false, bool SP2 = false>
__device__ __forceinline__ void gemm_phase(PG8_LAS unsigned char* lds, const Gemm g, const Sched& S, const Epi& E) {
    int tid_ = threadIdx.x; asm volatile("" : "+v"(tid_));
    const int tid = tid_, wid = __builtin_amdgcn_readfirstlane(tid >> 6), lane = tid & 63, wr = wid >> 2, wc = PG8_WC_ROT ? ((wid + (wid >> 2)) & 3) : (wid & 3),     fr = lane & 15, fq = lane >> 4;
    const int K = g.K, nt = K / BK, lda = g.lda ? g.lda : g.K, ldb = g.ldb ? g.ldb : g.K;
    unsigned voffA[2], voffB[2];
#pragma unroll
    for (int i = 0; i < 2; ++i) { int R, C; stage_rc(tid * 16 + i * 8192, R, C); const int Rb = Epi::PERM ? ((R & ~31) + perm32(R & 31)) : R;
        voffA[i] = (unsigned)(R * lda + C) * 2u; voffB[i] = (unsigned)(Rb * ldb + C) * 2u; }
    const size_t kstep = (size_t)(BK * 2);
    const size_t hstepA = (size_t)HALF * lda * 2, hstepB = (size_t)HALF * ldb * 2;
    const size_t tstepA = 2 * hstepA, tstepB = 2 * hstepB;
    const unsigned ldsw = (unsigned)wid * 1024u;
    const int aoff = lds_byte(wr * 64 + fr, fq * 8), boff = lds_byte(wc * 32 + fr, fq * 8);
#define PG8_SA(b, h) (((b) * 2 + (h)) * HTB)
#define PG8_SB(b, h) ((4 + (b) * 2 + (h)) * HTB)
#define PG8_STAGE(bufoff, gbase, voff) do { _Pragma("unroll") for (int _i = 0; _i < 2; ++_i) \
        __builtin_amdgcn_global_load_lds((const unsigned*)((const char*)(gbase) + (voff)[_i]), (PG8_LAS unsigned*)(lds + (bufoff) + ldsw + _i * 8192), 16, 0, ((bufoff) < 4 * HTB) ? PG8_AUX_A : PG8_AUX_B); } while (0)
#define PG8_LDA(dst, b, h) do { _Pragma("unroll") for (int m = 0; m < 4; ++m) _Pragma("unroll") for (int k = 0; k < 2; ++k) dst[m][k] = *(const PG8_LAS bf16x8*)(lds + PG8_SA(b, h) + aoff + m * 2048 + k * 1024); } while (0)
#define PG8_LDB(dst, b, h) do { _Pragma("unroll") for (int n = 0; n < 2; ++n) _Pragma("unroll") for (int k = 0; k < 2; ++k) dst[n][k] = *(const PG8_LAS bf16x8*)(lds + PG8_SB(b, h) + boff + n * 2048 + k * 1024); } while (0)
#if PG8_NOPRIO
#define PG8_PRIO(p) do {} while (0)
#else
#define PG8_PRIO(p) __builtin_amdgcn_s_setprio(p)
#endif
#if PG8_MMA_ORDER == 1
#define PG8_MMA_LOOPS _Pragma("unroll") for (int k = 0; k < 2; ++k) _Pragma("unroll") for (int m = 0; m < 4; ++m) _Pragma("unroll") for (int n = 0; n < 2; ++n)
#elif PG8_MMA_ORDER == 3
#define PG8_MMA_LOOPS _Pragma("unroll") for (int k = 0; k < 2; ++k) _Pragma("unroll") for (int n = 0; n < 2; ++n) _Pragma("unroll") for (int m = 0; m < 4; ++m)
#elif PG8_MMA_ORDER == 2
#define PG8_MMA_LOOPS _Pragma("unroll") for (int n = 0; n < 2; ++n) _Pragma("unroll") for (int m = 0; m < 4; ++m) _Pragma("unroll") for (int k = 0; k < 2; ++k)
#else
#define PG8_MMA_LOOPS _Pragma("unroll") for (int m = 0; m < 4; ++m) _Pragma("unroll") for (int n = 0; n < 2; ++n) _Pragma("unroll") for (int k = 0; k < 2; ++k)
#endif
#if PG8_MMA_ORDER == 4
#define PG8_MMA(ai, bj, At, Bt) do { PG8_PRIO(1); _Pragma("unroll") for (int k = 0; k < 2; ++k) _Pragma("unroll") for (int m = 0; m < 4; ++m) _Pragma("unroll") for (int nn = 0; nn < 2; ++nn) { const int n = (m & 1) ? 1 - nn : nn; \
        acc[ai][bj][m][n] = __builtin_amdgcn_mfma_f32_16x16x32_bf16(Bt[n][k], At[m][k], acc[ai][bj][m][n], 0, 0, 0); } PG8_PRIO(0); } while (0)
#else
#define PG8_MMA(ai, bj, At, Bt) do { PG8_PRIO(1); PG8_MMA_LOOPS \
        acc[ai][bj][m][n] = __builtin_amdgcn_mfma_f32_16x16x32_bf16(Bt[n][k], At[m][k], acc[ai][bj][m][n], 0, 0, 0); PG8_PRIO(0); } while (0)
#endif
#define PG8_MMA2(ai, At, Ba, Bb) do { __builtin_amdgcn_s_setprio(1); _Pragma("unroll") for (int k = 0; k < 2; ++k) _Pragma("unroll") for (int m = 0; m < 4; ++m) { _Pragma("unroll") for (int n = 0; n < 2; ++n) \
        acc[ai][0][m][n] = __builtin_amdgcn_mfma_f32_16x16x32_bf16(Ba[n][k], At[m][k], acc[ai][0][m][n], 0, 0, 0); _Pragma("unroll") for (int n = 0; n < 2; ++n) \
        acc[ai][1][m][n] = __builtin_amdgcn_mfma_f32_16x16x32_bf16(Bb[n][k], At[m][k], acc[ai][1][m][n], 0, 0, 0); } __builtin_amdgcn_s_setprio(0); } while (0)
#if PG8_MMA_PAIR
#define PG8_MMX(ai) PG8_MMA2(ai, At, B0, B1)
#else
#define PG8_MMX(ai) do { PG8_MMA(ai, 0, At, B0); PG8_MMA(ai, 1, At, B1); } while (0)
#endif
#define PG8_WAIT_V(n) asm volatile("s_waitcnt vmcnt(" #n ")" ::: "memory")
#define PG8_WAIT_VXN(n) asm volatile("s_cmp_lg_u32 %0, 0\n\ts_cbranch_scc0 .Lwv_n_%=\n\ts_waitcnt vmcnt(" #n ")\n\ts_branch .Lwv_d_%=\n.Lwv_n_%=:\n\ts_waitcnt vmcnt(8)\n.Lwv_d_%=:" :: "s"(relax) : "memory", "scc")
#if PG8_RELAX
#define PG8_WAIT_VX() do { if constexpr (Epi::NSTORE >= 16) PG8_WAIT_VXN(24); else if constexpr (Epi::NSTORE >= 8) PG8_WAIT_VXN(16); else PG8_WAIT_V(8); } while (0)
#else
#define PG8_WAIT_VX() PG8_WAIT_V(8)
#endif
#define PG8_WAIT_L(n) asm volatile("s_waitcnt lgkmcnt(" #n ")" ::: "memory")
#define PG8_BAR __builtin_amdgcn_s_barrier()
#define PG8_SCHED __builtin_amdgcn_sched_barrier(0)
    Unit cur, nxt; int ui = 0;
    if (!S.next(0, cur)) return;
    f32x4 acc[2][2][4][2];
#pragma unroll
    for (int a = 0; a < 2; ++a)
#pragma unroll
        for (int b = 0; b < 2; ++b)
#pragma unroll
            for (int m = 0; m < 4; ++m)
#pragma unroll
                for (int n = 0; n < 2; ++n) acc[a][b][m][n] = (f32x4){0.f, 0.f, 0.f, 0.f};
    bf16x8 At[4][2], B0[2][2], B1[2][2];
    const char* cA = (const char*)g.A + (size_t)cur.pm * tstepA; const char* cB = (const char*)g.Bt + (size_t)cur.pn * tstepB;
    S.a_ready(cur);
    if constexpr (SP2) {
        PG8_STAGE(PG8_SB(0, 0), cB, voffB); PG8_STAGE(PG8_SB(0, 1), cB + hstepB, voffB); PG8_STAGE(PG8_SA(0, 0), cA, voffA); PG8_STAGE(PG8_SA(0, 1), cA + hstepA, voffA);
        if (wr == 1) PG8_BAR;
        PG8_WAIT_V(2); PG8_BAR;
        PG8_STAGE(PG8_SB(1, 0), cB + kstep, voffB); PG8_STAGE(PG8_SA(1, 0), cA + kstep, voffA); PG8_STAGE(PG8_SB(1, 1), cB + hstepB + kstep, voffB);
        PG8_WAIT_V(6); PG8_BAR;
    } else {
        PG8_STAGE(PG8_SB(0, 0), cB, voffB); PG8_STAGE(PG8_SA(0, 0), cA, voffA); PG8_STAGE(PG8_SB(0, 1), cB + hstepB, voffB); PG8_STAGE(PG8_SA(0, 1), cA + hstepA, voffA);
        if (wr == 1) PG8_BAR;
        PG8_WAIT_V(4); PG8_BAR;
        PG8_STAGE(PG8_SB(1, 0), cB + kstep, voffB); PG8_STAGE(PG8_SA(1, 0), cA + kstep, voffA); PG8_STAGE(PG8_SB(1, 1), cB + hstepB + kstep, voffB);
        PG8_WAIT_V(6); PG8_BAR;
    }
    for (;;) {
        const bool has_next = S.next(ui + 1, nxt);
        const char* nA = has_next ? (const char*)g.A + (size_t)nxt.pm * tstepA : cA; const char* nB = has_next ? (const char*)g.Bt + (size_t)nxt.pn * tstepB : cB;
        for (int t = 0; t < nt; t += 2) {
            const bool last = (t == nt - 2);
            const char* a1 = cA + (size_t)(t + 1) * kstep;
            const char* a2 = last ? nA : cA + (size_t)(t + 2) * kstep; const char* b2 = last ? nB : cB + (size_t)(t + 2) * kstep;
            const char* a3 = a2 + kstep; const char* b3 = b2 + kstep;
            if (last && has_next) S.a_ready(nxt);
            if constexpr (Epi::PREFETCH) { if (t == nt - 6 || t == nt - 4) E.prefetch(cur, tid, t == nt - 6 ? 0 : 1, lds + 131072 + wid * 256); }
            const int relax = __builtin_amdgcn_readfirstlane((t == 0 && ui > 0) ? 1 : 0);
            if constexpr (SP2) {
            PG8_LDB(B0, 0, 0); PG8_LDB(B1, 0, 1); PG8_SCHED; PG8_LDA(At, 0, 0); PG8_STAGE(PG8_SA(1, 1), a1 + hstepA, voffA);
            PG8_WAIT_VX(); PG8_WAIT_L(0); PG8_BAR; PG8_MMX(0); PG8_BAR; PG8_SCHED;
            PG8_LDA(At, 0, 1); PG8_STAGE(PG8_SB(0, 0), b2, voffB); PG8_STAGE(PG8_SB(0, 1), b2 + hstepB, voffB); PG8_STAGE(PG8_SA(0, 0), a2, voffA);
            PG8_WAIT_VX(); PG8_WAIT_L(0); PG8_BAR; PG8_MMX(1); PG8_BAR; PG8_SCHED;
            PG8_LDB(B0, 1, 0); PG8_LDB(B1, 1, 1); PG8_SCHED; PG8_LDA(At, 1, 0); PG8_STAGE(PG8_SA(0, 1), a2 + hstepA, voffA);
            PG8_WAIT_V(8); PG8_WAIT_L(0); PG8_BAR; PG8_MMX(0); PG8_BAR; PG8_SCHED;
            PG8_LDA(At, 1, 1); PG8_STAGE(PG8_SB(1, 0), b3, voffB); PG8_STAGE(PG8_SB(1, 1), b3 + hstepB, voffB); PG8_STAGE(PG8_SA(1, 0), a3, voffA);
            PG8_WAIT_V(8); PG8_WAIT_L(0); PG8_BAR; PG8_MMX(1); PG8_BAR; PG8_SCHED;
            } else {
            PG8_LDB(B0, 0, 0); PG8_SCHED; PG8_LDA(At, 0, 0); PG8_STAGE(PG8_SA(1, 1), a1 + hstepA, voffA);
            PG8_WAIT_L(8); PG8_BAR; PG8_WAIT_L(0); PG8_MMA(0, 0, At, B0); PG8_BAR; PG8_SCHED;
            PG8_LDB(B1, 0, 1); PG8_STAGE(PG8_SB(0, 0), b2, voffB);
            PG8_BAR; PG8_WAIT_L(0); PG8_MMA(0, 1, At, B1); PG8_BAR;
            PG8_LDA(At, 0, 1); PG8_STAGE(PG8_SA(0, 0), a2, voffA);
            PG8_BAR; PG8_WAIT_L(0); PG8_MMA(1, 0, At, B0); PG8_BAR; PG8_SCHED;
            PG8_STAGE(PG8_SB(0, 1), b2 + hstepB, voffB);
            PG8_WAIT_V(6); PG8_BAR; PG8_MMA(1, 1, At, B1); PG8_BAR;
            PG8_LDB(B0, 1, 0); PG8_SCHED; PG8_LDA(At, 1, 0); PG8_STAGE(PG8_SA(0, 1), a2 + hstepA, voffA);
            PG8_WAIT_L(8); PG8_BAR; PG8_WAIT_L(0); PG8_MMA(0, 0, At, B0); PG8_BAR; PG8_SCHED;
            PG8_LDB(B1, 1, 1); PG8_STAGE(PG8_SB(1, 0), b3, voffB);
            PG8_BAR; PG8_WAIT_L(0); PG8_MMA(0, 1, At, B1); PG8_BAR;
            PG8_LDA(At, 1, 1); PG8_STAGE(PG8_SA(1, 0), a3, voffA);
            PG8_BAR; PG8_WAIT_L(0); PG8_MMA(1, 0, At, B0); PG8_BAR; PG8_SCHED;
            PG8_STAGE(PG8_SB(1, 1), b3 + hstepB, voffB);
            PG8_WAIT_V(6); PG8_BAR; PG8_MMA(1, 1, At, B1); PG8_BAR;
            }
        }
        if constexpr (ALIGN_EPI) { if (wr == 0) PG8_BAR; }
        if constexpr (!Epi::AFTER_DRAIN) { E(acc, cur, wr, wc, fr, fq); S.done(cur); }
        if (!has_next) break;
        if constexpr (!EPI_ZERO || Epi::AFTER_DRAIN)
#pragma unroll
        for (int a = 0; a < 2; ++a)
#pragma unroll
            for (int b = 0; b < 2; ++b)
#pragma unroll
                for (int m = 0; m < 4; ++m)
#pragma unroll
                    for (int n = 0; n < 2; ++n) {
#if PG8_ZERO64
                        asm volatile("v_mov_b64 %0, 0" : "=v"(*(double*)&acc[a][b][m][n])); asm volatile("v_mov_b64 %0, 0" : "=v"(*((double*)&acc[a][b][m][n] + 1)));
#else
                        acc[a][b][m][n] = (f32x4){0.f, 0.f, 0.f, 0.f};
#endif
                    }
        cur = nxt; cA = nA; cB = nB; ++ui;
        if constexpr (ALIGN_EPI) { if (wr == 1) PG8_BAR; }
    }
    PG8_WAIT_V(0);
    if constexpr (!ALIGN_EPI) { if (wr == 0) PG8_BAR; }
    PG8_BAR;
    if constexpr (Epi::AFTER_DRAIN) { E.fused(acc, cur, wr, wc, fr, fq, lds, wid, lane); S.done(cur); }
#undef PG8_SA
#undef PG8_SB
#undef PG8_STAGE
#undef PG8_LDA
#undef PG8_LDB
#undef PG8_MMA
#undef PG8_MMA2
#undef PG8_MMX
#undef PG8_MMA_LOOPS
#undef PG8_WAIT_V
#undef PG8_WAIT_L
#undef PG8_WAIT_VX
#undef PG8_WAIT_VXN
#undef PG8_BAR
#undef PG8_SCHED
}
}

#ifndef PG8_SP2
#define PG8_SP2 true
#endif
#ifndef PG8_ALIGN
#define PG8_ALIGN true
#endif
#ifndef ATT_NOREF
#define ATT_NOREF 1
#endif
#ifndef ATT_BANDSKIP
#define ATT_BANDSKIP 1
#endif
#ifndef ATT_SKIPBAR
#define ATT_SKIPBAR 1
#endif
#ifndef ATT_PHPRIO
#define ATT_PHPRIO 0
#endif
#if ATT_PHPRIO == 1
#define ATT_PRIO_A() __builtin_amdgcn_s_setprio(1)
#define ATT_PRIO_B() __builtin_amdgcn_s_setprio(0)
#elif ATT_PHPRIO == 2
#define ATT_PRIO_A() __builtin_amdgcn_s_setprio(0)
#define ATT_PRIO_B() __builtin_amdgcn_s_setprio(1)
#else
#define ATT_PRIO_A() do{}while(0)
#define ATT_PRIO_B() do{}while(0)
#endif
namespace attn_body {
constexpr bool NOREF = ATT_NOREF != 0;
using bf16=__hip_bfloat16;
using bf16x8=__attribute__((ext_vector_type(8)))short;
using s16x4=__attribute__((ext_vector_type(4)))short;
using f32x16=__attribute__((ext_vector_type(16)))float;
using f32x4=__attribute__((ext_vector_type(4)))float;
using u32x4=__attribute__((ext_vector_type(4)))unsigned;
constexpr int SEQ=2048,D=64,LDQ=3072;
constexpr int NW=8,QBLK=32,QB=QBLK*NW,KVBLK=64,NQB=SEQ/QB;
__device__ __forceinline__ int crow(int r,int hi){return (r&3)+8*(r>>2)+4*hi;}
#define SBAR() __builtin_amdgcn_sched_barrier(0)
__device__ __forceinline__ void cmask(f32x16&p0,f32x16&p1,int jb,int qrel,int hi){
  const float NEG=-INFINITY; int kb=64*jb+4*hi;
  #pragma unroll
  for(int r=0;r<16;++r){int kv=kb+(r&3)+8*(r>>2); if(kv>qrel)p0[r]=NEG; if(kv+32>qrel)p1[r]=NEG;}
}
__device__ __forceinline__ float dil_bias(int d){
  const unsigned u=(unsigned)d;
  const int c=(int)(u<=128u)+(int)((u<=512u)&&((u&3u)==0u))+(int)((d>=0)&&((u&15u)==0u));
  return c==0?-INFINITY:(c==1?0.f:(c==2?1.0f:1.5849625007211562f));
}
constexpr int DIL_LUT_OFF=144384, DIL_LUT_N=2336;
__device__ __forceinline__ void dil_hook(f32x16&p0,f32x16&p1,int dt,const char*shm){
#ifdef DIL_NO_LUT
  #pragma unroll
  for(int r=0;r<16;++r){const int d=dt-((r&3)+8*(r>>2)); p0[r]+=dil_bias(d); p1[r]+=dil_bias(d-32);}
#else
  const __attribute__((address_space(3))) float*Tl=(const __attribute__((address_space(3))) float*)(shm+DIL_LUT_OFF)+(dt+197);
  #pragma unroll
  for(int r=0;r<16;++r){const int off=(r&3)+8*(r>>2); float a0=Tl[59-off],a1=Tl[27-off],x0=p0[r],x1=p1[r],y0,y1;
    asm volatile("v_add_f32_e32 %0, %1, %2":"=v"(y0):"v"(x0),"v"(a0)); asm volatile("v_add_f32_e32 %0, %1, %2":"=v"(y1):"v"(x1),"v"(a1)); p0[r]=y0; p1[r]=y1;}
#endif
}
__device__ __forceinline__ void all_neg(f32x16&p0,f32x16&p1){
  #pragma unroll
  for(int r=0;r<16;++r){p0[r]=-INFINITY;p1[r]=-INFINITY;}
}

constexpr int NSLOT=3, SLOTB=8192;
constexpr int LDS_K=0, LDS_V=NSLOT*SLOTB, LDS_WS=2*NSLOT*SLOTB, LDS_OST=LDS_WS+NW*64*4, LDS_BYTES=LDS_OST+NW*4096;
constexpr float C2=0.125f*1.4426950408889634f;
__device__ __forceinline__ void glds16(const void*sbase,unsigned voff,unsigned lds_dst){unsigned keep;
  asm volatile("s_nop 4\n\ts_mov_b32 %0, m0\n\ts_mov_b32 m0, %3\n\ts_nop 0\n\tglobal_load_lds_dwordx4 %1, %2\n\ts_mov_b32 m0, %0":"=&s"(keep):"v"(voff),"s"(sbase),"s"(lds_dst):"memory");}
__device__ __forceinline__ float max3f(float a,float b,float c){float r;asm("v_max3_f32 %0, %1, %2, %3":"=v"(r):"v"(a),"v"(b),"v"(c));return r;}
__device__ __forceinline__ float max2f(float a,float b){float r;asm("v_max_f32_e32 %0, %1, %2":"=v"(r):"v"(a),"v"(b));return r;}
__device__ __forceinline__ float fadd_s(float a,float b){float r;asm("v_add_f32_e32 %0, %1, %2":"=v"(r):"v"(a),"v"(b));return r;}
__device__ __forceinline__ float fsub_s(float a,float b){float r;asm("v_sub_f32_e32 %0, %1, %2":"=v"(r):"v"(a),"v"(b));return r;}
typedef float f32x2_t __attribute__((ext_vector_type(2))); typedef __bf16 bf16x2_t __attribute__((ext_vector_type(2)));
__device__ __forceinline__ unsigned cvtpk_s(float lo,float hi){f32x2_t v={lo,hi};bf16x2_t b=__builtin_convertvector(v,bf16x2_t);return __builtin_bit_cast(unsigned,b);}
#define WAIT_BAR(N) asm volatile("s_waitcnt vmcnt(" #N ") lgkmcnt(0)\n\ts_barrier":::"memory")

__device__ __forceinline__ void qkt(f32x16&p0,f32x16&p1,const char*Kslot,const bf16x8*qr,int r32,int hi){
  const f32x16 negm=f32x16{};
  const char*kb=Kslot+hi*1024+r32*16;
  #pragma unroll
  for(int d0=0;d0<4;++d0){
    const bf16x8 b0=*reinterpret_cast<const bf16x8*>(kb+d0*2048);
    const bf16x8 b1=*reinterpret_cast<const bf16x8*>(kb+d0*2048+512);
    if(d0==0){p0=__builtin_amdgcn_mfma_f32_32x32x16_bf16(b0,qr[0],negm,0,0,0);p1=__builtin_amdgcn_mfma_f32_32x32x16_bf16(b1,qr[0],negm,0,0,0);}
    else{p0=__builtin_amdgcn_mfma_f32_32x32x16_bf16(b0,qr[d0],p0,0,0,0);p1=__builtin_amdgcn_mfma_f32_32x32x16_bf16(b1,qr[d0],p1,0,0,0);}}
}
typedef __attribute__((address_space(3))) const char* lds_cptr;
typedef short v4i16_t __attribute__((ext_vector_type(4)));
__device__ __forceinline__ void kload8(bf16x8*kf,lds_cptr kp){
  kf[0]=*(const __attribute__((address_space(3))) bf16x8*)(kp);      kf[1]=*(const __attribute__((address_space(3))) bf16x8*)(kp+512);
  kf[2]=*(const __attribute__((address_space(3))) bf16x8*)(kp+2048); kf[3]=*(const __attribute__((address_space(3))) bf16x8*)(kp+2560);
  kf[4]=*(const __attribute__((address_space(3))) bf16x8*)(kp+4096); kf[5]=*(const __attribute__((address_space(3))) bf16x8*)(kp+4608);
  kf[6]=*(const __attribute__((address_space(3))) bf16x8*)(kp+6144); kf[7]=*(const __attribute__((address_space(3))) bf16x8*)(kp+6656);
}
__device__ __forceinline__ void kload2(bf16x8*kf,lds_cptr kp,int j){ kf[2*j]=*(const __attribute__((address_space(3))) bf16x8*)(kp+j*2048); kf[2*j+1]=*(const __attribute__((address_space(3))) bf16x8*)(kp+j*2048+512); }
__device__ __forceinline__ s16x4 vtr(lds_cptr p){ return __builtin_bit_cast(s16x4,__builtin_amdgcn_ds_read_tr16_b64_v4i16((__attribute__((address_space(3))) v4i16_t*)p)); }
__device__ __forceinline__ float rowmax(const f32x16&p0,const f32x16&p1){
  float a=max3f(p0[0],p0[1],p1[0]),b=max3f(p0[2],p0[3],p1[1]);a=max3f(a,p1[2],p1[3]);
  #pragma unroll
  for(int r=4;r<16;r+=4){a=max3f(a,p0[r],p0[r+1]);b=max3f(b,p0[r+2],p0[r+3]);a=max3f(a,p1[r],p1[r+1]);b=max3f(b,p1[r+2],p1[r+3]);}
  const float m=max2f(a,b);
  auto rr=__builtin_amdgcn_permlane32_swap(__float_as_uint(m),__float_as_uint(m),false,false);
  return max2f(__uint_as_float(rr[0]),__uint_as_float(rr[1]));
}
__device__ __forceinline__ void pv(f32x16*o,int vb,bf16x8 pa0,bf16x8 pa1,bf16x8 pa2,bf16x8 pa3){
  #pragma unroll
  for(int d0=0;d0<2;++d0){s16x4 lo[4],hi[4];
    #pragma unroll
    for(int ks=0;ks<4;++ks){
      asm volatile("ds_read_b64_tr_b16 %0,%1 offset:%c2":"=&v"(lo[ks]):"v"(vb),"i"(d0*4096+ks*1024):"memory");
      asm volatile("ds_read_b64_tr_b16 %0,%1 offset:%c2":"=&v"(hi[ks]):"v"(vb),"i"(d0*4096+ks*1024+512):"memory");}
    asm volatile("s_waitcnt lgkmcnt(0)":::"memory");SBAR();
    #define PK(k) (bf16x8){lo[k][0],lo[k][1],lo[k][2],lo[k][3],hi[k][0],hi[k][1],hi[k][2],hi[k][3]}
    o[d0]=__builtin_amdgcn_mfma_f32_32x32x16_bf16(pa0,PK(0),o[d0],0,0,0);
    o[d0]=__builtin_amdgcn_mfma_f32_32x32x16_bf16(pa1,PK(1),o[d0],0,0,0);
    o[d0]=__builtin_amdgcn_mfma_f32_32x32x16_bf16(pa2,PK(2),o[d0],0,0,0);
    o[d0]=__builtin_amdgcn_mfma_f32_32x32x16_bf16(pa3,PK(3),o[d0],0,0,0);
    #undef PK
  }
}

#ifndef ATTN_STORE16
#ifndef ATT_ST
#define ATT_ST 1
#endif
#define ATTN_STORE16(p,v) do{ if(ATT_ST==2){ const u32x4 v__=(v); ST16_SC1((u32x4*)(p),v__); } else if(ATT_ST) __builtin_nontemporal_store((v),(u32x4*)(p)); else *(u32x4*)(p)=(v); }while(0)
#endif
constexpr int LDS_S1=83968, LDS_SSB=LDS_S1+NW*4096, LDS_DC=LDS_SSB+NW*128, ATTN_LDS_BYTES_DIFF=LDS_DC+544;
template<int MODE,int THRL,int ABL=0>
__device__ __forceinline__ void attn_unit(int qb,const bf16*__restrict__ QKVb,int qcol,int kcol,int vcol,bf16*Og,int ldo,const float*km0,char*shm,int est,int kncol,int vncol,int first,int&ring,int qncol,int qbn,bf16x8&qp0,bf16x8&qp1,bf16x8&qp2,bf16x8&qp3){
  const bf16*Qg=QKVb+qcol,*Kg=QKVb+kcol,*Vg=QKVb+vcol,*Kn=QKVb+kncol,*Vn=QKVb+vncol,*Qn=QKVb+qncol; const float*km1=km0+128*512;
  int tid_=threadIdx.x; asm volatile("":"+v"(tid_));
  #define CLOSE_BAR() do{ if constexpr((ABL&2048)!=0){ asm volatile("s_waitcnt lgkmcnt(0)\n\ts_barrier":::"memory"); } else if constexpr((ABL&32)!=0){ if(wid<4){ WBX(2); } } else { WBX(2); } }while(0)
  #define WBX(N) do{ if constexpr((ABL&8)!=0){ asm volatile("s_waitcnt vmcnt(" #N ") lgkmcnt(0)":::"memory"); } else { WAIT_BAR(N); } }while(0)
  const int tid=tid_,lane=tid&63,r32=lane&31,hi=lane>>5; const int wid=__builtin_amdgcn_readfirstlane(tid>>6);
  const int q0=qb*QB;
  const bf16*Qw=Qg+(long)(q0+wid*QBLK)*LDQ;
  const bf16*Kh=Kg,*Vh=Vg;
  const unsigned lds0=(unsigned)(uintptr_t)shm;
  float*wsf=(float*)(shm+LDS_WS)+wid*64;
  const bf16*ksrc=Kh+wid*8;
  const bf16*vsrc=Vh+(long)(16*(wid&3))*LDQ+(wid>>2)*32;
  const bf16*knsrc=Kn+wid*8; const bf16*vnsrc=Vn+(long)(16*(wid&3))*LDQ+(wid>>2)*32;
  const unsigned koff=(unsigned)lane*(LDQ*2u), voff=(unsigned)(lane>>2)*(LDQ*2u)+(unsigned)(lane&3)*16u;
  const unsigned kdst=lds0+LDS_K+wid*1024, vdst=lds0+LDS_V+wid*1024;
  #define DMA_K(t,slot) glds16(ksrc+(long)(t)*KVBLK*LDQ,koff,(unsigned)__builtin_amdgcn_readfirstlane(kdst+(slot)))
  #define DMA_V(t,slot) glds16(vsrc+(long)(t)*KVBLK*LDQ,voff,(unsigned)__builtin_amdgcn_readfirstlane(vdst+(slot)))
  #define DMA_KX(t,slot) do{ const int t_=(t); const bf16*s_=(t_<NT)?(ksrc+(long)t_*KVBLK*LDQ):(knsrc+(long)(t_-NT)*KVBLK*LDQ); glds16(s_,koff,(unsigned)__builtin_amdgcn_readfirstlane(kdst+(slot))); }while(0)
  #define DMA_VX(t,slot) do{ const int t_=(t); const bf16*s_=(t_<NT)?(vsrc+(long)t_*KVBLK*LDQ):(vnsrc+(long)(t_-NT)*KVBLK*LDQ); glds16(s_,voff,(unsigned)__builtin_amdgcn_readfirstlane(vdst+(slot))); }while(0)
  const int vb0=(int)(lds0+LDS_V)+((lane>>4)&1)*32+(lane&3)*8+(4*hi+((lane&15)>>2))*64;
  const int s0=ring, s1=(s0==(NSLOT-1)*SLOTB)?0:s0+SLOTB, s2=(s1==(NSLOT-1)*SLOTB)?0:s1+SLOTB;
  const char*Kbase=shm+LDS_K+s0; bf16x8 kf[8];
  const lds_cptr shm3=(lds_cptr)shm; const lds_cptr kp0=shm3+LDS_K+hi*1024+r32*16; const lds_cptr vp0=shm3+LDS_V+((lane>>4)&1)*32+(lane&3)*8+(4*hi+((lane&15)>>2))*64;
  const int NT=(q0+QB)/KVBLK;
  if(first){DMA_K(0,s0);DMA_V(0,s0);DMA_K(1,s1);}
  bf16x8 qr[4];
  if(first){
    #pragma unroll
    for(int d0=0;d0<4;++d0)qr[d0]=*reinterpret_cast<const bf16x8*>(&Qw[(long)r32*LDQ+d0*16+hi*8]); }
  else{
    qr[0]=qp0;qr[1]=qp1;qr[2]=qp2;qr[3]=qp3; }
  float mhat=0.f,l_reg=0.f;f32x16 o[2];o[0]=f32x16{};o[1]=f32x16{};const f32x16 zero16=f32x16{};
  const int qrel=wid*QBLK+r32;
  unsigned selmask=0u;
  if constexpr(MODE==2){
    if(qb<=3)selmask=(1u<<qb)-1u;
    else{
      float g[8];
      #pragma unroll
      for(int n=0;n<8;++n){
        if(n<qb){ float s=0.f;
          #pragma unroll
          for(int d0=0;d0<4;++d0){
            const f32x4 a0=*(const f32x4*)(km0+(long)n*512+d0*16+hi*8),a1=*(const f32x4*)(km0+(long)n*512+d0*16+hi*8+4);
            const f32x4 b0=*(const f32x4*)(km1+(long)n*512+d0*16+hi*8),b1=*(const f32x4*)(km1+(long)n*512+d0*16+hi*8+4);
            const f32x4 k0=a0+b0,k1=a1+b1;
            #pragma unroll
            for(int e=0;e<4;++e){
              const unsigned w=(unsigned)(unsigned short)qr[d0][e],w2=(unsigned)(unsigned short)qr[d0][4+e];
              s+=__uint_as_float(w<<16)*k0[e]; s+=__uint_as_float(w2<<16)*k1[e]; } }
          s+=__shfl_xor(s,32); g[n]=s; }
        else g[n]=-INFINITY; }
      #pragma unroll
      for(int n=0;n<8;++n){ int rank=0;
        #pragma unroll
        for(int m=0;m<8;++m){ if(m!=n){ rank+=(g[m]>g[n]||(g[m]==g[n]&&m<n))?1:0; } }
        if(n<qb&&rank<3)selmask|=(1u<<n); }
    }
    ((unsigned*)(shm+LDS_OST))[wid*1024+lane]=selmask;
  }
  const int dq=q0+qrel-4*hi;
  #define MHOOK(P0,P1,t) do{ if constexpr(MODE==1){ dil_hook(P0,P1,dq-64*(t),shm); } \
      else if constexpr(MODE==2){ if((t)<NT-4){ const unsigned sm_=((const unsigned*)(shm+LDS_OST))[wid*1024+lane]; if(!((sm_>>((t)>>2))&1u)) all_neg(P0,P1); } } }while(0)
  #define CMASK(P0,P1,t) do{ if constexpr(MODE!=1){ int jb_=(t)-(NT-4); if(jb_>=0)cmask(P0,P1,jb_,qrel,hi);} }while(0)
  bool resc=false;
  #define START(P0,P1) do{ resc=false; \
    if constexpr(!NOREF){ const float rm=rowmax(P0,P1); const float dl=(rm>-1e30f)?rm:0.f; mhat=fadd_s(mhat,dl); \
      _Pragma("unroll") for(int r=0;r<16;++r){P0[r]=fsub_s(P0[r],dl);P1[r]=fsub_s(P1[r],dl);} \
      } \
    _Pragma("unroll") for(int r=0;r<16;++r)P0[r]=__builtin_amdgcn_exp2f(P0[r]); }while(0)
  #define RESC() do{ if(resc){ asm volatile("s_waitcnt lgkmcnt(0)":::"memory"); \
      _Pragma("unroll") for(int d_=0;d_<2;++d_) _Pragma("unroll") for(int r=0;r<16;++r)o[d_][r]*=wsf[crow(r,hi)]; } }while(0)
  f32x16 pA0,pA1,pB0,pB1;
  int sl_prev=s0,sl_cur=s0,sl_next=s1;
  #define ROT() do{sl_prev=sl_cur;sl_cur=sl_next;sl_next=(sl_next==(NSLOT-1)*SLOTB)?0:sl_next+SLOTB;}while(0)
  if(first){DMA_K(2,s2);}
  if(first||!ATT_SKIPBAR){ WBX(3); }
  qkt(pA0,pA1,Kbase,qr,r32,hi);asm volatile("s_nop 15\n\ts_nop 7":"+v"(pA0),"+v"(pA1));CMASK(pA0,pA1,0);MHOOK(pA0,pA1,0);
  START(pA0,pA1);
  _Pragma("unroll") for(int r=0;r<16;++r)pA1[r]=__builtin_amdgcn_exp2f(pA1[r]);
  WBX(0);
  DMA_K(3,s0);DMA_V(1,s1);
  ROT();
  kload8(kf,kp0+sl_cur);
  WBX(2);
  s16x4 vlo[8],vhi[8]; u32x4 pw0,pw1,pw2,pw3;
  if constexpr((ABL&16)!=0){ _Pragma("unroll") for(int i_=0;i_<8;++i_){vlo[i_]=s16x4{};vhi[i_]=s16x4{};} }
  if constexpr((ABL&4)!=0){ pA0=f32x16{};pA1=f32x16{};pB0=f32x16{};pB1=f32x16{}; }
  if constexpr((ABL&512)!=0){ pw0=u32x4{};pw1=u32x4{};pw2=u32x4{};pw3=u32x4{}; }
  #define PKW(P,B) cvtpk_s(P[B],P[B+1])
  #define PAF(k) __builtin_bit_cast(bf16x8,pw##k)
  #define VFR(i) (bf16x8){vlo[i][0],vlo[i][1],vlo[i][2],vlo[i][3],vhi[i][0],vhi[i][1],vhi[i][2],vhi[i][3]}
  #define PIN(x) asm volatile("":"+v"(x))
  #define MX3(a,b,c) __builtin_fmaxf(__builtin_fmaxf((a),(b)),(c))
  #define GAPA(MF,A0,A1,A2,A3,W0,W1,PW) do{ if constexpr((ABL&4)==0){ MF; } if constexpr((ABL&512)==0){ sacc+=A0; sacc+=A1; sacc+=A2; sacc+=A3; PIN(sacc); W0; W1; PIN(PW); } if constexpr((ABL&1024)!=0){ rmx_=MX3(rmx_,A0,A1); rmx_=MX3(rmx_,A2,A3); PIN(rmx_); } SBAR(); }while(0)
  #define EX(v) (((ABL&1)!=0)?(v):__builtin_amdgcn_exp2f(v))
  #define GAPB(MF,X,B) do{ if constexpr((ABL&2)==0){ MF; } if constexpr((ABL&1024)!=0){ X[B]=fsub_s(X[B],mhat);X[B+1]=fsub_s(X[B+1],mhat);X[B+2]=fsub_s(X[B+2],mhat);X[B+3]=fsub_s(X[B+3],mhat); } X[B]=EX(X[B]); X[B+1]=EX(X[B+1]); X[B+2]=EX(X[B+2]); X[B+3]=EX(X[B+3]); PIN(X); SBAR(); }while(0)
  #define VRD(i) do{ if constexpr((ABL&16)!=0) break; vlo[i]=vtr(vp_+(((i)>>2)*4096+((i)&3)*1024)); vhi[i]=vtr(vp_+(((i)>>2)*4096+((i)&3)*1024+512)); }while(0)
  #define KRD(G,j) do{ if constexpr((ABL&128)==0){ if(G){ kload2(kf,kp0+sl_next,j); SBAR(); } } }while(0)
  #define STEP(C0,C1,P0,P1,t,GL) do{ SBAR(); ATT_PRIO_A(); \
    const lds_cptr vp_=vp0+sl_prev; \
    VRD(0); SBAR(); float sacc=(P0[0]+P0[1]); float rmx_=0.f; \
    GAPA(C0=__builtin_amdgcn_mfma_f32_32x32x16_bf16(kf[0],qr[0],zero16,0,0,0), P0[2],P0[3],P0[4],P0[5],     pw0[0]=PKW(P0,0), pw0[1]=PKW(P0,2), pw0); \
    VRD(4); SBAR(); GAPA(C1=__builtin_amdgcn_mfma_f32_32x32x16_bf16(kf[1],qr[0],zero16,0,0,0), P0[6],P0[7],P0[8],P0[9],     pw0[2]=PKW(P0,4), pw0[3]=PKW(P0,6), pw0); \
    VRD(1); SBAR(); GAPA(C0=__builtin_amdgcn_mfma_f32_32x32x16_bf16(kf[2],qr[1],C0,0,0,0),   P0[10],P0[11],P0[12],P0[13], pw1[0]=PKW(P0,8), pw1[1]=PKW(P0,10), pw1); \
    VRD(5); SBAR(); GAPA(C1=__builtin_amdgcn_mfma_f32_32x32x16_bf16(kf[3],qr[1],C1,0,0,0),   P0[14],P0[15],P1[0],P1[1],   pw1[2]=PKW(P0,12),pw1[3]=PKW(P0,14), pw1); \
    VRD(2); SBAR(); GAPA(C0=__builtin_amdgcn_mfma_f32_32x32x16_bf16(kf[4],qr[2],C0,0,0,0),   P1[2],P1[3],P1[4],P1[5],     pw2[0]=PKW(P1,0), pw2[1]=PKW(P1,2), pw2); \
    VRD(6); SBAR(); GAPA(C1=__builtin_amdgcn_mfma_f32_32x32x16_bf16(kf[5],qr[2],C1,0,0,0),   P1[6],P1[7],P1[8],P1[9],     pw2[2]=PKW(P1,4), pw2[3]=PKW(P1,6), pw2); \
    VRD(3); SBAR(); GAPA(C0=__builtin_amdgcn_mfma_f32_32x32x16_bf16(kf[6],qr[3],C0,0,0,0),   P1[10],P1[11],P1[12],P1[13], pw3[0]=PKW(P1,8), pw3[1]=PKW(P1,10), pw3); \
    VRD(7); SBAR(); GAPA(C1=__builtin_amdgcn_mfma_f32_32x32x16_bf16(kf[7],qr[3],C1,0,0,0),   P1[14],P1[15],0.f,0.f,       pw3[2]=PKW(P1,12),pw3[3]=PKW(P1,14), pw3); \
    l_reg+=sacc; if constexpr((ABL&1024)!=0){ asm volatile(""::"v"(rmx_)); } \
    if constexpr((ABL&64)==0){ STEP_DMA(t); } \
    if constexpr((ABL&32)!=0){ if(wid>=4){ WAIT_BAR(2); } } \
    if constexpr(NOREF){ if constexpr(MODE==1){ asm volatile("s_nop 7\n\ts_nop 7":"+v"(C0),"+v"(C1)); } CMASKX(C0,C1,t); MHOOK(C0,C1,t); resc=false; } else \
    if constexpr((ABL&256)==0){ \
    asm volatile("s_nop 7\n\ts_nop 7":"+v"(C0),"+v"(C1)); \
    _Pragma("unroll") for(int r=0;r<16;++r){C0[r]=fsub_s(C0[r],mhat);C1[r]=fsub_s(C1[r],mhat);} \
    CMASKX(C0,C1,t); MHOOK(C0,C1,t); \
    { float a=MX3(C0[0],C0[1],C1[0]),b=MX3(C0[2],C0[3],C1[1]); a=MX3(a,C1[2],C1[3]); \
      _Pragma("unroll") for(int r=4;r<16;r+=4){a=MX3(a,C0[r],C0[r+1]);b=MX3(b,C0[r+2],C0[r+3]);a=MX3(a,C1[r],C1[r+1]);b=MX3(b,C1[r+2],C1[r+3]);} \
      float rm=__builtin_fmaxf(a,b); { auto rr=__builtin_amdgcn_permlane32_swap(__float_as_uint(rm),__float_as_uint(rm),false,false); rm=__builtin_fmaxf(__uint_as_float(rr[0]),__uint_as_float(rr[1])); } \
      resc=false; \
      if(__builtin_expect(__any(rm>(float)THRL),0)){ const float dl=__builtin_fmaxf(rm,0.f); mhat+=dl; \
        _Pragma("unroll") for(int r=0;r<16;++r){C0[r]-=dl;C1[r]-=dl;} \
        const float f=__builtin_amdgcn_exp2f(-dl); l_reg*=f; if(hi==0)wsf[r32]=f; resc=true; } } \
    } else { resc=false; } \
    SBAR(); ATT_PRIO_B(); \
    GAPB(o[0]=__builtin_amdgcn_mfma_f32_32x32x16_bf16(PAF(0),VFR(0),o[0],0,0,0), C0,0); \
    GAPB(o[1]=__builtin_amdgcn_mfma_f32_32x32x16_bf16(PAF(0),VFR(4),o[1],0,0,0), C0,4); \
    KRD(GL,0); GAPB(o[0]=__builtin_amdgcn_mfma_f32_32x32x16_bf16(PAF(1),VFR(1),o[0],0,0,0), C0,8); \
    KRD(GL,1); GAPB(o[1]=__builtin_amdgcn_mfma_f32_32x32x16_bf16(PAF(1),VFR(5),o[1],0,0,0), C0,12); \
    KRD(GL,2); GAPB(o[0]=__builtin_amdgcn_mfma_f32_32x32x16_bf16(PAF(2),VFR(2),o[0],0,0,0), C1,0); \
    KRD(GL,3); GAPB(o[1]=__builtin_amdgcn_mfma_f32_32x32x16_bf16(PAF(2),VFR(6),o[1],0,0,0), C1,4); \
    GAPB(o[0]=__builtin_amdgcn_mfma_f32_32x32x16_bf16(PAF(3),VFR(3),o[0],0,0,0), C1,8); \
    GAPB(o[1]=__builtin_amdgcn_mfma_f32_32x32x16_bf16(PAF(3),VFR(7),o[1],0,0,0), C1,12); \
    }while(0)
  int t=1;
  #define CMASKX(P0,P1,t) do{}while(0)
  #define STEP_DMA(t) DMA_K((t)+3,sl_cur); DMA_V((t)+1,sl_next)
  for(;t+5<NT;t+=2){
    STEP(pB0,pB1,pA0,pA1,t,true);     CLOSE_BAR(); RESC(); ROT();
    STEP(pA0,pA1,pB0,pB1,t+1,true);   CLOSE_BAR(); RESC(); ROT();
  }
  #undef STEP_DMA
  #define STEP_DMA(t) DMA_KX((t)+3,sl_cur); DMA_VX((t)+1,sl_next)
  #undef CMASKX
  #define CMASKX(P0,P1,t) CMASK(P0,P1,t)
  for(;t+1<NT;t+=2){
    STEP(pB0,pB1,pA0,pA1,t,(t+1<NT));       CLOSE_BAR(); RESC(); ROT();
    STEP(pA0,pA1,pB0,pB1,t+1,(t+2<NT));     CLOSE_BAR(); RESC(); ROT();
  }
  if(!ATT_BANDSKIP||wid>=4){ STEP(pB0,pB1,pA0,pA1,NT-1,false); } else { STEP_DMA(NT-1); }
  CLOSE_BAR(); RESC();
  ring=sl_next;
  #undef STEP_DMA
  if(!ATT_BANDSKIP||(wid>>1)>=3)
  { float sacc=pB0[0]+pB0[1]; _Pragma("unroll") for(int r=2;r<16;++r)sacc+=pB0[r]; _Pragma("unroll") for(int r=0;r<16;++r)sacc+=pB1[r]; l_reg+=sacc;
    pw0=(u32x4){PKW(pB0,0),PKW(pB0,2),PKW(pB0,4),PKW(pB0,6)};pw1=(u32x4){PKW(pB0,8),PKW(pB0,10),PKW(pB0,12),PKW(pB0,14)};pw2=(u32x4){PKW(pB1,0),PKW(pB1,2),PKW(pB1,4),PKW(pB1,6)};pw3=(u32x4){PKW(pB1,8),PKW(pB1,10),PKW(pB1,12),PKW(pB1,14)};
    SBAR(); pv(o,vb0+sl_cur,PAF(0),PAF(1),PAF(2),PAF(3)); }
  #undef PKW
  #undef PAF
  #undef VFR
  #undef PIN
  #undef MX3
  #undef GAPA
  #undef GAPB
  #undef EX
  #undef VRD
  #undef KRD
  #undef STEP
  #undef CMASKX
  { const bf16*Qnw=Qn+(long)(qbn*QB+wid*QBLK)*LDQ;
    qp0=*reinterpret_cast<const bf16x8*>(&Qnw[(long)r32*LDQ+0*16+hi*8]); qp1=*reinterpret_cast<const bf16x8*>(&Qnw[(long)r32*LDQ+1*16+hi*8]);
    qp2=*reinterpret_cast<const bf16x8*>(&Qnw[(long)r32*LDQ+2*16+hi*8]); qp3=*reinterpret_cast<const bf16x8*>(&Qnw[(long)r32*LDQ+3*16+hi*8]); }
  {auto rr=__builtin_amdgcn_permlane32_swap(__float_as_uint(l_reg),__float_as_uint(l_reg),false,false);l_reg=__uint_as_float(rr[0])+__uint_as_float(rr[1]);}
  if(hi==0)wsf[32+r32]=l_reg;asm volatile("s_waitcnt lgkmcnt(0)":::"memory");
  float rli[16];
  #pragma unroll
  for(int r=0;r<16;++r)rli[r]=__builtin_amdgcn_rcpf(wsf[32+crow(r,hi)]);
  bf16*Ow=Og+(long)(q0+wid*QBLK)*ldo;
  if(est==0){ bf16*stg=(bf16*)(shm+LDS_OST)+wid*2048;
    #pragma unroll
    for(int r=0;r<16;++r){const int orow=crow(r,hi);
      #pragma unroll
      for(int d0=0;d0<2;++d0)stg[orow*64+d0*32+r32]=__float2bfloat16(o[d0][r]*rli[r]);}
    asm volatile("s_waitcnt lgkmcnt(0)":::"memory");
    #pragma unroll
    for(int i=0;i<4;++i){const int row=i*8+(lane>>3),ch=lane&7; const u32x4 v=*(const u32x4*)(stg+row*64+ch*8); ATTN_STORE16(Ow+(long)row*ldo+ch*8,v);} }
  else if(est==1){ bf16*s1=(bf16*)(shm+LDS_S1)+wid*2048;
    #pragma unroll
    for(int r=0;r<16;++r){const int orow=crow(r,hi);
      #pragma unroll
      for(int d0=0;d0<2;++d0)s1[orow*64+d0*32+r32]=__float2bfloat16(o[d0][r]*rli[r]);} }
  else{ bf16*s1=(bf16*)(shm+LDS_S1)+wid*2048; bf16*stg=(bf16*)(shm+LDS_OST)+wid*2048; bf16*dst=(est==2)?stg:s1;
    const float*dc=(const float*)(shm+LDS_DC); float*ssb=(float*)(shm+LDS_SSB)+wid*32; const float lam=dc[128];
    #pragma unroll
    for(int r=0;r<16;++r){const int orow=crow(r,hi);
      #pragma unroll
      for(int d0=0;d0<2;++d0){const int idx=orow*64+d0*32+r32; const float o1=__bfloat162float(s1[idx]); dst[idx]=__float2bfloat16(o1-lam*(o[d0][r]*rli[r]));}}
    asm volatile("s_waitcnt lgkmcnt(0)":::"memory");
    const int ch=lane&7;
    #pragma unroll
    for(int i=0;i<4;++i){const int row=i*8+(lane>>3); const u32x4 v=*(const u32x4*)(dst+row*64+ch*8);
      float dv[8];
      #pragma unroll
      for(int e=0;e<4;++e){dv[2*e]=__uint_as_float(v[e]<<16);dv[2*e+1]=__uint_as_float(v[e]&0xffff0000u);}
      float ss=0.f;
      #pragma unroll
      for(int e=0;e<8;++e)ss+=dv[e]*dv[e];
      ss+=__shfl_xor(ss,1);ss+=__shfl_xor(ss,2);ss+=__shfl_xor(ss,4);
      if(est==2){ if(ch==0)ssb[row]=ss; }
      else{ const float rs=1.0f/sqrtf((ss+ssb[row])*(1.0f/128.0f)+1e-5f);
        const u32x4 v0=*(const u32x4*)(stg+row*64+ch*8);
        const f32x4 g0a=*(const f32x4*)(dc+ch*8),g0b=*(const f32x4*)(dc+ch*8+4),g1a=*(const f32x4*)(dc+64+ch*8),g1b=*(const f32x4*)(dc+64+ch*8+4);
        u32x4 w0,w1;
        #pragma unroll
        for(int e=0;e<4;++e){ const float ga=(e<2)?g0a[2*e]:g0b[2*e-4], gb=(e<2)?g0a[2*e+1]:g0b[2*e-3], ha=(e<2)?g1a[2*e]:g1b[2*e-4], hb=(e<2)?g1a[2*e+1]:g1b[2*e-3];
          w0[e]=cvtpk_s(__uint_as_float(v0[e]<<16)*rs*ga,__uint_as_float(v0[e]&0xffff0000u)*rs*gb);
          w1[e]=cvtpk_s(dv[2*e]*rs*ha,dv[2*e+1]*rs*hb); }
        ATTN_STORE16(Ow+(long)row*ldo+ch*8,w0); ATTN_STORE16(Ow+(long)row*ldo+64+ch*8,w1); } } }
  asm volatile("s_waitcnt lgkmcnt(0)\n\ts_barrier":::"memory");
  #undef DMA_K
  #undef DMA_V
  #undef DMA_KX
  #undef DMA_VX
  #undef CMASK
  #undef MHOOK
  #undef START
  #undef RESC
  #undef ROT
  #undef WBX
  #undef CLOSE_BAR
}
constexpr int V_SLOTB=16384;
constexpr int X_K=0, X_V=NSLOT*SLOTB, X_WS=X_V+NSLOT*V_SLOTB, X_ST=X_WS+NW*256, X_DC=X_ST+NW*8192, X_BYTES=X_DC+544;
__device__ __forceinline__ void pv128(f32x16*o,int vb,bf16x8 pa0,bf16x8 pa1,bf16x8 pa2,bf16x8 pa3){
  #pragma unroll
  for(int d0=0;d0<4;++d0){s16x4 lo[4],hi[4];
    #pragma unroll
    for(int ks=0;ks<4;++ks){
      asm volatile("ds_read_b64_tr_b16 %0,%1 offset:%c2":"=&v"(lo[ks]):"v"(vb),"i"(d0*4096+ks*1024):"memory");
      asm volatile("ds_read_b64_tr_b16 %0,%1 offset:%c2":"=&v"(hi[ks]):"v"(vb),"i"(d0*4096+ks*1024+512):"memory");}
    asm volatile("s_waitcnt lgkmcnt(0)":::"memory");SBAR();
    #define PK(k) (bf16x8){lo[k][0],lo[k][1],lo[k][2],lo[k][3],hi[k][0],hi[k][1],hi[k][2],hi[k][3]}
    o[d0]=__builtin_amdgcn_mfma_f32_32x32x16_bf16(pa0,PK(0),o[d0],0,0,0);
    o[d0]=__builtin_amdgcn_mfma_f32_32x32x16_bf16(pa1,PK(1),o[d0],0,0,0);
    o[d0]=__builtin_amdgcn_mfma_f32_32x32x16_bf16(pa2,PK(2),o[d0],0,0,0);
    o[d0]=__builtin_amdgcn_mfma_f32_32x32x16_bf16(pa3,PK(3),o[d0],0,0,0);
    #undef PK
  }
}
template<int THRL> __device__ __forceinline__ void attn_unit_dv128(int qb,const bf16*__restrict__ QKVb,int qcol,int kcol,int vcol,bf16*Og,int ldo,char*shm,int est,int kncol,int first,int&ring,int qncol,int qbn,bf16x8&qp0,bf16x8&qp1,bf16x8&qp2,bf16x8&qp3){
  const bf16*Qg=QKVb+qcol,*Kg=QKVb+kcol,*Vg=QKVb+vcol,*Kn=QKVb+kncol,*Qn=QKVb+qncol;
  int tid_=threadIdx.x; asm volatile("":"+v"(tid_));
  const int tid=tid_,lane=tid&63,r32=lane&31,hi=lane>>5; const int wid=__builtin_amdgcn_readfirstlane(tid>>6);
  const int q0=qb*QB;
  const bf16*Qw=Qg+(long)(q0+wid*QBLK)*LDQ;
  const unsigned lds0=(unsigned)(uintptr_t)shm;
  float*wsf=(float*)(shm+X_WS)+wid*64;
  const bf16*ksrc=Kg+wid*8, *knsrc=Kn+wid*8;
  const bf16*vsrc=Vg+(long)(16*(wid&3))*LDQ+(wid>>2)*32;
  const unsigned koff=(unsigned)lane*(LDQ*2u), voff=(unsigned)(lane>>2)*(LDQ*2u)+(unsigned)(lane&3)*16u;
  const unsigned kdst=lds0+X_K+wid*1024, vdst=lds0+X_V+wid*1024;
  const int NT=(q0+QB)/KVBLK;
  #define DMA_K(t,slot) glds16(ksrc+(long)(t)*KVBLK*LDQ,koff,(unsigned)__builtin_amdgcn_readfirstlane(kdst+(slot)))
  #define DMA_V(t,vslot) do{ const bf16*s_=vsrc+(long)(t)*KVBLK*LDQ; glds16(s_,voff,(unsigned)__builtin_amdgcn_readfirstlane(vdst+(vslot))); glds16(s_+64,voff,(unsigned)__builtin_amdgcn_readfirstlane(vdst+(vslot)+8192)); }while(0)
  #define DMA_KX(t,slot) do{ const int t_=(t); const bf16*s_=(t_<NT)?(ksrc+(long)t_*KVBLK*LDQ):(knsrc+(long)(t_-NT)*KVBLK*LDQ); glds16(s_,koff,(unsigned)__builtin_amdgcn_readfirstlane(kdst+(slot))); }while(0)
  #define DMA_VX(t,vslot) do{ const int t_=(t); DMA_V((t_<NT)?t_:(t_-NT),vslot); }while(0)
  const int vb0=(int)(lds0+X_V)+((lane>>4)&1)*32+(lane&3)*8+(4*hi+((lane&15)>>2))*64;
  const int s0=ring, s1=(s0==(NSLOT-1)*SLOTB)?0:s0+SLOTB, s2=(s1==(NSLOT-1)*SLOTB)?0:s1+SLOTB;
  const char*Kbase=shm+X_K+s0; bf16x8 kf[8];
  const lds_cptr shm3=(lds_cptr)shm; const lds_cptr kp0=shm3+X_K+hi*1024+r32*16; const lds_cptr vp0=shm3+X_V+((lane>>4)&1)*32+(lane&3)*8+(4*hi+((lane&15)>>2))*64;
  if(first){DMA_K(0,s0);DMA_V(0,2*s0);DMA_K(1,s1);}
  bf16x8 qr[4];
  if(first){
    #pragma unroll
    for(int d0=0;d0<4;++d0)qr[d0]=*reinterpret_cast<const bf16x8*>(&Qw[(long)r32*LDQ+d0*16+hi*8]); }
  else{ qr[0]=qp0;qr[1]=qp1;qr[2]=qp2;qr[3]=qp3; }
  float mhat=0.f,l_reg=0.f;f32x16 o[4];o[0]=f32x16{};o[1]=f32x16{};o[2]=f32x16{};o[3]=f32x16{};const f32x16 zero16=f32x16{};
  const int qrel=wid*QBLK+r32;
  #define CMASK(P0,P1,t) do{ int jb_=(t)-(NT-4); if(jb_>=0)cmask(P0,P1,jb_,qrel,hi); }while(0)
  bool resc=false;
  #define RESC() do{ if(resc){ asm volatile("s_waitcnt lgkmcnt(0)":::"memory"); \
      _Pragma("unroll") for(int d_=0;d_<4;++d_) _Pragma("unroll") for(int r=0;r<16;++r)o[d_][r]*=wsf[crow(r,hi)]; } }while(0)
  f32x16 c0,c1; u32x4 pw0,pw1,pw2,pw3;
  int sl_prev=s0,sl_cur=s0,sl_next=s1;
  #define ROT() do{sl_prev=sl_cur;sl_cur=sl_next;sl_next=(sl_next==(NSLOT-1)*SLOTB)?0:sl_next+SLOTB;}while(0)
  if(first){DMA_K(2,s2);}
  if(first||!ATT_SKIPBAR){ WAIT_BAR(4); }
  #define PKW(P,B) cvtpk_s(P[B],P[B+1])
  qkt(c0,c1,Kbase,qr,r32,hi);asm volatile("s_nop 15\n\ts_nop 7":"+v"(c0),"+v"(c1));CMASK(c0,c1,0);
  { float dl=0.f; if constexpr(!NOREF){ const float rm=rowmax(c0,c1); dl=(rm>-1e30f)?rm:0.f; } mhat=dl;
    #pragma unroll
    for(int r=0;r<16;++r){c0[r]=__builtin_amdgcn_exp2f(c0[r]-dl);c1[r]=__builtin_amdgcn_exp2f(c1[r]-dl);}
    float sa=0.f,sb=0.f;
    #pragma unroll
    for(int r=0;r<16;++r){sa+=c0[r];sb+=c1[r];}
    l_reg=sa+sb;
    pw0=(u32x4){PKW(c0,0),PKW(c0,2),PKW(c0,4),PKW(c0,6)};pw1=(u32x4){PKW(c0,8),PKW(c0,10),PKW(c0,12),PKW(c0,14)};pw2=(u32x4){PKW(c1,0),PKW(c1,2),PKW(c1,4),PKW(c1,6)};pw3=(u32x4){PKW(c1,8),PKW(c1,10),PKW(c1,12),PKW(c1,14)}; }
  WAIT_BAR(0);
  DMA_K(3,s0);DMA_V(1,2*s1);
  ROT();
  kload8(kf,kp0+sl_cur);
  WAIT_BAR(3);
  s16x4 vlo[4],vhi[4];
  #define PAF(k) __builtin_bit_cast(bf16x8,pw##k)
  #define VFR(i) (bf16x8){vlo[i][0],vlo[i][1],vlo[i][2],vlo[i][3],vhi[i][0],vhi[i][1],vhi[i][2],vhi[i][3]}
  #define PIN(x) asm volatile("":"+v"(x))
  #define MX3(a,b,c) __builtin_fmaxf(__builtin_fmaxf((a),(b)),(c))
  #define EX(v) __builtin_amdgcn_exp2f(v)
  #define VRDX(s,KS) do{ vlo[s]=vtr(vp_+((s)*4096+(KS)*1024)); vhi[s]=vtr(vp_+((s)*4096+(KS)*1024+512)); }while(0)
  #define QKA(MF) do{ MF; SBAR(); }while(0)
  #define GAPX(MF,X,B,RF) do{ MF; RF; X[B]=EX(X[B]); X[B+1]=EX(X[B+1]); sacc+=X[B]; sacc+=X[B+1]; PIN(sacc); PIN(X); SBAR(); }while(0)
  #define PACKW(PW,W,X,B) do{ PW[W]=PKW(X,B); PIN(PW); }while(0)
  #define KRD(G,j) do{ if(G){ kload2(kf,kp0+sl_next,j); SBAR(); } }while(0)
  #define STEP(t,GL) do{ SBAR(); ATT_PRIO_A(); \
    const lds_cptr vp_=vp0+2*sl_prev; \
    VRDX(0,0); SBAR(); QKA(c0=__builtin_amdgcn_mfma_f32_32x32x16_bf16(kf[0],qr[0],zero16,0,0,0)); \
    QKA(c1=__builtin_amdgcn_mfma_f32_32x32x16_bf16(kf[1],qr[0],zero16,0,0,0)); \
    VRDX(1,0); SBAR(); QKA(c0=__builtin_amdgcn_mfma_f32_32x32x16_bf16(kf[2],qr[1],c0,0,0,0)); \
    QKA(c1=__builtin_amdgcn_mfma_f32_32x32x16_bf16(kf[3],qr[1],c1,0,0,0)); \
    VRDX(2,0); SBAR(); QKA(c0=__builtin_amdgcn_mfma_f32_32x32x16_bf16(kf[4],qr[2],c0,0,0,0)); \
    QKA(c1=__builtin_amdgcn_mfma_f32_32x32x16_bf16(kf[5],qr[2],c1,0,0,0)); \
    VRDX(3,0); SBAR(); QKA(c0=__builtin_amdgcn_mfma_f32_32x32x16_bf16(kf[6],qr[3],c0,0,0,0)); \
    QKA(c1=__builtin_amdgcn_mfma_f32_32x32x16_bf16(kf[7],qr[3],c1,0,0,0)); \
    STEP_DMA(t); \
    if constexpr(NOREF){ CMASKX(c0,c1,t); resc=false; } else { \
    asm volatile("s_nop 7\n\ts_nop 7":"+v"(c0),"+v"(c1)); \
    _Pragma("unroll") for(int r=0;r<16;++r){c0[r]=fsub_s(c0[r],mhat);c1[r]=fsub_s(c1[r],mhat);} \
    CMASKX(c0,c1,t); \
    { float a=MX3(c0[0],c0[1],c1[0]),b=MX3(c0[2],c0[3],c1[1]); a=MX3(a,c1[2],c1[3]); \
      _Pragma("unroll") for(int r=4;r<16;r+=4){a=MX3(a,c0[r],c0[r+1]);b=MX3(b,c0[r+2],c0[r+3]);a=MX3(a,c1[r],c1[r+1]);b=MX3(b,c1[r+2],c1[r+3]);} \
      float rm=__builtin_fmaxf(a,b); { auto rr=__builtin_amdgcn_permlane32_swap(__float_as_uint(rm),__float_as_uint(rm),false,false); rm=__builtin_fmaxf(__uint_as_float(rr[0]),__uint_as_float(rr[1])); } \
      resc=false; \
      if(__builtin_expect(__any(rm>(float)THRL),0)){ const float dl=__builtin_fmaxf(rm,0.f); mhat+=dl; \
        _Pragma("unroll") for(int r=0;r<16;++r){c0[r]-=dl;c1[r]-=dl;} \
        const float f=__builtin_amdgcn_exp2f(-dl); l_reg*=f; if(hi==0)wsf[r32]=f; resc=true; } } \
    } \
    SBAR(); ATT_PRIO_B(); float sacc=0.f; \
    GAPX(o[0]=__builtin_amdgcn_mfma_f32_32x32x16_bf16(PAF(0),VFR(0),o[0],0,0,0), c0,0,  VRDX(0,1)); \
    GAPX(o[1]=__builtin_amdgcn_mfma_f32_32x32x16_bf16(PAF(0),VFR(1),o[1],0,0,0), c0,2,  VRDX(1,1)); \
    GAPX(o[2]=__builtin_amdgcn_mfma_f32_32x32x16_bf16(PAF(0),VFR(2),o[2],0,0,0), c0,4,  VRDX(2,1)); \
    GAPX(o[3]=__builtin_amdgcn_mfma_f32_32x32x16_bf16(PAF(0),VFR(3),o[3],0,0,0), c0,6,  VRDX(3,1)); \
    GAPX(o[0]=__builtin_amdgcn_mfma_f32_32x32x16_bf16(PAF(1),VFR(0),o[0],0,0,0), c0,8,  VRDX(0,2)); PACKW(pw0,0,c0,0); SBAR(); \
    GAPX(o[1]=__builtin_amdgcn_mfma_f32_32x32x16_bf16(PAF(1),VFR(1),o[1],0,0,0), c0,10, VRDX(1,2)); PACKW(pw0,1,c0,2); SBAR(); \
    GAPX(o[2]=__builtin_amdgcn_mfma_f32_32x32x16_bf16(PAF(1),VFR(2),o[2],0,0,0), c0,12, VRDX(2,2)); PACKW(pw0,2,c0,4); SBAR(); \
    GAPX(o[3]=__builtin_amdgcn_mfma_f32_32x32x16_bf16(PAF(1),VFR(3),o[3],0,0,0), c0,14, VRDX(3,2)); PACKW(pw0,3,c0,6); SBAR(); \
    KRD(GL,0); GAPX(o[0]=__builtin_amdgcn_mfma_f32_32x32x16_bf16(PAF(2),VFR(0),o[0],0,0,0), c1,0,  VRDX(0,3)); PACKW(pw1,0,c0,8);  SBAR(); \
    KRD(GL,1); GAPX(o[1]=__builtin_amdgcn_mfma_f32_32x32x16_bf16(PAF(2),VFR(1),o[1],0,0,0), c1,2,  VRDX(1,3)); PACKW(pw1,1,c0,10); SBAR(); \
    KRD(GL,2); GAPX(o[2]=__builtin_amdgcn_mfma_f32_32x32x16_bf16(PAF(2),VFR(2),o[2],0,0,0), c1,4,  VRDX(2,3)); PACKW(pw1,2,c0,12); SBAR(); \
    KRD(GL,3); GAPX(o[3]=__builtin_amdgcn_mfma_f32_32x32x16_bf16(PAF(2),VFR(3),o[3],0,0,0), c1,6,  VRDX(3,3)); PACKW(pw1,3,c0,14); SBAR(); \
    GAPX(o[0]=__builtin_amdgcn_mfma_f32_32x32x16_bf16(PAF(3),VFR(0),o[0],0,0,0), c1,8,  (void)0); PACKW(pw2,0,c1,0); SBAR(); \
    GAPX(o[1]=__builtin_amdgcn_mfma_f32_32x32x16_bf16(PAF(3),VFR(1),o[1],0,0,0), c1,10, (void)0); PACKW(pw2,1,c1,2); SBAR(); \
    GAPX(o[2]=__builtin_amdgcn_mfma_f32_32x32x16_bf16(PAF(3),VFR(2),o[2],0,0,0), c1,12, (void)0); PACKW(pw2,2,c1,4); SBAR(); \
    GAPX(o[3]=__builtin_amdgcn_mfma_f32_32x32x16_bf16(PAF(3),VFR(3),o[3],0,0,0), c1,14, (void)0); PACKW(pw2,3,c1,6); SBAR(); \
    PACKW(pw3,0,c1,8); PACKW(pw3,1,c1,10); PACKW(pw3,2,c1,12); PACKW(pw3,3,c1,14); \
    l_reg+=sacc; \
    }while(0)
  int t=1;
  #define CMASKX(P0,P1,t) do{}while(0)
  #define STEP_DMA(t) DMA_K((t)+3,sl_cur); DMA_V((t)+1,2*sl_next)
  for(;t+5<NT;t+=2){
    STEP(t,true);     WAIT_BAR(3); RESC(); ROT();
    STEP(t+1,true);   WAIT_BAR(3); RESC(); ROT();
  }
  #undef CMASKX
  #undef STEP_DMA
  #define CMASKX(P0,P1,t) CMASK(P0,P1,t)
  #define STEP_DMA(t) DMA_KX((t)+3,sl_cur); DMA_VX((t)+1,2*sl_next)
#ifndef ATT_BANDSKIP
#define ATT_BANDSKIP 1
#endif
  const int jmax=ATT_BANDSKIP?(wid>>1):3;
#if ATT_BANDSKIP >= 2
  const int tlast=(jmax<2)?NT-3+jmax:NT-1;
  bool early=false;
  for(;t+1<NT;t+=2){
    if(t>tlast){ early=true; break; }
    STEP(t,(t+1<NT));       WAIT_BAR(3); RESC(); ROT();
    if(t+1>tlast){ t+=1; early=true; break; }
    STEP(t+1,(t+2<NT));     WAIT_BAR(3); RESC(); ROT();
  }
  if(!early&&tlast==NT-1){ STEP(NT-1,false); WAIT_BAR(3); RESC(); t=NT; }
  for(;t<NT;++t){ STEP_DMA(t); WAIT_BAR(3); if(t<NT-1){ ROT(); } }
#else
  for(;t+1<NT;t+=2){
    STEP(t,(t+1<NT));       WAIT_BAR(3); RESC(); ROT();
    STEP(t+1,(t+2<NT));     WAIT_BAR(3); RESC(); ROT();
  }
  if(!ATT_BANDSKIP||wid>=4){ STEP(NT-1,false); } else { STEP_DMA(NT-1); }
  WAIT_BAR(3); RESC();
#endif
  ring=sl_next;
  #undef STEP_DMA
  #undef CMASKX
  if(jmax>=3){ SBAR(); pv128(o,vb0+2*sl_cur,PAF(0),PAF(1),PAF(2),PAF(3)); }
  #undef PKW
  #undef PAF
  #undef PACKW
  #undef VFR
  #undef PIN
  #undef MX3
  #undef EX
  #undef VRDX
  #undef QKA
  #undef GAPX
  #undef KRD
  #undef STEP
  { const bf16*Qnw=Qn+(long)(qbn*QB+wid*QBLK)*LDQ;
    qp0=*reinterpret_cast<const bf16x8*>(&Qnw[(long)r32*LDQ+0*16+hi*8]); qp1=*reinterpret_cast<const bf16x8*>(&Qnw[(long)r32*LDQ+1*16+hi*8]);
    qp2=*reinterpret_cast<const bf16x8*>(&Qnw[(long)r32*LDQ+2*16+hi*8]); qp3=*reinterpret_cast<const bf16x8*>(&Qnw[(long)r32*LDQ+3*16+hi*8]); }
  {auto rr=__builtin_amdgcn_permlane32_swap(__float_as_uint(l_reg),__float_as_uint(l_reg),false,false);l_reg=__uint_as_float(rr[0])+__uint_as_float(rr[1]);}
  if(hi==0)wsf[32+r32]=l_reg;asm volatile("s_waitcnt lgkmcnt(0)":::"memory");
  float rli[16];
  #pragma unroll
  for(int r=0;r<16;++r)rli[r]=__builtin_amdgcn_rcpf(wsf[32+crow(r,hi)]);
  bf16*st=(bf16*)(shm+X_ST)+wid*4096;
  if(est==1){
    #pragma unroll
    for(int r=0;r<16;++r){const int orow=crow(r,hi);
      #pragma unroll
      for(int d0=0;d0<4;++d0)st[orow*128+d0*32+r32]=__float2bfloat16(o[d0][r]*rli[r]);} }
  else{ const float*dc=(const float*)(shm+X_DC); const float lam=dc[128];
    #pragma unroll
    for(int r=0;r<16;++r){const int orow=crow(r,hi);
      #pragma unroll
      for(int d0=0;d0<4;++d0){const int idx=orow*128+d0*32+r32; const float o1=__bfloat162float(st[idx]); st[idx]=__float2bfloat16(o1-lam*(o[d0][r]*rli[r]));}}
    asm volatile("s_waitcnt lgkmcnt(0)":::"memory");
    bf16*Ow=Og+(long)(q0+wid*QBLK)*ldo; const int ch=lane&15;
    const f32x4 ga=*(const f32x4*)(dc+ch*8),gb=*(const f32x4*)(dc+ch*8+4);
    #pragma unroll
    for(int i=0;i<8;++i){const int row=i*4+(lane>>4); const u32x4 v=*(const u32x4*)(st+row*128+ch*8);
      float dv[8];
      #pragma unroll
      for(int e=0;e<4;++e){dv[2*e]=__uint_as_float(v[e]<<16);dv[2*e+1]=__uint_as_float(v[e]&0xffff0000u);}
      float ss=0.f;
      #pragma unroll
      for(int e=0;e<8;++e)ss+=dv[e]*dv[e];
      ss+=__shfl_xor(ss,1);ss+=__shfl_xor(ss,2);ss+=__shfl_xor(ss,4);ss+=__shfl_xor(ss,8);
      const float rs=1.0f/sqrtf(ss*(1.0f/128.0f)+1e-5f);
      u32x4 w; w[0]=cvtpk_s(dv[0]*rs*ga[0],dv[1]*rs*ga[1]); w[1]=cvtpk_s(dv[2]*rs*ga[2],dv[3]*rs*ga[3]); w[2]=cvtpk_s(dv[4]*rs*gb[0],dv[5]*rs*gb[1]); w[3]=cvtpk_s(dv[6]*rs*gb[2],dv[7]*rs*gb[3]);
      ATTN_STORE16(Ow+(long)row*ldo+ch*8,w); } }
  asm volatile("s_waitcnt lgkmcnt(0)\n\ts_barrier":::"memory");
  #undef DMA_K
  #undef DMA_V
  #undef DMA_KX
  #undef DMA_VX
  #undef CMASK
  #undef RESC
  #undef ROT
}
constexpr int ATTN_LDS_BYTES=LDS_BYTES;
#undef SBAR
#undef WAIT_BAR
}
#ifndef ATT_A_MODE
#define ATT_A_MODE 1
#endif
#ifndef ATT_B_MODE
#define ATT_B_MODE 2
#endif
#ifndef ATT_THRL
#define ATT_THRL 8
#endif

constexpr int NWAVES = 8;
constexpr int BATCH = 16, T = 2048, D = 1024, HD = 64, FF = 2816, NQKV = 3072;
constexpr int M = BATCH * T;
constexpr float NORM_EPS = 1e-5f;
constexpr float LAMBDA_INIT = 0.35550906759096934f;
static_assert(M == pg8::TOK, "row count");

constexpr size_t MiB = 1u << 20;
constexpr size_t WS_CTL = 0, CTL_ZERO_BYTES = 32768;
constexpr size_t WS_ROPE = 1 * MiB;
constexpr size_t WS_SSP = 3 * MiB;
constexpr size_t WS_KMP = 5 * MiB;
constexpr size_t WS_W = 6 * MiB, W_LAYER = 25 * MiB;
constexpr size_t W_IN = 0, W_OUT = 6 * MiB, W_GU = 8 * MiB, W_DN = 19 * MiB;
constexpr size_t WS_HB = 56 * MiB;
constexpr size_t WS_OB = 120 * MiB;
constexpr size_t WS_QKV = 184 * MiB;
constexpr size_t WS_OS = 376 * MiB;
constexpr size_t WS_END = 504 * MiB;
static_assert(WS_ROPE == pg8::XWS_ROPE && WS_SSP == pg8::XWS_SSP && WS_KMP == pg8::XWS_KMP && WS_HB == pg8::XWS_HB && WS_QKV == pg8::XWS_QKV, "d_ws map vs epilogues");
constexpr int CW_BAR = 4096;
constexpr int RING_OFF = 0, RING_BYTES = 131072;
constexpr int LDSCTL_OFF = 143360, MISC_OFF = LDSCTL_OFF + 320;
constexpr int PTAB_OFF = LDSCTL_OFF + 512;
constexpr int RTAB_OFF = LDSCTL_OFF + 1024;
constexpr int LDS_BYTES = 163840;
static_assert(attn_body::X_BYTES <= LDSCTL_OFF && attn_body::DIL_LUT_OFF == RTAB_OFF && attn_body::DIL_LUT_OFF + 4 * attn_body::DIL_LUT_N <= LDS_BYTES && attn_body::ATTN_LDS_BYTES_DIFF <= RING_BYTES && RTAB_OFF + 11 * 1024 <= LDS_BYTES && MISC_OFF + 128 <= PTAB_OFF && PTAB_OFF + 160 <= RTAB_OFF, "LDS map");

#define GAS __attribute__((address_space(1)))
#define LAS __attribute__((address_space(3)))
typedef unsigned short bf16;
typedef unsigned v4u __attribute__((ext_vector_type(4)));
typedef unsigned v2u __attribute__((ext_vector_type(2)));
typedef float f32x4 __attribute__((ext_vector_type(4)));
typedef GAS unsigned gu32;
#define RLX_AGENT __ATOMIC_RELAXED, __HIP_MEMORY_SCOPE_AGENT
#define LDS_WAIT() asm volatile("s_waitcnt lgkmcnt(0)" ::: "memory")
#define VM_WAIT() asm volatile("s_waitcnt vmcnt(0)" ::: "memory")
__device__ __forceinline__ unsigned f2bf(float f) { unsigned u = __builtin_bit_cast(unsigned, f); return (u + 0x7fffu + ((u >> 16) & 1u)) >> 16; }
__device__ __forceinline__ unsigned pk2(float lo, float hi) { return f2bf(lo) | (f2bf(hi) << 16); }
__device__ __forceinline__ float bf_lo(unsigned w) { return __uint_as_float(w << 16); }
__device__ __forceinline__ float bf_hi(unsigned w) { return __uint_as_float(w & 0xffff0000u); }

#define XB_TMO      128
#define XB_XCNT(j)  (256  + 64 * (j))
#define XB_XSUB(j)  (1280 + 64 * (j))
#define XB_XGEN(j)  (2304 + 64 * (j))
#define XB_TOP      3328
#define XB_TOPGEN   3392
#define XCD_BAR_WORDS 3456
#define XB_SPIN_CAP (1u << 18)

__device__ __forceinline__ unsigned xb_ld(unsigned* p)              { return __hip_atomic_load(p, __ATOMIC_RELAXED, __HIP_MEMORY_SCOPE_AGENT); }
__device__ __forceinline__ unsigned xb_add(unsigned* p, unsigned v) { return __hip_atomic_fetch_add(p, v, __ATOMIC_RELAXED, __HIP_MEMORY_SCOPE_AGENT); }
__device__ __forceinline__ unsigned xb_xcc_id() { return (unsigned)__builtin_amdgcn_s_getreg((3 << 11) | 20) & 0xFu; }
#define XB_SPIN(cond, bar) do { unsigned _sp = 0; while (cond) { __builtin_amdgcn_s_sleep(1); \
    if ((++_sp & 255u) == 0u) { if (xb_ld(&(bar)[XB_TMO])) break; if (_sp > XB_SPIN_CAP) { atomicAdd(&(bar)[XB_TMO], 1u); break; } } } } while (0)

struct XcdBarrier {
    unsigned* bar; unsigned x;
    volatile LAS unsigned* st;
};

__device__ __forceinline__ XcdBarrier xcd_barrier_post(unsigned* bar, volatile LAS unsigned* st) {
    XcdBarrier b; b.bar = bar; b.x = xb_xcc_id(); b.st = st;
    if (threadIdx.x == 0) (void)xb_add(&bar[XB_XCNT(b.x)], 1u);
    return b;
}
__device__ __forceinline__ void xcd_barrier_complete(unsigned* bar, unsigned x, unsigned& nloc, unsigned& nx) {
    const unsigned G = gridDim.x * gridDim.y * gridDim.z;
    unsigned sum, cnt, mine, sp = 0u;
    for (;;) {
        sum = 0u; cnt = 0u; mine = 0u;
#pragma unroll
        for (unsigned j = 0; j < 16; ++j) { const unsigned c = xb_ld(&bar[XB_XCNT(j)]); sum += c; cnt += (c > 0u) ? 1u : 0u; mine = (j == x) ? c : mine; }
        if (sum == G) break;
        __builtin_amdgcn_s_sleep(1);
        if ((++sp & 255u) == 0u) { if (xb_ld(&bar[XB_TMO])) break; if (sp > XB_SPIN_CAP) { atomicAdd(&bar[XB_TMO], 1u); break; } }
    }
    nloc = mine > 0u ? mine : 1u; nx = cnt > 0u ? cnt : 1u;
}

__device__ __forceinline__ void xcd_barrier(const XcdBarrier& b) {
    asm volatile("s_waitcnt vmcnt(0)" ::: "memory");
    __syncthreads();
    if (threadIdx.x == 0) {
        unsigned* bar = b.bar;
        __builtin_amdgcn_s_waitcnt(0);
        unsigned nloc = b.st[0], nx = b.st[1];
        if (nloc == 0u) { xcd_barrier_complete(bar, b.x, nloc, nx); b.st[0] = nloc; b.st[1] = nx; }
        const unsigned old = xb_add(&bar[XB_XSUB(b.x)], 1u);
        const unsigned gen = old / nloc;
        if (old + 1u == (gen + 1u) * nloc) {
            __builtin_amdgcn_fence(__ATOMIC_RELEASE, "agent");
            asm volatile("s_waitcnt vmcnt(0)" ::: "memory");
            const unsigned og = xb_add(&bar[XB_TOP], 1u);
            const unsigned tg = og / nx;
            if (og + 1u == (tg + 1u) * nx) xb_add(&bar[XB_TOPGEN], 1u);
            else XB_SPIN(xb_ld(&bar[XB_TOPGEN]) == tg, bar);
            __builtin_amdgcn_fence(__ATOMIC_ACQUIRE, "agent");
            xb_add(&bar[XB_XGEN(b.x)], 1u);
            asm volatile("s_waitcnt vmcnt(0)" ::: "memory");
        } else {
            XB_SPIN(xb_ld(&bar[XB_XGEN(b.x)]) == gen, bar);
            __builtin_amdgcn_fence(__ATOMIC_ACQUIRE, "agent");
            asm volatile("s_waitcnt vmcnt(0)" ::: "memory");
        }
    }
    __syncthreads();
}


struct Frame {
    LAS unsigned char* lds;
    volatile LAS unsigned* MISC;
    gu32* ctl;
    int tid, lane, wave;
    int vcu, G, bx;
};
#ifndef FIN_ST
#define FIN_ST 1
#endif
#ifndef P0_ST
#define P0_ST 0
#endif
__device__ __forceinline__ float wave_sum(float v) {
#pragma unroll
    for (int o = 1; o < 64; o <<= 1) v += __shfl_xor(v, o);
    return v;
}
__device__ __forceinline__ void p0_transpose_item(const float* W, const float* g, int K, int N, bf16* WT, int mode, LAS float* scr, int item, int lane) {
    const int nblk = N / 32, kb = item / nblk, nb = item % nblk, k0 = 64 * kb, n0 = 32 * nb;
    const int orow = (mode == 0) ? n0 : (256 * (n0 >> 7) + (n0 & 127) + (mode == 2 ? 128 : 0));
    f32x4 w[8];
#pragma unroll
    for (int i = 0; i < 8; ++i) w[i] = MEM_NT ? __builtin_nontemporal_load((const GAS f32x4*)(W + (size_t)(k0 + 8 * i + (lane >> 3)) * N + n0 + 4 * (lane & 7))) : *(const GAS f32x4*)(W + (size_t)(k0 + 8 * i + (lane >> 3)) * N + n0 + 4 * (lane & 7));
    if (g) {
#pragma unroll
        for (int i = 0; i < 8; ++i) w[i] = w[i] * g[k0 + 8 * i + (lane >> 3)];
    }
#pragma unroll
    for (int i = 0; i < 8; ++i) { LAS float* d = scr + (8 * i + (lane >> 3)) * 33 + 4 * (lane & 7); d[0] = w[i].x; d[1] = w[i].y; d[2] = w[i].z; d[3] = w[i].w; }
    LDS_WAIT(); asm volatile("" ::: "memory");
    const int c = lane & 7;
#pragma unroll
    for (int j = 0; j < 4; ++j) { const int n = (lane >> 3) + 8 * j; const LAS float* s = scr + (8 * c) * 33 + n;
        v4u o; o.x = pk2(s[0 * 33], s[1 * 33]); o.y = pk2(s[2 * 33], s[3 * 33]); o.z = pk2(s[4 * 33], s[5 * 33]); o.w = pk2(s[6 * 33], s[7 * 33]);
        if (P0_ST == 2) ST16_SC1((GAS v4u*)(WT + (size_t)(orow + n) * K + k0 + 8 * c), o); else *(GAS v4u*)(WT + (size_t)(orow + n) * K + k0 + 8 * c) = o; }
    LDS_WAIT(); asm volatile("" ::: "memory");
}

struct Args { const void* in[18]; float* out; unsigned char* ws; };

template <class Sched> __device__ __forceinline__ void prep_rtab(Frame& F, const Sched& S, const float* ssp, int nparts) {
    LAS float* rt = (LAS float*)(F.lds + RTAB_OFF); LAS float* tmp = rt + 11 * 256;
    pg8::Unit u; int last_pm = -1; float val = 0.f;
    const int rl = F.tid & 255, hf = F.tid >> 8;
    for (int i = 0; S.next(i, u); ++i) {
        if (u.pm != last_pm) {
            last_pm = u.pm; const int row = u.pm * 256 + rl; float s = 0.f;
            if (nparts == 1) { if (hf == 0) s = ssp[row]; }
            else {
#pragma unroll
                for (int j = 0; j < 8; ++j) s += ssp[(size_t)(hf * 8 + j) * M + row];
            }
            __syncthreads();
            tmp[hf * 256 + rl] = s; LDS_WAIT(); __syncthreads();
            val = 1.0f / sqrtf((tmp[rl] + tmp[256 + rl]) * (1.0f / D) + NORM_EPS);
        }
        if ((i & 1) == hf) rt[i * 256 + rl] = val;
    }
    LDS_WAIT(); __syncthreads();
}


__device__ __forceinline__ unsigned char* get_ptr(volatile LAS unsigned* t, int k) {
    { unsigned a_ = (unsigned)(uintptr_t)t; asm volatile("" : "+v"(a_)); t = (volatile LAS unsigned*)a_; }
    const unsigned lo = (unsigned)__builtin_amdgcn_readfirstlane((int)t[2 * k]), hi = (unsigned)__builtin_amdgcn_readfirstlane((int)t[2 * k + 1]);
    unsigned long long v = (unsigned long long)lo | ((unsigned long long)hi << 32); asm volatile("" : "+s"(v)); return (unsigned char*)(GAS unsigned char*)v; }
#define PTAB ((volatile LAS unsigned*)((LAS unsigned char*)lds + PTAB_OFF))
#define IN_PTR(T, k) ((T*)get_ptr(PTAB, (k)))
#define OUT_PTR() ((float*)get_ptr(PTAB, 18))
#define WS_BASE() (get_ptr(PTAB, 19))
#define WS_PTR(T, off) ((T*)(WS_BASE() + (off)))
__device__ __forceinline__ int vcu_of(int bx, int G) { return (G % 8 == 0) ? (bx % 8) * (G / 8) + bx / 8 : bx; }
#define GRID_BAR() do { XcdBarrier b_; b_.bar = WS_PTR(unsigned, WS_CTL) + CW_BAR; b_.x = xb_xcc_id(); b_.st = (volatile LAS unsigned*)((LAS unsigned char*)lds + MISC_OFF) + 8; xcd_barrier(b_); } while (0)
__device__ __forceinline__ int opq_s(int v) { asm volatile("" : "+s"(v)); return v; }
__device__ __forceinline__ int opq_v(int v) { asm volatile("" : "+v"(v)); return v; }
#define MK_FRAME() Frame F; F.lds = (LAS unsigned char*)lds; F.MISC = (volatile LAS unsigned*)(F.lds + MISC_OFF); F.ctl = nullptr; F.tid = opq_v(threadIdx.x); F.lane = F.tid & 63; \
    F.wave = __builtin_amdgcn_readfirstlane(F.tid >> 6); F.G = opq_s(gridDim.x); F.bx = opq_s(blockIdx.x); F.vcu = vcu_of(F.bx, F.G)


#ifndef REP_P0
#define REP_P0 1
#endif
#ifndef REP_QKV
#define REP_QKV 1
#endif
#ifndef REP_ATTN0
#define REP_ATTN0 1
#endif
#ifndef REP_ATTN1
#define REP_ATTN1 1
#endif
#ifndef REP_COMB
#define REP_COMB 1
#endif
#ifndef REP_OUT0
#define REP_OUT0 1
#endif
#ifndef REP_UP
#define REP_UP 1
#endif
#define REPEAT(n) for (int rep_ = 0; rep_ < opq_s(n); ++rep_)
__global__ void __launch_bounds__(NWAVES * 64, 2) mk_fwd(Args args) {
    extern __shared__ __attribute__((aligned(16))) unsigned char lds[];
    for (int u = threadIdx.x; u < (LDS_BYTES - LDSCTL_OFF) / 4; u += NWAVES * 64) ((LAS unsigned*)((LAS unsigned char*)lds + LDSCTL_OFF))[u] = 0u;
    __syncthreads();
    if (threadIdx.x < 20) { const unsigned long long v = threadIdx.x < 18 ? (unsigned long long)args.in[threadIdx.x < 18 ? threadIdx.x : 0] : (threadIdx.x == 18 ? (unsigned long long)args.out : (unsigned long long)args.ws);
        PTAB[2 * threadIdx.x] = (unsigned)v; PTAB[2 * threadIdx.x + 1] = (unsigned)(v >> 32); }
    LDS_WAIT(); __syncthreads();
    (void)xcd_barrier_post(WS_PTR(unsigned, WS_CTL) + CW_BAR, (volatile LAS unsigned*)((LAS unsigned char*)lds + MISC_OFF) + 8);

#ifndef SKIP_P0
    REPEAT(REP_P0) {
        MK_FRAME();
        unsigned char* ws = WS_BASE();
        const int gw = F.vcu * NWAVES + F.wave, NGW = F.G * NWAVES;
        LAS float* scr = (LAS float*)(F.lds + RING_OFF + F.wave * 16384);
        constexpr int I_IN = (D / 64) * (NQKV / 32), I_OUT = (D / 64) * (D / 32), I_G = (D / 64) * (FF / 32), I_D = (FF / 64) * (D / 32);
        constexpr int I_LAYER = I_IN + I_OUT + 2 * I_G + I_D, NITEMS = 2 * I_LAYER;
        for (int it = gw; it < NITEMS; it += NGW) {
            const int L = it / I_LAYER; int r = it % I_LAYER;
            unsigned char* wl = ws + WS_W + (size_t)L * W_LAYER;
            const float* ffn_g = IN_PTR(const float, 13) + (size_t)L * D;
            if (r < I_IN) { p0_transpose_item(IN_PTR(const float, L ? 6 : 3), IN_PTR(const float, L ? 5 : 2), D, NQKV, (bf16*)(wl + W_IN), 0, scr, r, F.lane); continue; } r -= I_IN;
            if (r < I_OUT) { p0_transpose_item(IN_PTR(const float, L ? 7 : 4), nullptr, D, D, (bf16*)(wl + W_OUT), 0, scr, r, F.lane); continue; } r -= I_OUT;
            if (r < I_G) { p0_transpose_item(IN_PTR(const float, 14) + (size_t)L * D * FF, ffn_g, D, FF, (bf16*)(wl + W_GU), 1, scr, r, F.lane); continue; } r -= I_G;
            if (r < I_G) { p0_transpose_item(IN_PTR(const float, 15) + (size_t)L * D * FF, ffn_g, D, FF, (bf16*)(wl + W_GU), 2, scr, r, F.lane); continue; } r -= I_G;
            p0_transpose_item(IN_PTR(const float, 16) + (size_t)L * FF * D, nullptr, FF, D, (bf16*)(wl + W_DN), 0, scr, r, F.lane);
        }
        const float* x = IN_PTR(const float, 0);
        bf16* HB = (bf16*)(ws + WS_HB); float* ssp = (float*)(ws + WS_SSP);
#ifndef P0_ADJ
#define P0_ADJ 0
#endif
        for (int m0 = P0_ADJ ? 2 * gw : gw; m0 < M; m0 += 2 * NGW) {
            f32x4 v[2][4];
#pragma unroll
            for (int q = 0; q < 2; ++q) { const int mq = P0_ADJ ? ((m0 + q < M) ? m0 + q : m0) : ((m0 + q * NGW < M) ? m0 + q * NGW : m0); const GAS f32x4* xr = (const GAS f32x4*)(x + (size_t)mq * D) + F.lane;
#pragma unroll
                for (int j = 0; j < 4; ++j) v[q][j] = MEM_NT ? __builtin_nontemporal_load(xr + 64 * j) : xr[64 * j]; }
#pragma unroll
            for (int q = 0; q < 2; ++q) { const int m = P0_ADJ ? ((m0 + q < M) ? m0 + q : m0) : ((m0 + q * NGW < M) ? m0 + q * NGW : m0); float s = 0.f;
#pragma unroll
                for (int j = 0; j < 4; ++j) s += (v[q][j].x * v[q][j].x + v[q][j].y * v[q][j].y) + (v[q][j].z * v[q][j].z + v[q][j].w * v[q][j].w);
                s = wave_sum(s);
                GAS unsigned long long* o8 = (GAS unsigned long long*)(HB + (size_t)m * D) + F.lane;
#pragma unroll
                for (int j = 0; j < 4; ++j) { const unsigned long long pv = (unsigned long long)pk2(v[q][j].x, v[q][j].y) | ((unsigned long long)pk2(v[q][j].z, v[q][j].w) << 32); if (P0_ST == 2) ST8_SC1(o8 + 64 * j, pv); else if (P0_ST == 1) __builtin_nontemporal_store(pv, o8 + 64 * j); else o8[64 * j] = pv; }
                if (F.lane == 0) ssp[m] = s; }
        }
        const int* pos = IN_PTR(const int, 1); float* rope = (float*)(ws + WS_ROPE);
        for (int idx = gw * 64 + F.lane; idx < M * 8; idx += NGW * 64) {
            const int row = idx >> 3, i = idx & 7;
            const float invf = i == 0 ? 1.0f : i == 1 ? 0.1939227432012558f : i == 2 ? 0.03760603070259094f : i == 3 ? 0.007292664609849453f :
                               i == 4 ? 0.0014142135623842478f : i == 5 ? 0.00027424818836152554f : i == 6 ? 5.3182957344688475e-05f : 1.0313385246263351e-05f;
            const float ang = (float)pos[row] * invf;
            float sn, cs; sincosf(ang, &sn, &cs);
            rope[(size_t)row * 16 + i] = cs; rope[(size_t)row * 16 + 8 + i] = sn;
        }
    }
#endif
    GRID_BAR();

#pragma unroll 1
    for (int L = 0; L < 2; ++L) {
#ifndef SKIP_QKV
        REPEAT(REP_QKV) {
            MK_FRAME();
            unsigned char* ws = WS_BASE();
            pg8::Gemm g{(const bf16*)(ws + WS_HB), (const bf16*)(ws + WS_W + (size_t)L * W_LAYER + W_IN), M, NQKV, D}; pg8::StaticOrder S; S.init(M, NQKV, F.G, F.bx);
            prep_rtab(F, S, (const float*)(ws + WS_SSP), L == 0 ? 1 : 16);
            pg8::EpiQKV E{PTAB, (const LAS float*)(F.lds + RTAB_OFF), L == 0 ? 0x3CFu : 0xFFu, L == 0 ? 0xC3u : 0x0Fu, L == 0 ? 0x300u : 0u, attn_body::C2};
            pg8::gemm_phase<pg8::EpiQKV, pg8::StaticOrder, PG8_ALIGN, PG8_SP2>(F.lds + RING_OFF, g, S, E);
        }
#endif
        GRID_BAR();
        if (L == 0) {
#ifndef SKIP_ATTN0
            const int G = opq_s(gridDim.x);
            {
                LAS float* lut = (LAS float*)((LAS unsigned char*)lds + RING_OFF + attn_body::DIL_LUT_OFF);
#pragma clang loop vectorize(disable) unroll(disable)
                for (int i = opq_v(threadIdx.x); i < attn_body::DIL_LUT_N; i += NWAVES * 64) ((volatile LAS float*)lut)[i] = attn_body::dil_bias(opq_v(i) - 256);
                LDS_WAIT(); __syncthreads();
            }
            REPEAT(REP_ATTN0) for (int it = vcu_of(opq_s(blockIdx.x), G); it < 256; it += G) {
                const int p = it >> 1, par = it & 1, b = p >> 3, hh = p & 7;
                int ring = 0, first = 1;
                attn_body::bf16x8 qp0 = {}, qp1 = {}, qp2 = {}, qp3 = {};
#pragma unroll 1
                for (int k = 0; k < 4; ++k) {
                    const int qb = par == 0 ? (k == 0 ? 7 : k == 1 ? 4 : k == 2 ? 3 : 0) : (k == 0 ? 6 : k == 1 ? 5 : k == 2 ? 2 : 1);
                    const int k1 = k < 3 ? k + 1 : 3, qb1 = par == 0 ? (k1 == 0 ? 7 : k1 == 1 ? 4 : k1 == 2 ? 3 : 0) : (k1 == 0 ? 6 : k1 == 1 ? 5 : k1 == 2 ? 2 : 1);
                    {
                        const attn_body::bf16* qkvb = WS_PTR(const attn_body::bf16, WS_QKV) + (size_t)b * T * NQKV + 64 * hh;
                        attn_body::bf16* ob = WS_PTR(attn_body::bf16, WS_OB) + (size_t)b * T * D + 64 * hh;
                        attn_body::attn_unit<ATT_A_MODE, ATT_THRL>(qb, qkvb, 0, 512, 1024, ob, D, nullptr, (char*)lds + RING_OFF, 0, 2048, 2560, first, ring, 1536, qb, qp0, qp1, qp2, qp3);
                        first = 0;
                    }
                    {
                        const attn_body::bf16* qkvb = WS_PTR(const attn_body::bf16, WS_QKV) + (size_t)b * T * NQKV + 64 * hh;
                        attn_body::bf16* ob = WS_PTR(attn_body::bf16, WS_OB) + (size_t)b * T * D + 64 * hh;
                        const float* km0 = WS_PTR(const float, WS_KMP) + (size_t)(b * 8) * 512 + 64 * hh;
                        attn_body::attn_unit<ATT_B_MODE, ATT_THRL>(qb, qkvb, 1536, 2048, 2560, ob + 512, D, km0, (char*)lds + RING_OFF, 0, 512, 1024, 0, ring, 0, qb1, qp0, qp1, qp2, qp3);
                    }
                }
                VM_WAIT(); __syncthreads();
            }
#ifdef XABL
            for (int it = vcu_of(opq_s(blockIdx.x), G); it < 256; it += G) {
                const int p = it >> 1, b = p >> 3, hh = p & 7;
                int ring = 0; attn_body::bf16x8 qp0 = {}, qp1 = {}, qp2 = {}, qp3 = {};
#pragma unroll 1
                for (int k = 0; k < 8; ++k) {
                    const attn_body::bf16* qkvb = WS_PTR(const attn_body::bf16, WS_QKV) + (size_t)b * T * NQKV + 64 * hh;
                    attn_body::bf16* osb = WS_PTR(attn_body::bf16, WS_OS) + (size_t)b * T * 2048 + 64 * hh;
                    attn_body::attn_unit<0, 8, XABL>(7, qkvb, 0, 512, 1024, osb, 2048, nullptr, (char*)lds + RING_OFF, 0, 512, 1024, k == 0 ? 1 : 0, ring, 0, 7, qp0, qp1, qp2, qp3);
                }
                VM_WAIT(); __syncthreads();
            }
#endif
#endif
        } else {
#ifndef SKIP_ATTN1
            const int G = opq_s(gridDim.x);
            {
                LAS float* dc = (LAS float*)((LAS unsigned char*)lds + RING_OFF + attn_body::X_DC);
                const int tid = opq_v(threadIdx.x);
                if (tid < 128) dc[tid] = IN_PTR(const float, 12)[tid] * (1.0f - LAMBDA_INIT);
                if (tid < 64) {
                    const float s1 = wave_sum(IN_PTR(const float, 8)[tid] * IN_PTR(const float, 9)[tid]), s2 = wave_sum(IN_PTR(const float, 10)[tid] * IN_PTR(const float, 11)[tid]);
                    if (tid == 0) dc[128] = expf(s1) - expf(s2) + LAMBDA_INIT;
                }
                LDS_WAIT(); __syncthreads();
            }
            REPEAT(REP_ATTN1) for (int it = vcu_of(opq_s(blockIdx.x), G); it < 256; it += G) {
                const int p = it >> 1, par = it & 1, b = p >> 3, h = p & 7;
                int ring = 0; attn_body::bf16x8 qp0 = {}, qp1 = {}, qp2 = {}, qp3 = {};
#pragma unroll 1
                for (int k = 0; k < 8; ++k) {
                    const int kq = k >> 1, i = k & 1, in_ = (k + 1) & 1;
                    const int qb = par == 0 ? (kq == 0 ? 7 : kq == 1 ? 4 : kq == 2 ? 3 : 0) : (kq == 0 ? 6 : kq == 1 ? 5 : kq == 2 ? 2 : 1);
                    const int kqn = (k < 7 ? k + 1 : 7) >> 1, qbn = par == 0 ? (kqn == 0 ? 7 : kqn == 1 ? 4 : kqn == 2 ? 3 : 0) : (kqn == 0 ? 6 : kqn == 1 ? 5 : kqn == 2 ? 2 : 1);
                    const attn_body::bf16* qkvb = WS_PTR(const attn_body::bf16, WS_QKV) + (size_t)b * T * NQKV;
                    attn_body::bf16* ob = WS_PTR(attn_body::bf16, WS_OB) + (size_t)b * T * D + 128 * h;
                    attn_body::attn_unit_dv128<ATT_THRL>(qb, qkvb, 64 * (2 * h + i), 1024 + 64 * (2 * h + i), 2048 + 128 * h, ob, D, (char*)lds + RING_OFF, i == 0 ? 1 : 3,
                                                  1024 + 64 * (2 * h + in_), k == 0 ? 1 : 0, ring, 64 * (2 * h + in_), qbn, qp0, qp1, qp2, qp3);
                }
                VM_WAIT(); __syncthreads();
            }
#endif
        }
        GRID_BAR();
#ifndef SKIP_OUT
        {
            MK_FRAME();
            unsigned char* ws = WS_BASE();
            pg8::Gemm g{(const bf16*)(ws + WS_OB), (const bf16*)(ws + WS_W + (size_t)L * W_LAYER + W_OUT), M, D, D}; pg8::StaticOrder S; S.init(M, D, F.G, F.bx);
            pg8::EpiResid E{PTAB};
            pg8::gemm_phase<pg8::EpiResid, pg8::StaticOrder, PG8_ALIGN, PG8_SP2>(F.lds + RING_OFF, g, S, E);
        }
#endif
#ifndef XEPI
#define XEPI 1
#endif
#ifdef XOUT
        for (int xr = 0; xr < opq_s(XOUT); ++xr) {
            GRID_BAR();
            MK_FRAME();
            unsigned char* ws = WS_BASE();
            pg8::Gemm g{(const bf16*)(ws + WS_OB), (const bf16*)(ws + WS_W + (size_t)L * W_LAYER + W_OUT), M, D, D}; pg8::StaticOrder S; S.init(M, D, F.G, F.bx);
            pg8::EpiResidT<XEPI> E{PTAB};
            pg8::gemm_phase<pg8::EpiResidT<XEPI>, pg8::StaticOrder, PG8_ALIGN, PG8_SP2>(F.lds + RING_OFF, g, S, E);
        }
#endif
#ifdef XDOWN
        for (int xr = 0; xr < opq_s(XDOWN); ++xr) {
            GRID_BAR();
            MK_FRAME();
            unsigned char* ws = WS_BASE();
            pg8::Gemm g{(const bf16*)(ws + WS_QKV), (const bf16*)(ws + WS_W + (size_t)L * W_LAYER + W_DN), M, D, FF}; pg8::StaticOrder S; S.init(M, D, F.G, F.bx);
            pg8::EpiResidT<XEPI> E{PTAB};
            pg8::gemm_phase<pg8::EpiResidT<XEPI>, pg8::StaticOrder, PG8_ALIGN, PG8_SP2>(F.lds + RING_OFF, g, S, E);
        }
#endif
        GRID_BAR();
#ifndef SKIP_UP
        REPEAT(REP_UP) {
            MK_FRAME();
            unsigned char* ws = WS_BASE();
            pg8::Gemm g{(const bf16*)(ws + WS_HB), (const bf16*)(ws + WS_W + (size_t)L * W_LAYER + W_GU), M, 2 * FF, D}; pg8::StaticOrder S; S.init(M, 2 * FF, F.G, F.bx);
            prep_rtab(F, S, (const float*)(ws + WS_SSP), 16);
            pg8::EpiSwiGLU E{PTAB, (const LAS float*)(F.lds + RTAB_OFF)};
            pg8::gemm_phase<pg8::EpiSwiGLU, pg8::StaticOrder, PG8_ALIGN, PG8_SP2>(F.lds + RING_OFF, g, S, E);
        }
#endif
        GRID_BAR();
#ifndef SKIP_DOWN
        {
            MK_FRAME();
            unsigned char* ws = WS_BASE();
            pg8::Gemm g{(const bf16*)(ws + WS_QKV), (const bf16*)(ws + WS_W + (size_t)L * W_LAYER + W_DN), M, D, FF, ACT_LD, 0}; pg8::StaticOrder S; S.init(M, D, F.G, F.bx);
            pg8::EpiResid E{PTAB};
            pg8::gemm_phase<pg8::EpiResid, pg8::StaticOrder, PG8_ALIGN, PG8_SP2>(F.lds + RING_OFF, g, S, E);
        }
#endif
        GRID_BAR();
    }
#ifndef SKIP_FINAL
    {
        MK_FRAME();
        unsigned char* ws = WS_BASE();
        const int gw = F.vcu * NWAVES + F.wave, NGW = F.G * NWAVES;
        float* out = OUT_PTR();
        const bf16* HB = (const bf16*)(ws + WS_HB); const float* ssp = (const float*)(ws + WS_SSP);
        const float* gf = IN_PTR(const float, 17);
        f32x4 gv[2][2];
#pragma unroll
        for (int j = 0; j < 2; ++j) { gv[j][0] = *(const GAS f32x4*)(gf + 512 * j + 8 * F.lane); gv[j][1] = *(const GAS f32x4*)(gf + 512 * j + 8 * F.lane + 4); }
        for (int m = gw; m < M; m += NGW) {
            float s = 0.f;
#pragma unroll
            for (int j = 0; j < 16; ++j) s += ssp[(size_t)j * M + m];
            const float rs = 1.0f / sqrtf(s * (1.0f / D) + NORM_EPS);
#pragma unroll
            for (int j = 0; j < 2; ++j) {
                const v4u w = MEM_NT ? __builtin_nontemporal_load((const GAS v4u*)(HB + (size_t)m * D + 512 * j + 8 * F.lane)) : *(const GAS v4u*)(HB + (size_t)m * D + 512 * j + 8 * F.lane);
                const f32x4 a = (f32x4){bf_lo(w.x), bf_hi(w.x), bf_lo(w.y), bf_hi(w.y)}, b = (f32x4){bf_lo(w.z), bf_hi(w.z), bf_lo(w.w), bf_hi(w.w)};
                GAS f32x4* po = (GAS f32x4*)(out + (size_t)m * D + 512 * j + 8 * F.lane);
                if (FIN_ST == 2) { const f32x4 o0 = a * rs * gv[j][0], o1 = b * rs * gv[j][1]; ST16_SC1(po, o0); ST16_SC1(po + 1, o1); } else if (FIN_ST) { __builtin_nontemporal_store(a * rs * gv[j][0], po); __builtin_nontemporal_store(b * rs * gv[j][1], po + 1); } else { po[0] = a * rs * gv[j][0]; po[1] = b * rs * gv[j][1]; }
            }
        }
    }
#endif
}

extern "C" void kernel_launch(void* const* d_in, const int* in_sizes, int n_in, void* d_out, int out_size, void* d_ws, size_t ws_size, hipStream_t stream) {
    static int grid = 0;
    if (grid == 0) {
        if (n_in != 18 || in_sizes[0] != M * D || out_size != M * D || ws_size < WS_END) { fprintf(stderr, "kernel_launch: unexpected problem shape / workspace (n_in %d, in0 %d, out %d, ws %zu)\n", n_in, n_in > 0 ? in_sizes[0] : -1, out_size, ws_size); grid = -1; return; }
        int dev = 0, cus = 0, per_cu = 0;
        if (hipGetDevice(&dev) != hipSuccess || hipDeviceGetAttribute(&cus, hipDeviceAttributeMultiprocessorCount, dev) != hipSuccess) { grid = -1; return; }
        if (hipFuncSetAttribute((const void*)mk_fwd, hipFuncAttributeMaxDynamicSharedMemorySize, LDS_BYTES) != hipSuccess) { fprintf(stderr, "kernel_launch: hipFuncSetAttribute failed\n"); grid = -1; return; }
        if (hipOccupancyMaxActiveBlocksPerMultiprocessor(&per_cu, (const void*)mk_fwd, NWAVES * 64, LDS_BYTES) != hipSuccess || per_cu < 1) { fprintf(stderr, "kernel_launch: occupancy query says %d blocks per CU\n", per_cu); per_cu = 1; }
        (void)hipGetLastError();
        grid = cus;
    }
    if (grid < 0) return;
    if (hipMemsetAsync((char*)d_ws + WS_CTL, 0, CTL_ZERO_BYTES, stream) != hipSuccess) { fprintf(stderr, "kernel_launch: hipMemsetAsync failed\n"); return; }
    Args a{};
    for (int i = 0; i < 18; ++i) a.in[i] = d_in[i];
    a.out = (float*)d_out; a.ws = (unsigned char*)d_ws;
    hipLaunchKernelGGL(mk_fwd, dim3(grid), dim3(NWAVES * 64), LDS_BYTES, stream, a);
}
```
